# Optimizing an MI355X kernel written in HIP

```python
import math
import jax, jax.numpy as jnp
from jax import lax
import numpy as np

D_MODEL = 2048
BATCH = 4
SEQ = 2048
DEPTH = 4

HEAD_DIM = 128
H_MOBA = 4
H_MLSTM = 4
H_DIL = 4
DK_MLSTM = 128
DV_MLSTM = 256
D_MIX = H_MOBA * HEAD_DIM + H_MLSTM * DV_MLSTM + H_DIL * HEAD_DIM
D_FF = 5632
D_PLE = 256
MOBA_BLOCK = 256
MOBA_TOPK = 3
MOBA_Q_CHUNK = 64
DIL_PAIRS = ((128, 1), (512, 4), (2048, 16))
DIL_BLOCK = 128
MLSTM_CHUNK = 64
CONV_WIDTH = 4
RMS_EPS = 1e-6
NEG_INF = -1e30
N_ALIBI = H_MOBA + H_DIL
IN_SIZES = (3 * H_MOBA * HEAD_DIM,
            3 * H_DIL * HEAD_DIM,
            2 * H_MLSTM * DK_MLSTM,
            H_MLSTM * DV_MLSTM,
            H_MLSTM * DV_MLSTM,
            H_MLSTM,
            H_MLSTM)
D_IN = (3 * H_MOBA * HEAD_DIM + 3 * H_DIL * HEAD_DIM + 2 * H_MLSTM * DK_MLSTM
        + 2 * H_MLSTM * DV_MLSTM + 2 * H_MLSTM)

kernel_name = 'hymba_moba_mlstm_dilated_macaron_ple'


def rms_norm(x, g):
    xf = x.astype(jnp.float32)
    y = xf * lax.rsqrt(jnp.mean(xf * xf, axis=-1, keepdims=True) + RMS_EPS)
    return (y * g.astype(jnp.float32)).astype(x.dtype)


def swiglu(h, w_up, w_down):
    gate, up = jnp.split(h @ w_up, 2, axis=-1)
    return (jax.nn.silu(gate) * up) @ w_down


def alibi_slopes():
    return 2.0 ** (-8.0 * jnp.arange(1, N_ALIBI + 1, dtype=jnp.float32) / N_ALIBI)


def split_heads(x, n):
    b, t, _ = x.shape
    return x.reshape(b, t, n, -1).transpose(0, 2, 1, 3)


def merge_heads(x):
    b, h, t, d = x.shape
    return x.transpose(0, 2, 1, 3).reshape(b, t, h * d)


def moba_attention(q, k, v, slopes):
    B, H, T, hd = q.shape
    f32 = jnp.float32
    scale = hd ** -0.5
    nb = -(-T // MOBA_BLOCK)
    Tp = nb * MOBA_BLOCK
    pad = ((0, 0), (0, 0), (0, Tp - T), (0, 0))
    qp, kp, vp = jnp.pad(q, pad), jnp.pad(k, pad), jnp.pad(v, pad)
    kb = kp.reshape(B, H, nb, MOBA_BLOCK, hd)
    vb = vp.reshape(B, H, nb, MOBA_BLOCK, hd)
    k_mean = jnp.mean(kb.astype(f32), axis=3)
    n_cols = max(nb, MOBA_TOPK)
    nq = Tp // MOBA_Q_CHUNK
    q_chunks = jnp.moveaxis(qp.reshape(B, H, nq, MOBA_Q_CHUNK, hd), 2, 0)
    b_idx = jnp.arange(B)[:, None, None, None]
    h_idx = jnp.arange(H)[None, :, None, None]
    KM = MOBA_TOPK * MOBA_BLOCK

    def one_chunk(args):
        qi, ci = args
        start = ci * MOBA_Q_CHUNK
        cur = start // MOBA_BLOCK
        q_pos = start + jnp.arange(MOBA_Q_CHUNK)
        gate = jnp.einsum('bhqd,bhnd->bhqn', qi.astype(f32), k_mean)
        gate = jnp.where(jnp.arange(nb) < cur, gate, NEG_INF)
        gate = jnp.pad(gate, ((0, 0), (0, 0), (0, 0), (0, n_cols - nb)), constant_values=NEG_INF)
        _, sel = lax.top_k(gate, MOBA_TOPK)
        sel = jnp.minimum(sel, nb - 1)
        valid = jnp.arange(MOBA_TOPK) < cur
        k_sel = kb[b_idx, h_idx, sel]
        v_sel = vb[b_idx, h_idx, sel]
        s_sel = jnp.einsum('bhqd,bhqjkd->bhqjk', qi, k_sel, preferred_element_type=f32) * scale
        dist_sel = (q_pos[:, None, None] - (sel[..., None] * MOBA_BLOCK + jnp.arange(MOBA_BLOCK))).astype(f32)
        s_sel = jnp.where(valid[:, None], s_sel - slopes[:, None, None, None] * dist_sel, NEG_INF)
        k_own = lax.dynamic_slice_in_dim(kp, cur * MOBA_BLOCK, MOBA_BLOCK, axis=2)
        v_own = lax.dynamic_slice_in_dim(vp, cur * MOBA_BLOCK, MOBA_BLOCK, axis=2)
        s_own = jnp.einsum('bhqd,bhkd->bhqk', qi, k_own, preferred_element_type=f32) * scale
        dist_own = q_pos[:, None] - (cur * MOBA_BLOCK + jnp.arange(MOBA_BLOCK))[None, :]
        s_own = jnp.where(dist_own >= 0, s_own - slopes[:, None, None] * dist_own.astype(f32), NEG_INF)
        s = jnp.concatenate([s_sel.reshape(B, H, MOBA_Q_CHUNK, KM), s_own], axis=-1)
        prob = jax.nn.softmax(s, axis=-1).astype(v.dtype)
        p_sel = prob[..., :KM].reshape(B, H, MOBA_Q_CHUNK, MOBA_TOPK, MOBA_BLOCK)
        p_own = prob[..., KM:]
        return (jnp.einsum('bhqjk,bhqjkd->bhqd', p_sel, v_sel)
                + jnp.einsum('bhqk,bhkd->bhqd', p_own, v_own))

    out = lax.map(one_chunk, (q_chunks, jnp.arange(nq)))
    out = jnp.moveaxis(out, 0, 2).reshape(B, H, Tp, hd)
    return out[:, :, :T]


def dilated_branch(q, k, v, slopes, window, dil):
    B, H, T, hd = q.shape
    f32 = jnp.float32
    scale = hd ** -0.5
    L = T // dil
    band = window // dil
    nbl = -(-L // DIL_BLOCK)
    Lp = nbl * DIL_BLOCK

    def to_blocks(a):
        a = a.reshape(B, H, L, dil, hd).transpose(0, 1, 3, 2, 4)
        a = jnp.pad(a, ((0, 0), (0, 0), (0, 0), (0, Lp - L), (0, 0)))
        return a.reshape(B, H, dil, nbl, DIL_BLOCK, hd)

    def with_prev(a):
        prev = jnp.pad(a, ((0, 0), (0, 0), (0, 0), (1, 0), (0, 0), (0, 0)))[:, :, :, :-1]
        return jnp.concatenate([prev, a], axis=4)

    qb = to_blocks(q)
    kc, vc = with_prev(to_blocks(k)), with_prev(to_blocks(v))
    s = jnp.einsum('bhrnqd,bhrnkd->bhrnqk', qb, kc, preferred_element_type=f32) * scale
    k_loc = jnp.arange(2 * DIL_BLOCK)
    delta = (DIL_BLOCK + jnp.arange(DIL_BLOCK))[:, None] - k_loc[None, :]
    k_sub = (jnp.arange(nbl)[:, None] - 1) * DIL_BLOCK + k_loc[None, :]
    mask = (delta >= 0) & (delta <= band) & (k_sub[:, None, :] >= 0)
    s = s - slopes[:, None, None, None, None] * (delta * dil).astype(f32)
    s = jnp.where(mask, s, NEG_INF)
    lse = jax.nn.logsumexp(s, axis=-1)
    prob = jnp.exp(s - lse[..., None]).astype(v.dtype)
    o = jnp.einsum('bhrnqk,bhrnkd->bhrnqd', prob, vc)

    def from_blocks(a):
        a = a.reshape(B, H, dil, Lp, *a.shape[5:])[:, :, :, :L]
        a = jnp.swapaxes(a, 2, 3)
        return a.reshape(B, H, T, *a.shape[4:])

    return from_blocks(o), from_blocks(lse)


def dilated_attention(q, k, v, slopes):
    outs, lses = [], []
    for window, dil in DIL_PAIRS:
        o, lse = dilated_branch(q, k, v, slopes, window, dil)
        outs.append(o.astype(jnp.float32))
        lses.append(lse)
    wts = jax.nn.softmax(jnp.stack(lses, axis=0), axis=0)
    return jnp.sum(wts[..., None] * jnp.stack(outs, axis=0), axis=0).astype(q.dtype)


def mlstm(q, k, v, i_pre, f_pre):
    B, H, T, dk = q.shape
    dv = v.shape[-1]
    f32 = jnp.float32
    nc = T // MLSTM_CHUNK
    q = q.astype(f32)
    k = k.astype(f32) * dk ** -0.5
    v = v.astype(f32)
    log_f = jax.nn.log_sigmoid(f_pre.astype(f32))
    log_i = i_pre.astype(f32)
    causal = jnp.tril(jnp.ones((MLSTM_CHUNK, MLSTM_CHUNK), dtype=bool))

    def chunks(a):
        return jnp.moveaxis(a.reshape(B, H, nc, MLSTM_CHUNK, *a.shape[3:]), 2, 0)

    def step(carry, xs):
        c_st, n_st, m_st = carry
        qc, kc, vc, lf, li = xs
        b = jnp.cumsum(lf, axis=-1)
        d_log = jnp.where(causal, b[..., :, None] - b[..., None, :] + li[..., None, :], NEG_INF)
        m_inter = b + m_st[..., None]
        m_t = jnp.maximum(m_inter, jnp.max(d_log, axis=-1))
        w_inter = jnp.exp(m_inter - m_t)
        s = jnp.einsum('bhtd,bhsd->bhts', qc, kc) * jnp.exp(d_log - m_t[..., None])
        num = (w_inter[..., None] * jnp.einsum('bhtd,bhde->bhte', qc, c_st)
               + jnp.einsum('bhts,bhse->bhte', s, vc))
        den = w_inter * jnp.einsum('bhtd,bhd->bht', qc, n_st) + jnp.sum(s, axis=-1)
        h = num / jnp.maximum(jnp.abs(den), jnp.exp(-m_t))[..., None]
        b_last = b[..., -1]
        g = b_last[..., None] - b + li
        m_new = jnp.maximum(b_last + m_st, jnp.max(g, axis=-1))
        w_old = jnp.exp(b_last + m_st - m_new)
        w_k = jnp.exp(g - m_new[..., None])
        c_new = w_old[..., None, None] * c_st + jnp.einsum('bhs,bhsd,bhse->bhde', w_k, kc, vc)
        n_new = w_old[..., None] * n_st + jnp.einsum('bhs,bhsd->bhd', w_k, kc)
        return (c_new, n_new, m_new), h

    init = (jnp.zeros((B, H, dk, dv), f32), jnp.zeros((B, H, dk), f32), jnp.zeros((B, H), f32))
    _, h = lax.scan(step, init, (chunks(q), chunks(k), chunks(v), chunks(log_f), chunks(log_i)))
    return jnp.moveaxis(h, 0, 2).reshape(B, H, T, dv)


def causal_conv(u, w, b):
    c = u.shape[-1]
    y = lax.conv_general_dilated(u, w.astype(u.dtype)[:, None, :], window_strides=(1,),
                                 padding=((CONV_WIDTH - 1, 0),),
                                 dimension_numbers=('NWC', 'WIO', 'NWC'), feature_group_count=c)
    return y + b.astype(u.dtype)


def token_mix(hn, w_in, conv_w, conv_b, b_igate, b_fgate, g_head, w_out, slopes_moba, slopes_dil):
    z = hn @ w_in
    offs = np.cumsum(IN_SIZES)[:-1].tolist()
    qkv_a, qkv_c, qk_m, v_m, o_m, i_m, f_m = jnp.split(z, offs, axis=-1)
    qa, ka, va = (split_heads(t, H_MOBA) for t in jnp.split(qkv_a, 3, axis=-1))
    out_a = moba_attention(qa, ka, va, slopes_moba)
    qc, kc, vc = (split_heads(t, H_DIL) for t in jnp.split(qkv_c, 3, axis=-1))
    out_c = dilated_attention(qc, kc, vc, slopes_dil)
    qk_m = jax.nn.silu(causal_conv(qk_m, conv_w, conv_b))
    qm, km = jnp.split(qk_m, 2, axis=-1)
    i_pre = jnp.swapaxes(i_m + b_igate, 1, 2)
    f_pre = jnp.swapaxes(f_m + b_fgate, 1, 2)
    h_m = mlstm(split_heads(qm, H_MLSTM), split_heads(km, H_MLSTM), split_heads(v_m, H_MLSTM), i_pre, f_pre)
    h_m = h_m * lax.rsqrt(jnp.mean(h_m * h_m, axis=-1, keepdims=True) + RMS_EPS)
    h_m = h_m * g_head.astype(jnp.float32).reshape(H_MLSTM, 1, DV_MLSTM)
    out_m = (jax.nn.sigmoid(o_m.astype(jnp.float32)) * merge_heads(h_m)).astype(hn.dtype)
    mixed = jnp.concatenate([merge_heads(out_a), out_m, merge_heads(out_c)], axis=-1)
    return mixed @ w_out


def setup_inputs(seed: int = 0) -> dict:
    key = jax.random.key(seed)
    ks = jax.random.split(key, 24)
    f32 = jnp.float32

    def normal(k, shape, scale):
        return jax.random.normal(k, shape, f32) * scale

    def gain(k, shape):
        return 1.0 + normal(k, shape, 0.02)

    return {
        'x': normal(ks[0], (BATCH, SEQ, D_MODEL), 1.0),
        'p': normal(ks[1], (DEPTH, BATCH, SEQ, D_PLE), 1.0),
        'g_ffn1': gain(ks[2], (DEPTH, D_MODEL)),
        'w_up1': normal(ks[3], (DEPTH, D_MODEL, 2 * D_FF), D_MODEL ** -0.5),
        'w_down1': normal(ks[4], (DEPTH, D_FF, D_MODEL), D_FF ** -0.5),
        'g_mix': gain(ks[5], (DEPTH, D_MODEL)),
        'w_in': normal(ks[6], (DEPTH, D_MODEL, D_IN), D_MODEL ** -0.5),
        'conv_w': normal(ks[7], (DEPTH, CONV_WIDTH, 2 * H_MLSTM * DK_MLSTM), CONV_WIDTH ** -0.5),
        'conv_b': normal(ks[8], (DEPTH, 2 * H_MLSTM * DK_MLSTM), 0.01),
        'b_igate': normal(ks[9], (DEPTH, H_MLSTM), 0.1),
        'b_fgate': jnp.linspace(3.0, 6.0, H_MLSTM, dtype=f32)[None, :] + normal(ks[10], (DEPTH, H_MLSTM), 0.1),
        'g_head': gain(ks[11], (DEPTH, H_MLSTM * DV_MLSTM)),
        'w_out': normal(ks[12], (DEPTH, D_MIX, D_MODEL), D_MIX ** -0.5),
        'g_ffn2': gain(ks[13], (DEPTH, D_MODEL)),
        'w_up2': normal(ks[14], (DEPTH, D_MODEL, 2 * D_FF), D_MODEL ** -0.5),
        'w_down2': normal(ks[15], (DEPTH, D_FF, D_MODEL), D_FF ** -0.5),
        'g_ple': gain(ks[16], (DEPTH, D_MODEL)),
        'w_ple_gate': normal(ks[17], (DEPTH, D_MODEL, D_MODEL), D_MODEL ** -0.5),
        'w_ple_proj': normal(ks[18], (DEPTH, D_PLE, D_MODEL), D_PLE ** -0.5),
        'g_final': gain(ks[19], (D_MODEL,)),
    }


def reference(x, p, g_ffn1, w_up1, w_down1, g_mix, w_in, conv_w, conv_b, b_igate, b_fgate,
              g_head, w_out, g_ffn2, w_up2, w_down2, g_ple, w_ple_gate, w_ple_proj, g_final):
    slopes = alibi_slopes()
    slopes_moba, slopes_dil = slopes[0::2], slopes[1::2]
    h = x
    for i in range(DEPTH):
        h = h + 0.5 * swiglu(rms_norm(h, g_ffn1[i]), w_up1[i], w_down1[i])
        h = h + token_mix(rms_norm(h, g_mix[i]), w_in[i], conv_w[i], conv_b[i], b_igate[i],
                          b_fgate[i], g_head[i], w_out[i], slopes_moba, slopes_dil)
        h = h + 0.5 * swiglu(rms_norm(h, g_ffn2[i]), w_up2[i], w_down2[i])
        gate = jax.nn.sigmoid(rms_norm(h, g_ple[i]) @ w_ple_gate[i])
        h = h + gate * (p[i] @ w_ple_proj[i])
    return rms_norm(h, g_final)
```

```cpp
#include <hip/hip_runtime.h>
#include <cstdio>
#include <cstdint>
namespace pg8 {
#define PG8_LAS __attribute__((address_space(3)))
typedef unsigned short bf16_t;
typedef short bf16x8 __attribute__((ext_vector_type(8)));
typedef float f32x4 __attribute__((ext_vector_type(4)));
typedef unsigned u32x4 __attribute__((ext_vector_type(4)));
constexpr int BM = 256, BK = 64, HALF = 128, HTB = HALF * BK * 2  , STAGE_BYTES = 8 * HTB, NXCD = 8, WGM = 8;

__host__ __device__ __forceinline__ int lds_byte(int r, int c) { const int st = (r >> 4) * 2 + (c >> 5), rr = r & 15, cc = c & 31, ob = rr * 64 + cc * 2; return st * 1024 + (ob ^ (((ob >> 9) & 1) << 5)); }
__host__ __device__ __forceinline__ void stage_rc(int b, int& R, int& C) { const int st = b / 1024, sb = b % 1024, swz = sb ^ (((sb >> 9) & 1) << 5); R = (st >> 1) * 16 + swz / 64; C = (st & 1) * 32 + (swz % 64) / 2; }
__host__ __device__ __forceinline__ int perm32(int rho) { const int n = rho >> 4, i = rho & 15; return 8 * (i >> 2) + 4 * n + (i & 3); }

struct Unit { int pm, pn; };
struct Gemm { const bf16_t* A; const bf16_t* Bt; int M, N, K; };

struct StaticOrder {
    int nM, nN, nwg, G, c;
    __host__ __device__ void init(int M, int N, int G_, int c_) { nM = M / BM; nN = N / BM; nwg = nM * nN; G = G_; c = c_; }
    __host__ __device__ bool next(int i, Unit& u) const {
        const long L = (long)i * G + c; if (L >= nwg) return false;
        int wgid = (int)L; { const int q = nwg / NXCD, r = nwg % NXCD, xcd = wgid % NXCD, off = wgid / NXCD; wgid = (xcd < r ? xcd * (q + 1) : r * (q + 1) + (xcd - r) * q) + off; }
        const int nig = WGM * nN, gid = wgid / nig, fm = gid * WGM, gsz = (nM - fm) < WGM ? (nM - fm) : WGM;
        u.pm = fm + ((wgid % nig) % gsz); u.pn = (wgid % nig) / gsz; return true;
    }
    __device__ __forceinline__ void a_ready(const Unit&) const {}
    __device__ __forceinline__ void done(const Unit&) const {}
};

__device__ __forceinline__ unsigned cvt_pk_bf16(float lo, float hi) { unsigned r; asm volatile("v_cvt_pk_bf16_f32 %0, %1, %2" : "=v"(r) : "v"(lo), "v"(hi)); return r; }
typedef float f32x2 __attribute__((ext_vector_type(2)));
constexpr float RMS_EPS_F = 1e-6f;
__device__ __forceinline__ void load_rstd(const float* ssq, int row0, int fq, float (&rs)[2][4]) {
#pragma unroll
    for (int ai = 0; ai < 2; ++ai)
#pragma unroll
        for (int m = 0; m < 4; ++m) {
            const f32x4* p = (const f32x4*)(ssq + (size_t)(row0 + ai * HALF + m * 16) * 32 + fq * 8);
            const f32x4 a = p[0], b = p[1];
            float s = ((a[0] + a[1]) + (a[2] + a[3])) + ((b[0] + b[1]) + (b[2] + b[3]));
            s += __shfl_xor(s, 16); s += __shfl_xor(s, 32);
            rs[ai][m] = __builtin_amdgcn_rsqf(s * (1.0f / 2048.0f) + RMS_EPS_F);
        }
}
__device__ __forceinline__ float sigmoid_f(float x) { return __builtin_amdgcn_rcpf(1.0f + __builtin_amdgcn_exp2f(-1.4426950408889634f * x)); }

struct EpiSwiGLU {
    static constexpr bool PERM = true, AFTER_DRAIN = false;
    bf16_t* act; const float* ssq; int ldc;
    __device__ __forceinline__ void operator()(const f32x4 (&acc)[2][2][4][2], const Unit& u, int wr, int wc, int fr, int fq) const {
        const int row0 = u.pm * BM + wr * 64 + fr, col0 = u.pn * HALF + wc * 32 + 8 * fq;
        float rs[2][4]; load_rstd(ssq, row0, fq, rs);
#pragma unroll
        for (int ai = 0; ai < 2; ++ai)
#pragma unroll
            for (int m = 0; m < 4; ++m) {
                const float s = rs[ai][m]; float v[8];
#pragma unroll
                for (int n = 0; n < 2; ++n)
#pragma unroll
                    for (int j = 0; j < 4; ++j) { const float g = acc[ai][0][m][n][j] * s, up = acc[ai][1][m][n][j] * s; v[n * 4 + j] = g * sigmoid_f(g) * up; }
                u32x4 w; w.x = cvt_pk_bf16(v[0], v[1]); w.y = cvt_pk_bf16(v[2], v[3]); w.z = cvt_pk_bf16(v[4], v[5]); w.w = cvt_pk_bf16(v[6], v[7]);
                *(u32x4*)(act + (size_t)(row0 + ai * HALF + m * 16) * ldc + col0) = w;
            }
    }
};
struct EpiScaleBf16 {
    static constexpr bool PERM = true, AFTER_DRAIN = false;
    bf16_t* O; const float* ssq; int ldc;
    __device__ __forceinline__ void operator()(const f32x4 (&acc)[2][2][4][2], const Unit& u, int wr, int wc, int fr, int fq) const {
        const int row0 = u.pm * BM + wr * 64 + fr, col0 = u.pn * BM + wc * 32 + 8 * fq;
        float rs[2][4];
        if (ssq) load_rstd(ssq, row0, fq, rs);
        else {
#pragma unroll
            for (int ai = 0; ai < 2; ++ai)
#pragma unroll
                for (int m = 0; m < 4; ++m) rs[ai][m] = 1.0f; }
#pragma unroll
        for (int ai = 0; ai < 2; ++ai)
#pragma unroll
            for (int m = 0; m < 4; ++m) { const float s = rs[ai][m]; bf16_t* rowp = O + (size_t)(row0 + ai * HALF + m * 16) * ldc + col0;
#pragma unroll
                for (int bj = 0; bj < 2; ++bj) { const f32x4 v0 = acc[ai][bj][m][0] * s, v1 = acc[ai][bj][m][1] * s;
                    u32x4 w; w.x = cvt_pk_bf16(v0[0], v0[1]); w.y = cvt_pk_bf16(v0[2], v0[3]); w.z = cvt_pk_bf16(v1[0], v1[1]); w.w = cvt_pk_bf16(v1[2], v1[3]);
                    *(u32x4*)(rowp + bj * HALF) = w; } }
    }
};
template <int MODE> struct EpiResid {
    static constexpr bool PERM = true, AFTER_DRAIN = false;
    float* h; bf16_t* hb; float* ssq_out; float alpha; const float* ssq_in; const bf16_t* pp;
    __device__ __forceinline__ void operator()(const f32x4 (&acc)[2][2][4][2], const Unit& u, int wr, int wc, int fr, int fq) const {
        const int row0 = u.pm * BM + wr * 64 + fr, col0 = u.pn * BM + wc * 32 + 8 * fq;
        float rs[2][4];
        if (MODE == 1) load_rstd(ssq_in, row0, fq, rs);
#pragma unroll
        for (int ai = 0; ai < 2; ++ai)
#pragma unroll
            for (int m = 0; m < 4; ++m) {
                const int r = row0 + ai * HALF + m * 16; float q = 0.f;
#pragma unroll
                for (int bj = 0; bj < 2; ++bj) {
                    const size_t off = (size_t)r * 2048 + col0 + bj * HALF;
                    f32x4 a = *(const f32x4*)(h + off), b = *(const f32x4*)(h + off + 4);
                    if (MODE == 0) { a += acc[ai][bj][m][0] * alpha; b += acc[ai][bj][m][1] * alpha; }
                    else {
                        const u32x4 pw = *(const u32x4*)(pp + off); const float s = rs[ai][m];
#pragma unroll
                        for (int j = 0; j < 4; ++j) {
                            const unsigned w0 = pw[j >> 1], w1 = pw[2 + (j >> 1)];
                            const float p0 = __uint_as_float((j & 1) ? (w0 & 0xffff0000u) : (w0 << 16)), p1 = __uint_as_float((j & 1) ? (w1 & 0xffff0000u) : (w1 << 16));
                            a[j] += sigmoid_f(acc[ai][bj][m][0][j] * s) * p0; b[j] += sigmoid_f(acc[ai][bj][m][1][j] * s) * p1; }
                    }
                    *(f32x4*)(h + off) = a; *(f32x4*)(h + off + 4) = b;
                    u32x4 w; w.x = cvt_pk_bf16(a[0], a[1]); w.y = cvt_pk_bf16(a[2], a[3]); w.z = cvt_pk_bf16(b[0], b[1]); w.w = cvt_pk_bf16(b[2], b[3]);
                    *(u32x4*)(hb + off) = w;
                    q += ((a[0] * a[0] + a[1] * a[1]) + (a[2] * a[2] + a[3] * a[3])) + ((b[0] * b[0] + b[1] * b[1]) + (b[2] * b[2] + b[3] * b[3]));
                }
                q += __shfl_xor(q, 16); q += __shfl_xor(q, 32);
                if (fq == 0) ssq_out[(size_t)r * 32 + u.pn * 4 + wc] = q;
            }
    }
};

template <class Epi, class Sched, bool ALIGN_EPI = false, bool SP2 = false>
__device__ __forceinline__ void gemm_phase(PG8_LAS unsigned char* lds, const Gemm g, const Sched& S, const Epi& E) {
    int tid_ = threadIdx.x; asm volatile("" : "+v"(tid_));
    const int tid = tid_, wid = __builtin_amdgcn_readfirstlane(tid >> 6), lane = tid & 63, wr = wid >> 2, wc = wid & 3, fr = lane & 15, fq = lane >> 4;
    const int K = g.K, nt = K / BK;
    unsigned voffA[2], voffB[2];
#pragma unroll
    for (int i = 0; i < 2; ++i) { int R, C; stage_rc(tid * 16 + i * 8192, R, C); const int Rb = Epi::PERM ? ((R & ~31) + perm32(R & 31)) : R;
        voffA[i] = (unsigned)(R * K + C) * 2u; voffB[i] = (unsigned)(Rb * K + C) * 2u; }
    const size_t kstep = (size_t)(BK * 2);
    const size_t hstep = (size_t)HALF * K * 2;
    const size_t tstep = 2 * hstep;
    const unsigned ldsw = (unsigned)wid * 1024u;
    const int aoff = lds_byte(wr * 64 + fr, fq * 8), boff = lds_byte(wc * 32 + fr, fq * 8);
#define PG8_SA(b, h) (((b) * 2 + (h)) * HTB)
#define PG8_SB(b, h) ((4 + (b) * 2 + (h)) * HTB)
#define PG8_STAGE(bufoff, gbase, voff) do { _Pragma("unroll") for (int _i = 0; _i < 2; ++_i) \
        __builtin_amdgcn_global_load_lds((const unsigned*)((const char*)(gbase) + (voff)[_i]), (PG8_LAS unsigned*)(lds + (bufoff) + ldsw + _i * 8192), 16, 0, 0); } while (0)
#define PG8_LDA(dst, b, h) do { _Pragma("unroll") for (int m = 0; m < 4; ++m) _Pragma("unroll") for (int k = 0; k < 2; ++k) dst[m][k] = *(const PG8_LAS bf16x8*)(lds + PG8_SA(b, h) + aoff + m * 2048 + k * 1024); } while (0)
#define PG8_LDB(dst, b, h) do { _Pragma("unroll") for (int n = 0; n < 2; ++n) _Pragma("unroll") for (int k = 0; k < 2; ++k) dst[n][k] = *(const PG8_LAS bf16x8*)(lds + PG8_SB(b, h) + boff + n * 2048 + k * 1024); } while (0)
#define PG8_MMA(ai, bj, At, Bt) do { __builtin_amdgcn_s_setprio(1); _Pragma("unroll") for (int m = 0; m < 4; ++m) _Pragma("unroll") for (int n = 0; n < 2; ++n) _Pragma("unroll") for (int k = 0; k < 2; ++k) \
        acc[ai][bj][m][n] = __builtin_amdgcn_mfma_f32_16x16x32_bf16(Bt[n][k], At[m][k], acc[ai][bj][m][n], 0, 0, 0); __builtin_amdgcn_s_setprio(0); } while (0)
#define PG8_WAIT_V(n) asm volatile("s_waitcnt vmcnt(" #n ")" ::: "memory")
#define PG8_WAIT_L(n) asm volatile("s_waitcnt lgkmcnt(" #n ")" ::: "memory")
#define PG8_BAR __builtin_amdgcn_s_barrier()
#define PG8_SCHED __builtin_amdgcn_sched_barrier(0)
    Unit cur, nxt; int ui = 0;
    if (!S.next(0, cur)) return;
    f32x4 acc[2][2][4][2];
#pragma unroll
    for (int a = 0; a < 2; ++a)
#pragma unroll
        for (int b = 0; b < 2; ++b)
#pragma unroll
            for (int m = 0; m < 4; ++m)
#pragma unroll
                for (int n = 0; n < 2; ++n) acc[a][b][m][n] = (f32x4){0.f, 0.f, 0.f, 0.f};
    bf16x8 At[4][2], B0[2][2], B1[2][2];
    const char* cA = (const char*)g.A + (size_t)cur.pm * tstep; const char* cB = (const char*)g.Bt + (size_t)cur.pn * tstep;
    S.a_ready(cur);
    if constexpr (SP2) {
        PG8_STAGE(PG8_SB(0, 0), cB, voffB); PG8_STAGE(PG8_SB(0, 1), cB + hstep, voffB); PG8_STAGE(PG8_SA(0, 0), cA, voffA); PG8_STAGE(PG8_SA(0, 1), cA + hstep, voffA);
        if (wr == 1) PG8_BAR;
        PG8_WAIT_V(2); PG8_BAR;
        PG8_STAGE(PG8_SB(1, 0), cB + kstep, voffB); PG8_STAGE(PG8_SA(1, 0), cA + kstep, voffA); PG8_STAGE(PG8_SB(1, 1), cB + hstep + kstep, voffB);
        PG8_WAIT_V(6); PG8_BAR;
    } else {
        PG8_STAGE(PG8_SB(0, 0), cB, voffB); PG8_STAGE(PG8_SA(0, 0), cA, voffA); PG8_STAGE(PG8_SB(0, 1), cB + hstep, voffB); PG8_STAGE(PG8_SA(0, 1), cA + hstep, voffA);
        if (wr == 1) PG8_BAR;
        PG8_WAIT_V(4); PG8_BAR;
        PG8_STAGE(PG8_SB(1, 0), cB + kstep, voffB); PG8_STAGE(PG8_SA(1, 0), cA + kstep, voffA); PG8_STAGE(PG8_SB(1, 1), cB + hstep + kstep, voffB);
        PG8_WAIT_V(6); PG8_BAR;
    }
    for (;;) {
        const bool has_next = S.next(ui + 1, nxt);
        const char* nA = has_next ? (const char*)g.A + (size_t)nxt.pm * tstep : cA; const char* nB = has_next ? (const char*)g.Bt + (size_t)nxt.pn * tstep : cB;
        for (int t = 0; t < nt; t += 2) {
            const bool last = (t == nt - 2);
            const char* a1 = cA + (size_t)(t + 1) * kstep;
            const char* a2 = last ? nA : cA + (size_t)(t + 2) * kstep; const char* b2 = last ? nB : cB + (size_t)(t + 2) * kstep;
            const char* a3 = a2 + kstep; const char* b3 = b2 + kstep;
            if (last && has_next) S.a_ready(nxt);
            if constexpr (SP2) {
            PG8_LDB(B0, 0, 0); PG8_LDB(B1, 0, 1); PG8_SCHED; PG8_LDA(At, 0, 0); PG8_STAGE(PG8_SA(1, 1), a1 + hstep, voffA);
            PG8_WAIT_V(8); PG8_WAIT_L(0); PG8_BAR; PG8_MMA(0, 0, At, B0); PG8_MMA(0, 1, At, B1); PG8_BAR; PG8_SCHED;
            PG8_LDA(At, 0, 1); PG8_STAGE(PG8_SB(0, 0), b2, voffB); PG8_STAGE(PG8_SB(0, 1), b2 + hstep, voffB); PG8_STAGE(PG8_SA(0, 0), a2, voffA);
            PG8_WAIT_V(8); PG8_WAIT_L(0); PG8_BAR; PG8_MMA(1, 0, At, B0); PG8_MMA(1, 1, At, B1); PG8_BAR; PG8_SCHED;
            PG8_LDB(B0, 1, 0); PG8_LDB(B1, 1, 1); PG8_SCHED; PG8_LDA(At, 1, 0); PG8_STAGE(PG8_SA(0, 1), a2 + hstep, voffA);
            PG8_WAIT_V(8); PG8_WAIT_L(0); PG8_BAR; PG8_MMA(0, 0, At, B0); PG8_MMA(0, 1, At, B1); PG8_BAR; PG8_SCHED;
            PG8_LDA(At, 1, 1); PG8_STAGE(PG8_SB(1, 0), b3, voffB); PG8_STAGE(PG8_SB(1, 1), b3 + hstep, voffB); PG8_STAGE(PG8_SA(1, 0), a3, voffA);
            PG8_WAIT_V(8); PG8_WAIT_L(0); PG8_BAR; PG8_MMA(1, 0, At, B0); PG8_MMA(1, 1, At, B1); PG8_BAR; PG8_SCHED;
            } else {
            PG8_LDB(B0, 0, 0); PG8_SCHED; PG8_LDA(At, 0, 0); PG8_STAGE(PG8_SA(1, 1), a1 + hstep, voffA);
            PG8_WAIT_L(8); PG8_BAR; PG8_WAIT_L(0); PG8_MMA(0, 0, At, B0); PG8_BAR; PG8_SCHED;
            PG8_LDB(B1, 0, 1); PG8_STAGE(PG8_SB(0, 0), b2, voffB);
            PG8_BAR; PG8_WAIT_L(0); PG8_MMA(0, 1, At, B1); PG8_BAR;
            PG8_LDA(At, 0, 1); PG8_STAGE(PG8_SA(0, 0), a2, voffA);
            PG8_BAR; PG8_WAIT_L(0); PG8_MMA(1, 0, At, B0); PG8_BAR; PG8_SCHED;
            PG8_STAGE(PG8_SB(0, 1), b2 + hstep, voffB);
            PG8_WAIT_V(6); PG8_BAR; PG8_MMA(1, 1, At, B1); PG8_BAR;
            PG8_LDB(B0, 1, 0); PG8_SCHED; PG8_LDA(At, 1, 0); PG8_STAGE(PG8_SA(0, 1), a2 + hstep, voffA);
            PG8_WAIT_L(8); PG8_BAR; PG8_WAIT_L(0); PG8_MMA(0, 0, At, B0); PG8_BAR; PG8_SCHED;
            PG8_LDB(B1, 1, 1); PG8_STAGE(PG8_SB(1, 0), b3, voffB);
            PG8_BAR; PG8_WAIT_L(0); PG8_MMA(0, 1, At, B1); PG8_BAR;
            PG8_LDA(At, 1, 1); PG8_STAGE(PG8_SA(1, 0), a3, voffA);
            PG8_BAR; PG8_WAIT_L(0); PG8_MMA(1, 0, At, B0); PG8_BAR; PG8_SCHED;
            PG8_STAGE(PG8_SB(1, 1), b3 + hstep, voffB);
            PG8_WAIT_V(6); PG8_BAR; PG8_MMA(1, 1, At, B1); PG8_BAR;
            }
        }
        if constexpr (ALIGN_EPI) { if (wr == 0) PG8_BAR; }
        if constexpr (!Epi::AFTER_DRAIN) { E(acc, cur, wr, wc, fr, fq); S.done(cur); }
        if (!has_next) break;
#pragma unroll
        for (int a = 0; a < 2; ++a)
#pragma unroll
            for (int b = 0; b < 2; ++b)
#pragma unroll
                for (int m = 0; m < 4; ++m)
#pragma unroll
                    for (int n = 0; n < 2; ++n) acc[a][b][m][n] = (f32x4){0.f, 0.f, 0.f, 0.f};
        cur = nxt; cA = nA; cB = nB; ++ui;
        if constexpr (ALIGN_EPI) { if (wr == 1) PG8_BAR; }
    }
    PG8_WAIT_V(0);
    if constexpr (!ALIGN_EPI) { if (wr == 0) PG8_BAR; }
    PG8_BAR;
    if constexpr (Epi::AFTER_DRAIN) { E.fused(acc, cur, wr, wc, fr, fq, lds, wid, lane); S.done(cur); }
#undef PG8_SA
#undef PG8_SB
#undef PG8_STAGE
#undef PG8_LDA
#undef PG8_LDB
#undef PG8_MMA
#undef PG8_WAIT_V
#undef PG8_WAIT_L
#undef PG8_BAR
#undef PG8_SCHED
}
}

constexpr int NBATCH = 4, T = 2048, D = 2048, M = NBATCH * T, DEPTH = 4, DFF = 5632, NUP = 2 * DFF, NIN = 6144, DIN = 6152, DPLE = 256;
constexpr int NH = 4, HD = 128, DKM = 128, DVM = 256, NBH = NBATCH * NH;
constexpr int ZQA = 0, ZKA = 512, ZVA = 1024, ZQC = 1536, ZKC = 2048, ZVC = 2560, ZQKM = 3072, ZVM = 4096, ZOM = 5120;
constexpr float RMS_EPS = 1e-6f, LOG2E = 1.4426950408889634f;
constexpr int NWAVES = 8;

constexpr size_t MiB = 1u << 20;
constexpr size_t WS_CTL = 0, CTL_ZERO_BYTES = 1 * MiB;
constexpr size_t WS_W = 2 * MiB, LW_UP1 = 0, LW_DN1 = 44 * MiB, LW_IN = 66 * MiB, LW_OUT = 90 * MiB, LW_UP2 = 98 * MiB, LW_DN2 = 142 * MiB, LW_G = 164 * MiB, LW_P = 172 * MiB, LW_STRIDE = 174 * MiB;
constexpr size_t WS_HB0 = 700 * MiB, WS_HB1 = 732 * MiB, WS_SSQ0 = 764 * MiB, WS_SSQ1 = 765 * MiB, WS_GATES = 766 * MiB, WS_BCUM = 767 * MiB;
constexpr size_t WS_ACT = 768 * MiB, WS_Z = 856 * MiB, WS_MIXED = 952 * MiB, WS_PP = 984 * MiB, WS_PB = 1016 * MiB;
constexpr size_t WS_QC = 1032 * MiB, WS_KC = 1040 * MiB, WS_KMEAN = 1048 * MiB, WS_END = 1056 * MiB;
static_assert(WS_W + 4 * LW_STRIDE <= WS_HB0 && WS_ACT + (size_t)M * DFF * 2 <= WS_Z && WS_Z + (size_t)M * NIN * 2 <= WS_MIXED, "d_ws map");
constexpr int CW_BAR = 4096;

constexpr int RING_OFF = 0, RING_BYTES = 131072;
constexpr int SCR_BYTES = 8 * 16640;
constexpr int LDSCTL_OFF = SCR_BYTES, MISC_OFF = LDSCTL_OFF + 320;
constexpr int LDS_BYTES = 147456;
static_assert(MISC_OFF + 128 <= LDS_BYTES && SCR_BYTES >= RING_BYTES, "LDS map");

#define GAS __attribute__((address_space(1)))
#define LAS __attribute__((address_space(3)))
typedef unsigned short bf16;
typedef unsigned v4u __attribute__((ext_vector_type(4)));
typedef unsigned v2u __attribute__((ext_vector_type(2)));
typedef float f32x4 __attribute__((ext_vector_type(4)));
typedef GAS unsigned gu32;
#define RLX_AGENT __ATOMIC_RELAXED, __HIP_MEMORY_SCOPE_AGENT
#define LDS_WAIT() asm volatile("s_waitcnt lgkmcnt(0)" ::: "memory")
#define VM_WAIT() asm volatile("s_waitcnt vmcnt(0)" ::: "memory")
__device__ __forceinline__ unsigned f2bf(float f) { unsigned u = __builtin_bit_cast(unsigned, f); return (u + 0x7fffu + ((u >> 16) & 1u)) >> 16; }
__device__ __forceinline__ unsigned pk2(float lo, float hi) { return f2bf(lo) | (f2bf(hi) << 16); }
__device__ __forceinline__ float bflo(unsigned w) { return __uint_as_float(w << 16); }
__device__ __forceinline__ float bfhi(unsigned w) { return __uint_as_float(w & 0xffff0000u); }
__device__ __forceinline__ float bf2f(bf16 b) { return __uint_as_float(((unsigned)b) << 16); }

#define XB_TMO      128
#define XB_XCNT(j)  (256  + 64 * (j))
#define XB_XSUB(j)  (1280 + 64 * (j))
#define XB_XGEN(j)  (2304 + 64 * (j))
#define XB_TOP      3328
#define XB_TOPGEN   3392
#define XCD_BAR_WORDS 3456
#define XB_SPIN_CAP (1u << 18)

__device__ __forceinline__ unsigned xb_ld(unsigned* p)              { return __hip_atomic_load(p, __ATOMIC_RELAXED, __HIP_MEMORY_SCOPE_AGENT); }
__device__ __forceinline__ unsigned xb_add(unsigned* p, unsigned v) { return __hip_atomic_fetch_add(p, v, __ATOMIC_RELAXED, __HIP_MEMORY_SCOPE_AGENT); }
__device__ __forceinline__ unsigned xb_xcc_id() { return (unsigned)__builtin_amdgcn_s_getreg((3 << 11) | 20) & 0xFu; }
#define XB_SPIN(cond, bar) do { unsigned _sp = 0; while (cond) { __builtin_amdgcn_s_sleep(1); \
    if ((++_sp & 255u) == 0u) { if (xb_ld(&(bar)[XB_TMO])) break; if (_sp > XB_SPIN_CAP) { atomicAdd(&(bar)[XB_TMO], 1u); break; } } } } while (0)

struct XcdBarrier {
    unsigned* bar; unsigned x;
    volatile LAS unsigned* st;
};

__device__ __forceinline__ XcdBarrier xcd_barrier_post(unsigned* bar, volatile LAS unsigned* st) {
    XcdBarrier b; b.bar = bar; b.x = xb_xcc_id(); b.st = st;
    if (threadIdx.x == 0) (void)xb_add(&bar[XB_XCNT(b.x)], 1u);
    return b;
}
__device__ __forceinline__ void xcd_barrier_complete(unsigned* bar, unsigned x, unsigned& nloc, unsigned& nx) {
    const unsigned G = gridDim.x * gridDim.y * gridDim.z;
    unsigned sum, cnt, mine, sp = 0u;
    for (;;) {
        sum = 0u; cnt = 0u; mine = 0u;
#pragma unroll
        for (unsigned j = 0; j < 16; ++j) { const unsigned c = xb_ld(&bar[XB_XCNT(j)]); sum += c; cnt += (c > 0u) ? 1u : 0u; mine = (j == x) ? c : mine; }
        if (sum == G) break;
        __builtin_amdgcn_s_sleep(1);
        if ((++sp & 255u) == 0u) { if (xb_ld(&bar[XB_TMO])) break; if (sp > XB_SPIN_CAP) { atomicAdd(&bar[XB_TMO], 1u); break; } }
    }
    nloc = mine > 0u ? mine : 1u; nx = cnt > 0u ? cnt : 1u;
}

__device__ __forceinline__ void xcd_barrier(const XcdBarrier& b) {
    asm volatile("s_waitcnt vmcnt(0)" ::: "memory");
    __syncthreads();
    if (threadIdx.x == 0) {
        unsigned* bar = b.bar;
        __builtin_amdgcn_s_waitcnt(0);
        unsigned nloc = b.st[0], nx = b.st[1];
        if (nloc == 0u) { xcd_barrier_complete(bar, b.x, nloc, nx); b.st[0] = nloc; b.st[1] = nx; }
        const unsigned old = xb_add(&bar[XB_XSUB(b.x)], 1u);
        const unsigned gen = old / nloc;
        if (old + 1u == (gen + 1u) * nloc) {
            __builtin_amdgcn_fence(__ATOMIC_RELEASE, "agent");
            asm volatile("s_waitcnt vmcnt(0)" ::: "memory");
            const unsigned og = xb_add(&bar[XB_TOP], 1u);
            const unsigned tg = og / nx;
            if (og + 1u == (tg + 1u) * nx) xb_add(&bar[XB_TOPGEN], 1u);
            else XB_SPIN(xb_ld(&bar[XB_TOPGEN]) == tg, bar);
            __builtin_amdgcn_fence(__ATOMIC_ACQUIRE, "agent");
            xb_add(&bar[XB_XGEN(b.x)], 1u);
            asm volatile("s_waitcnt vmcnt(0)" ::: "memory");
        } else {
            XB_SPIN(xb_ld(&bar[XB_XGEN(b.x)]) == gen, bar);
            __builtin_amdgcn_fence(__ATOMIC_ACQUIRE, "agent");
            asm volatile("s_waitcnt vmcnt(0)" ::: "memory");
        }
    }
    __syncthreads();
}


struct Args { const float* in[20]; float* out; unsigned char* ws; int ph_lo, ph_hi; };
struct Frame {
    LAS unsigned char* lds;
    volatile LAS unsigned* MISC;
    gu32* ctl;
    int tid, lane, wave;
    int vcu, G;
    float* out; unsigned char* ws;
};
__device__ __forceinline__ float wave_sum(float v) {
#pragma unroll
    for (int o = 1; o < 64; o <<= 1) v += __shfl_xor(v, o);
    return v;
}
__device__ __forceinline__ float wave_max(float v) {
#pragma unroll
    for (int o = 1; o < 64; o <<= 1) v = fmaxf(v, __shfl_xor(v, o));
    return v;
}
__device__ __forceinline__ bf16* wptr(Frame& F, int layer, size_t off) { return (bf16*)(F.ws + WS_W + (size_t)layer * LW_STRIDE + off); }
#define WPTR(off) ((bf16*)(ws + WS_W + (size_t)L * LW_STRIDE + (off)))

#define OPAQUE_TID(F) do { int t_ = threadIdx.x; asm volatile("" : "+v"(t_)); (F).tid = t_; (F).lane = t_ & 63; (F).wave = __builtin_amdgcn_readfirstlane(t_ >> 6); } while (0)
__device__ __forceinline__ void p0_transpose_item(const float* W, int K, int ldn, const float* g, bf16* WT, int upmap, LAS float* scr, int item, int nblk, int lane) {
    const int kb = item / nblk, nb = item - kb * nblk, k0 = 64 * kb, n0 = 64 * nb;
    const int kq = lane >> 4, nc = (lane & 15) * 4;
    f32x4 v[16];
    const float* src = W + (size_t)(k0 + kq) * ldn + n0 + nc;
#pragma unroll
    for (int i = 0; i < 16; ++i) v[i] = *(const GAS f32x4*)(src + (size_t)(4 * i) * ldn);
#pragma unroll
    for (int i = 0; i < 16; ++i) { LAS float* d = scr + (4 * i + kq) * 65 + nc; d[0] = v[i][0]; d[1] = v[i][1]; d[2] = v[i][2]; d[3] = v[i][3]; }
    int drow0 = n0;
    if (upmap) { const int bj = n0 / DFF, j = n0 - bj * DFF; drow0 = 256 * (j >> 7) + 128 * bj + (j & 127); }
    const int c = lane & 7;
    f32x4 g0 = (f32x4){1.f, 1.f, 1.f, 1.f}, g1 = g0;
    if (g) { g0 = *(const GAS f32x4*)(g + k0 + 8 * c); g1 = *(const GAS f32x4*)(g + k0 + 8 * c + 4); }
    LDS_WAIT(); asm volatile("" ::: "memory");
#pragma unroll
    for (int j = 0; j < 8; ++j) { const int n = (lane >> 3) + 8 * j; const LAS float* s = scr + (8 * c) * 65 + n;
        v4u o; o.x = pk2(s[0 * 65] * g0[0], s[1 * 65] * g0[1]); o.y = pk2(s[2 * 65] * g0[2], s[3 * 65] * g0[3]); o.z = pk2(s[4 * 65] * g1[0], s[5 * 65] * g1[1]); o.w = pk2(s[6 * 65] * g1[2], s[7 * 65] * g1[3]);
        *(GAS v4u*)(WT + (size_t)(drow0 + n) * K + k0 + 8 * c) = o; }
    LDS_WAIT(); asm volatile("" ::: "memory");
}
__device__ __forceinline__ void p0_prologue(Frame& F, const Args& A) {
    OPAQUE_TID(F);
    LAS float* scr = (LAS float*)(F.lds + F.wave * 16640);
    const int gw = F.vcu * NWAVES + F.wave, NGW = F.G * NWAVES;
    constexpr int I_UP = (D / 64) * (NUP / 64), I_DN = (DFF / 64) * (D / 64), I_IN = (D / 64) * (NIN / 64), I_SQ = (D / 64) * (D / 64), I_P = (DPLE / 64) * (D / 64);
    constexpr int I_LAYER = 2 * I_UP + 2 * I_DN + I_IN + 2 * I_SQ + I_P;
    for (int it = gw; it < DEPTH * I_LAYER; it += NGW) {
        const int l = it / I_LAYER; int r = it - l * I_LAYER;
        if (r < I_UP) { p0_transpose_item(A.in[3] + (size_t)l * D * NUP, D, NUP, A.in[2] + l * D, wptr(F, l, LW_UP1), 1, scr, r, NUP / 64, F.lane); continue; } r -= I_UP;
        if (r < I_DN) { p0_transpose_item(A.in[4] + (size_t)l * DFF * D, DFF, D, nullptr, wptr(F, l, LW_DN1), 0, scr, r, D / 64, F.lane); continue; } r -= I_DN;
        if (r < I_IN) { p0_transpose_item(A.in[6] + (size_t)l * D * DIN, D, DIN, A.in[5] + l * D, wptr(F, l, LW_IN), 0, scr, r, NIN / 64, F.lane); continue; } r -= I_IN;
        if (r < I_SQ) { p0_transpose_item(A.in[12] + (size_t)l * D * D, D, D, nullptr, wptr(F, l, LW_OUT), 0, scr, r, D / 64, F.lane); continue; } r -= I_SQ;
        if (r < I_UP) { p0_transpose_item(A.in[14] + (size_t)l * D * NUP, D, NUP, A.in[13] + l * D, wptr(F, l, LW_UP2), 1, scr, r, NUP / 64, F.lane); continue; } r -= I_UP;
        if (r < I_DN) { p0_transpose_item(A.in[15] + (size_t)l * DFF * D, DFF, D, nullptr, wptr(F, l, LW_DN2), 0, scr, r, D / 64, F.lane); continue; } r -= I_DN;
        if (r < I_SQ) { p0_transpose_item(A.in[17] + (size_t)l * D * D, D, D, A.in[16] + l * D, wptr(F, l, LW_G), 0, scr, r, D / 64, F.lane); continue; } r -= I_SQ;
        p0_transpose_item(A.in[18] + (size_t)l * DPLE * D, DPLE, D, nullptr, wptr(F, l, LW_P), 0, scr, r, D / 64, F.lane);
    }
    bf16* hb = (bf16*)(F.ws + WS_HB0); float* ssq = (float*)(F.ws + WS_SSQ0);
    for (int m = gw; m < M; m += NGW) {
        const GAS f32x4* xr = (const GAS f32x4*)(A.in[0] + (size_t)m * D) + F.lane; GAS f32x4* hr = (GAS f32x4*)(F.out + (size_t)m * D) + F.lane;
        GAS v2u* br = (GAS v2u*)(hb + (size_t)m * D) + F.lane; float s = 0.f;
#pragma unroll
        for (int j = 0; j < 8; ++j) { const f32x4 v = xr[64 * j]; hr[64 * j] = v; v2u o; o.x = pk2(v[0], v[1]); o.y = pk2(v[2], v[3]); br[64 * j] = o; s += (v[0] * v[0] + v[1] * v[1]) + (v[2] * v[2] + v[3] * v[3]); }
        s = wave_sum(s);
        if (F.lane < 32) ssq[(size_t)m * 32 + F.lane] = F.lane == 0 ? s : 0.f;
    }
    { const size_t n8 = (size_t)DEPTH * M * DPLE / 8; const float* p = A.in[1]; bf16* pb = (bf16*)(F.ws + WS_PB);
      for (size_t i = (size_t)gw * 64 + F.lane; i < n8; i += (size_t)NGW * 64) { const f32x4 a = *(const GAS f32x4*)(p + i * 8), b = *(const GAS f32x4*)(p + i * 8 + 4);
          v4u o; o.x = pk2(a[0], a[1]); o.y = pk2(a[2], a[3]); o.z = pk2(b[0], b[1]); o.w = pk2(b[2], b[3]); *(GAS v4u*)(pb + i * 8) = o; } }
}

__device__ __forceinline__ void gates_phase(Frame& F, const Args& A, int layer, const float* ssq) {
    OPAQUE_TID(F);
    const float* w = A.in[6] + (size_t)layer * D * DIN + NIN; const float* g = A.in[5] + layer * D; float* gates = (float*)(F.ws + WS_GATES);
    const int sub = F.tid & 15, rl = F.tid >> 4;
    for (int rg = F.vcu; rg < M / 32; rg += F.G) {
        const int row = rg * 32 + rl; const float* hr = F.out + (size_t)row * D + sub * 128; const float* gr = g + sub * 128; const float* wr_ = w + (size_t)(sub * 128) * DIN;
        float a[8];
#pragma unroll
        for (int j = 0; j < 8; ++j) a[j] = 0.f;
        for (int k4 = 0; k4 < 32; ++k4) {
            const f32x4 hv = *(const GAS f32x4*)(hr + 4 * k4), gv = *(const GAS f32x4*)(gr + 4 * k4);
#pragma unroll
            for (int e = 0; e < 4; ++e) { const float x = hv[e] * gv[e]; const f32x4 w0 = *(const GAS f32x4*)(wr_ + (size_t)(4 * k4 + e) * DIN), w1 = *(const GAS f32x4*)(wr_ + (size_t)(4 * k4 + e) * DIN + 4);
#pragma unroll
                for (int j = 0; j < 4; ++j) { a[j] += x * w0[j]; a[4 + j] += x * w1[j]; } }
        }
#pragma unroll
        for (int j = 0; j < 8; ++j) { a[j] += __shfl_xor(a[j], 1); a[j] += __shfl_xor(a[j], 2); a[j] += __shfl_xor(a[j], 4); a[j] += __shfl_xor(a[j], 8); }
        if (sub == 0) {
            float s = 0.f;
            for (int j = 0; j < 32; ++j) s += ssq[(size_t)row * 32 + j];
            const float rstd = 1.0f / sqrtf(s * (1.0f / D) + RMS_EPS);
#pragma unroll
            for (int j = 0; j < 4; ++j) { gates[(size_t)row * 8 + j] = a[j] * rstd + A.in[9][layer * 4 + j]; gates[(size_t)row * 8 + 4 + j] = a[4 + j] * rstd + A.in[10][layer * 4 + j]; }
        }
    }
}

__device__ __forceinline__ void naive_prep(Frame& F, const Args& A, int layer) {
    OPAQUE_TID(F);
    const bf16* z = (const bf16*)(F.ws + WS_Z); const float* gates = (const float*)(F.ws + WS_GATES);
    bf16* qc = (bf16*)(F.ws + WS_QC); bf16* kc = (bf16*)(F.ws + WS_KC); float* kmean = (float*)(F.ws + WS_KMEAN); float* bcum = (float*)(F.ws + WS_BCUM);
    const float* cw = A.in[7] + (size_t)layer * 4 * 1024; const float* cb = A.in[8] + (size_t)layer * 1024;
    const size_t gt = (size_t)F.vcu * 512 + F.tid, NT = (size_t)F.G * 512;
    for (size_t i = gt; i < (size_t)M * 1024; i += NT) {
        const int row = (int)(i >> 10), c = (int)(i & 1023), t = row & (T - 1);
        float y = cb[c];
#pragma unroll
        for (int j = 0; j < 4; ++j) { const int tt = t - 3 + j; if (tt >= 0) y += cw[j * 1024 + c] * bf2f(z[(size_t)(row - 3 + j) * NIN + ZQKM + c]); }
        y = y / (1.0f + expf(-y));
        const int b = row >> 11, isk = c >> 9, hh = (c >> 7) & 3, d = c & 127;
        if (isk) kc[((size_t)(b * NH + hh) * T + t) * 128 + d] = (bf16)f2bf(y * 0.08838834764831845f); else qc[((size_t)(b * NH + hh) * T + t) * 128 + d] = (bf16)f2bf(y);
    }
    const int gw = F.vcu * NWAVES + F.wave, NGW = F.G * NWAVES;
    for (int it = gw; it < NBH * 8; it += NGW) {
        const int bh = it >> 3, blk = it & 7, b = bh >> 2, hh = bh & 3; float s0 = 0.f, s1 = 0.f;
        for (int k = 0; k < 256; ++k) { const unsigned w = *(const unsigned*)(z + (size_t)(b * T + blk * 256 + k) * NIN + ZKA + hh * 128 + 2 * F.lane); s0 += bflo(w); s1 += bfhi(w); }
        kmean[(size_t)it * 128 + 2 * F.lane] = s0 * (1.0f / 256.0f); kmean[(size_t)it * 128 + 2 * F.lane + 1] = s1 * (1.0f / 256.0f);
    }
    for (int bh = gw; bh < NBH; bh += NGW) {
        const int b = bh >> 2, hh = bh & 3; float carry = 0.f;
        for (int c = 0; c < T / 64; ++c) { const int t = c * 64 + F.lane; const float x = gates[(size_t)(b * T + t) * 8 + 4 + hh];
            float v = fminf(x, 0.f) - log1pf(expf(-fabsf(x)));
#pragma unroll
            for (int o = 1; o < 64; o <<= 1) { const float n = __shfl_up(v, o); if (F.lane >= o) v += n; }
            v += carry; bcum[(size_t)bh * T + t] = v; carry = __shfl(v, 63); }
    }
}
__device__ __forceinline__ float dot128(const LAS float* q, const bf16* krow) {
    float s = 0.f;
#pragma unroll 4
    for (int c = 0; c < 16; ++c) { const v4u kv = *(const GAS v4u*)(krow + 8 * c); const f32x4 qa = *(const LAS f32x4*)(q + 8 * c), qb = *(const LAS f32x4*)(q + 8 * c + 4);
        s += (qa[0] * bflo(kv.x) + qa[1] * bfhi(kv.x)) + (qa[2] * bflo(kv.y) + qa[3] * bfhi(kv.y)) + (qb[0] * bflo(kv.z) + qb[1] * bfhi(kv.z)) + (qb[2] * bflo(kv.w) + qb[3] * bfhi(kv.w)); }
    return s;
}
__device__ __forceinline__ void naive_mixers(Frame& F, const Args& A, int layer) {
    OPAQUE_TID(F);
    const bf16* z = (const bf16*)(F.ws + WS_Z); const float* gates = (const float*)(F.ws + WS_GATES); bf16* mixed = (bf16*)(F.ws + WS_MIXED);
    const bf16* qc = (const bf16*)(F.ws + WS_QC); const bf16* kc = (const bf16*)(F.ws + WS_KC); const float* kmean = (const float*)(F.ws + WS_KMEAN); const float* bcum = (const float*)(F.ws + WS_BCUM);
    LAS float* ql = (LAS float*)(F.lds + F.wave * 8704); LAS float* sc = ql + 128;
    const int gw = F.vcu * NWAVES + F.wave, NGW = F.G * NWAVES, lane = F.lane;
    const float scale = 0.08838834764831845f;
    for (int it = gw; it < 3 * NBH * T; it += NGW) {
        const int kind = it / (NBH * T), r = it - kind * (NBH * T), t = (T - 1) - (r / NBH), bh = r % NBH, b = bh >> 2, hh = bh & 3, row = b * T + t;
        LDS_WAIT(); asm volatile("" ::: "memory");
        if (kind == 0) {
            const float slope = exp2f(-(float)(2 * hh + 1));
            const unsigned qw = *(const unsigned*)(z + (size_t)row * NIN + ZQA + hh * 128 + 2 * lane); const float q0 = bflo(qw), q1 = bfhi(qw);
            ql[2 * lane] = q0; ql[2 * lane + 1] = q1;
            const int cur = t >> 8; float gt[8];
#pragma unroll
            for (int n = 0; n < 8; ++n) { const float* km = kmean + ((size_t)bh * 8 + n) * 128 + 2 * lane; const float v = wave_sum(q0 * km[0] + q1 * km[1]); gt[n] = n < cur ? v : -3.0e38f; }
            unsigned sel = 0u; const int nsel = cur < 3 ? cur : 3;
            for (int k = 0; k < nsel; ++k) { float best = -3.0e38f; int bi = -1;
#pragma unroll
                for (int n = 0; n < 8; ++n) { const bool ok = n < cur && !((sel >> n) & 1u) && (bi < 0 || gt[n] > best); if (ok) { best = gt[n]; bi = n; } }
                sel |= 1u << bi; }
            sel |= 1u << cur;
            LDS_WAIT(); asm volatile("" ::: "memory");
            float mx = -3.0e38f; int ns = 0;
            for (int blk = 0; blk <= cur; ++blk) { if (!((sel >> blk) & 1u)) continue;
                for (int i = 0; i < 4; ++i) { const int key = blk * 256 + lane + 64 * i; float s = -3.0e38f;
                    if (key <= t) s = scale * dot128(ql, z + (size_t)(b * T + key) * NIN + ZKA + hh * 128) - slope * (float)(t - key);
                    sc[ns * 256 + lane + 64 * i] = s; mx = fmaxf(mx, s); }
                ++ns; }
            mx = wave_max(mx); float sum = 0.f;
            for (int i = 0; i < ns * 4; ++i) { const float s = sc[lane + 64 * i]; const float p = s > -1.0e38f ? expf(s - mx) : 0.f; sc[lane + 64 * i] = p; sum += p; }
            sum = wave_sum(sum);
            LDS_WAIT(); asm volatile("" ::: "memory");
            float o0 = 0.f, o1 = 0.f; ns = 0;
            for (int blk = 0; blk <= cur; ++blk) { if (!((sel >> blk) & 1u)) continue;
                const int kend = blk == cur ? (t - blk * 256 + 1) : 256;
                for (int k = 0; k < kend; ++k) { const float p = sc[ns * 256 + k]; const unsigned vw = *(const unsigned*)(z + (size_t)(b * T + blk * 256 + k) * NIN + ZVA + hh * 128 + 2 * lane); o0 += p * bflo(vw); o1 += p * bfhi(vw); }
                ++ns; }
            const float inv = 1.0f / sum;
            *(unsigned*)(mixed + (size_t)row * D + hh * 128 + 2 * lane) = pk2(o0 * inv, o1 * inv);
        } else if (kind == 1) {
            const float slope = exp2f(-(float)(2 * hh + 2));
            const unsigned qw = *(const unsigned*)(z + (size_t)row * NIN + ZQC + hh * 128 + 2 * lane);
            ql[2 * lane] = bflo(qw); ql[2 * lane + 1] = bfhi(qw);
            LDS_WAIT(); asm volatile("" ::: "memory");
            float mx = -3.0e38f;
            for (int p = 0; p < 3; ++p) { const int dil = p == 0 ? 1 : (p == 1 ? 4 : 16);
                for (int i = 0; i < 3; ++i) { const int j = lane + 64 * i, key = t - j * dil; float s = -3.0e38f;
                    if (j <= 128 && key >= 0) s = scale * dot128(ql, z + (size_t)(b * T + key) * NIN + ZKC + hh * 128) - slope * (float)(j * dil);
                    sc[p * 192 + j] = s; mx = fmaxf(mx, s); } }
            mx = wave_max(mx); float sum = 0.f;
            for (int i = 0; i < 9; ++i) { const float s = sc[lane + 64 * i]; const float pr = s > -1.0e38f ? expf(s - mx) : 0.f; sc[lane + 64 * i] = pr; sum += pr; }
            sum = wave_sum(sum);
            LDS_WAIT(); asm volatile("" ::: "memory");
            float o0 = 0.f, o1 = 0.f;
            for (int p = 0; p < 3; ++p) { const int dil = p == 0 ? 1 : (p == 1 ? 4 : 16);
                for (int j = 0; j <= 128; ++j) { const int key = t - j * dil; if (key < 0) break; const float pr = sc[p * 192 + j];
                    const unsigned vw = *(const unsigned*)(z + (size_t)(b * T + key) * NIN + ZVC + hh * 128 + 2 * lane); o0 += pr * bflo(vw); o1 += pr * bfhi(vw); } }
            const float inv = 1.0f / sum;
            *(unsigned*)(mixed + (size_t)row * D + 1536 + hh * 128 + 2 * lane) = pk2(o0 * inv, o1 * inv);
        } else {
            const unsigned qw = *(const unsigned*)(qc + ((size_t)bh * T + t) * 128 + 2 * lane);
            ql[2 * lane] = bflo(qw); ql[2 * lane + 1] = bfhi(qw);
            const float Bt = bcum[(size_t)bh * T + t]; float mx = Bt;
            for (int s = lane; s <= t; s += 64) { const float d = Bt - bcum[(size_t)bh * T + s] + gates[(size_t)(b * T + s) * 8 + hh]; mx = fmaxf(mx, d); }
            mx = wave_max(mx);
            LDS_WAIT(); asm volatile("" ::: "memory");
            float den = 0.f;
            for (int s = lane; s <= t; s += 64) { const float d = Bt - bcum[(size_t)bh * T + s] + gates[(size_t)(b * T + s) * 8 + hh];
                const float S = dot128(ql, kc + ((size_t)bh * T + s) * 128) * expf(d - mx); sc[s] = S; den += S; }
            den = wave_sum(den);
            LDS_WAIT(); asm volatile("" ::: "memory");
            f32x4 num = (f32x4){0.f, 0.f, 0.f, 0.f};
            for (int s = 0; s <= t; ++s) { const float S = sc[s]; const v2u vw = *(const GAS v2u*)(z + (size_t)(b * T + s) * NIN + ZVM + hh * 256 + 4 * lane);
                num[0] += S * bflo(vw.x); num[1] += S * bfhi(vw.x); num[2] += S * bflo(vw.y); num[3] += S * bfhi(vw.y); }
            const float dn = fmaxf(fabsf(den), expf(-mx)); num = num * (1.0f / dn);
            const float ss = wave_sum((num[0] * num[0] + num[1] * num[1]) + (num[2] * num[2] + num[3] * num[3]));
            const float rn = 1.0f / sqrtf(ss * (1.0f / 256.0f) + RMS_EPS);
            const f32x4 gh = *(const GAS f32x4*)(A.in[11] + (size_t)layer * 1024 + hh * 256 + 4 * lane);
            const v2u ow = *(const GAS v2u*)(z + (size_t)row * NIN + ZOM + hh * 256 + 4 * lane);
            const float og[4] = {bflo(ow.x), bfhi(ow.x), bflo(ow.y), bfhi(ow.y)}; float r4[4];
#pragma unroll
            for (int e = 0; e < 4; ++e) r4[e] = num[e] * rn * gh[e] / (1.0f + expf(-og[e]));
            v2u o; o.x = pk2(r4[0], r4[1]); o.y = pk2(r4[2], r4[3]);
            *(GAS v2u*)(mixed + (size_t)row * D + 512 + hh * 256 + 4 * lane) = o;
        }
    }
}
__device__ __forceinline__ void final_norm(Frame& F, const Args& A) {
    OPAQUE_TID(F);
    const int gw = F.vcu * NWAVES + F.wave, NGW = F.G * NWAVES; const float* g = A.in[19];
    for (int m = gw; m < M; m += NGW) {
        GAS f32x4* hr = (GAS f32x4*)(F.out + (size_t)m * D) + F.lane; f32x4 v[8]; float s = 0.f;
#pragma unroll
        for (int j = 0; j < 8; ++j) { v[j] = hr[64 * j]; s += (v[j][0] * v[j][0] + v[j][1] * v[j][1]) + (v[j][2] * v[j][2] + v[j][3] * v[j][3]); }
        const float rstd = 1.0f / sqrtf(wave_sum(s) * (1.0f / D) + RMS_EPS);
#pragma unroll
        for (int j = 0; j < 8; ++j) { const f32x4 gv = *((const GAS f32x4*)g + F.lane + 64 * j); hr[64 * j] = v[j] * rstd * gv; }
    }
}

constexpr int N_PHASES = 2 + 10 * DEPTH;
__global__ void __launch_bounds__(NWAVES * 64, 2) mk_fwd(Args args) {
    extern __shared__ __attribute__((aligned(16))) unsigned char lds[];
    Frame F;
    F.lds = (LAS unsigned char*)lds;
    F.MISC = (volatile LAS unsigned*)(F.lds + MISC_OFF);
    F.tid = threadIdx.x; F.lane = F.tid & 63; F.wave = __builtin_amdgcn_readfirstlane(F.tid >> 6);
    F.G = gridDim.x; { const int bx = blockIdx.x; F.vcu = (F.G % 8 == 0) ? (bx % 8) * (F.G / 8) + bx / 8 : bx; }
    F.ws = args.ws; F.out = args.out; F.ctl = (gu32*)(args.ws + WS_CTL);
    for (int u = F.tid; u < (LDS_BYTES - LDSCTL_OFF) / 4; u += NWAVES * 64) ((LAS unsigned*)(F.lds + LDSCTL_OFF))[u] = 0u;
    __syncthreads();
    XcdBarrier bar = xcd_barrier_post((unsigned*)(F.ctl + CW_BAR), F.MISC + 8);
    const int lo = args.ph_lo, hi = args.ph_hi;
#define IN(k) (lo <= (k) && (k) < hi)
#define SEAM(k) do { if (IN((k) + 1)) xcd_barrier(bar); } while (0)
#define PH_BEGIN int L = layer; asm volatile("" : "+s"(L)); unsigned char* ws = args.ws; asm volatile("" : "+s"(ws)); \
    bf16* hb_cur = (bf16*)(ws + ((L & 1) ? WS_HB1 : WS_HB0)); bf16* hb_nxt = (bf16*)(ws + ((L & 1) ? WS_HB0 : WS_HB1)); \
    float* ssq0 = (float*)(ws + WS_SSQ0); float* ssq1 = (float*)(ws + WS_SSQ1); \
    bf16* act = (bf16*)(ws + WS_ACT); bf16* z = (bf16*)(ws + WS_Z); bf16* mixed = (bf16*)(ws + WS_MIXED); bf16* pp = (bf16*)(ws + WS_PP); \
    (void)hb_cur; (void)hb_nxt; (void)ssq0; (void)ssq1; (void)act; (void)z; (void)mixed; (void)pp;

    if (IN(0)) { p0_prologue(F, args); SEAM(0); }

    for (int layer = 0; layer < DEPTH; ++layer) {
        const int pb = 1 + 10 * layer;
        if (IN(pb + 0)) { PH_BEGIN
            pg8::Gemm g{hb_cur, WPTR(LW_UP1), M, NUP, D}; pg8::StaticOrder S; S.init(M, NUP, F.G, (int)blockIdx.x);
            pg8::EpiSwiGLU E{act, ssq0, DFF};
            pg8::gemm_phase<pg8::EpiSwiGLU, pg8::StaticOrder, true, true>(F.lds + RING_OFF, g, S, E);
            SEAM(pb + 0);
        }
        if (IN(pb + 1)) { PH_BEGIN
            pg8::Gemm g{act, WPTR(LW_DN1), M, D, DFF}; pg8::StaticOrder S; S.init(M, D, F.G, (int)blockIdx.x);
            pg8::EpiResid<0> E{F.out, hb_cur, ssq1, 0.5f, nullptr, nullptr};
            pg8::gemm_phase<pg8::EpiResid<0>, pg8::StaticOrder, true, true>(F.lds + RING_OFF, g, S, E);
            SEAM(pb + 1);
        }
        if (IN(pb + 2)) { PH_BEGIN
            pg8::Gemm g{hb_cur, WPTR(LW_IN), M, NIN, D}; pg8::StaticOrder S; S.init(M, NIN, F.G, (int)blockIdx.x);
            pg8::EpiScaleBf16 E{z, ssq1, NIN};
            pg8::gemm_phase<pg8::EpiScaleBf16, pg8::StaticOrder, true, true>(F.lds + RING_OFF, g, S, E);
            gates_phase(F, args, L, ssq1);
            SEAM(pb + 2);
        }
        if (IN(pb + 3)) { PH_BEGIN
            pg8::Gemm g{(const bf16*)(F.ws + WS_PB) + (size_t)L * M * DPLE, WPTR(LW_P), M, D, DPLE}; pg8::StaticOrder S; S.init(M, D, F.G, (int)blockIdx.x);
            pg8::EpiScaleBf16 E{pp, nullptr, D};
            pg8::gemm_phase<pg8::EpiScaleBf16, pg8::StaticOrder, true, true>(F.lds + RING_OFF, g, S, E);
            naive_prep(F, args, L);
            SEAM(pb + 3);
        }
        if (IN(pb + 4)) { PH_BEGIN naive_mixers(F, args, L); SEAM(pb + 4); }
        if (IN(pb + 5)) { SEAM(pb + 5); }
        if (IN(pb + 6)) { PH_BEGIN
            pg8::Gemm g{mixed, WPTR(LW_OUT), M, D, D}; pg8::StaticOrder S; S.init(M, D, F.G, (int)blockIdx.x);
            pg8::EpiResid<0> E{F.out, hb_cur, ssq0, 1.0f, nullptr, nullptr};
            pg8::gemm_phase<pg8::EpiResid<0>, pg8::StaticOrder, true, true>(F.lds + RING_OFF, g, S, E);
            SEAM(pb + 6);
        }
        if (IN(pb + 7)) { PH_BEGIN
            pg8::Gemm g{hb_cur, WPTR(LW_UP2), M, NUP, D}; pg8::StaticOrder S; S.init(M, NUP, F.G, (int)blockIdx.x);
            pg8::EpiSwiGLU E{act, ssq0, DFF};
            pg8::gemm_phase<pg8::EpiSwiGLU, pg8::StaticOrder, true, true>(F.lds + RING_OFF, g, S, E);
            SEAM(pb + 7);
        }
        if (IN(pb + 8)) { PH_BEGIN
            pg8::Gemm g{act, WPTR(LW_DN2), M, D, DFF}; pg8::StaticOrder S; S.init(M, D, F.G, (int)blockIdx.x);
            pg8::EpiResid<0> E{F.out, hb_cur, ssq1, 0.5f, nullptr, nullptr};
            pg8::gemm_phase<pg8::EpiResid<0>, pg8::StaticOrder, true, true>(F.lds + RING_OFF, g, S, E);
            SEAM(pb + 8);
        }
        if (IN(pb + 9)) { PH_BEGIN
            pg8::Gemm g{hb_cur, WPTR(LW_G), M, D, D}; pg8::StaticOrder S; S.init(M, D, F.G, (int)blockIdx.x);
            pg8::EpiResid<1> E{F.out, hb_nxt, ssq0, 1.0f, ssq1, pp};
            pg8::gemm_phase<pg8::EpiResid<1>, pg8::StaticOrder, true, true>(F.lds + RING_OFF, g, S, E);
            SEAM(pb + 9);
        }
    }
    if (IN(N_PHASES - 1)) final_norm(F, args);
#undef IN
#undef SEAM
#undef PH_BEGIN
}

#ifndef MK_MULTI
#define MK_MULTI 1
#endif
extern "C" void kernel_launch(void* const* d_in, const int* in_sizes, int n_in, void* d_out, int out_size, void* d_ws, size_t ws_size, hipStream_t stream) {
    static int grid = 0;
    if (grid == 0) {
        if (n_in != 20 || in_sizes[0] != M * D || out_size != M * D || ws_size < WS_END) { fprintf(stderr, "kernel_launch: unexpected shapes: n_in %d in0 %d out %d ws %zu (need %zu)\n", n_in, n_in > 0 ? in_sizes[0] : -1, out_size, ws_size, (size_t)WS_END); grid = -1; return; }
        int dev = 0, cus = 0, per_cu = 0;
        if (hipGetDevice(&dev) != hipSuccess || hipDeviceGetAttribute(&cus, hipDeviceAttributeMultiprocessorCount, dev) != hipSuccess) { grid = -1; return; }
        if (hipFuncSetAttribute((const void*)mk_fwd, hipFuncAttributeMaxDynamicSharedMemorySize, LDS_BYTES) != hipSuccess) { fprintf(stderr, "kernel_launch: hipFuncSetAttribute failed\n"); grid = -1; return; }
        if (hipOccupancyMaxActiveBlocksPerMultiprocessor(&per_cu, (const void*)mk_fwd, NWAVES * 64, LDS_BYTES) != hipSuccess || per_cu < 1) { fprintf(stderr, "kernel_launch: occupancy query says %d blocks per CU\n", per_cu); }
        (void)hipGetLastError();
        grid = cus;
    }
    if (grid < 0) return;
    if (hipMemsetAsync((char*)d_ws + WS_CTL, 0, CTL_ZERO_BYTES, stream) != hipSuccess) return;
    Args a{};
    for (int i = 0; i < 20; ++i) a.in[i] = (const float*)d_in[i];
    a.out = (float*)d_out; a.ws = (unsigned char*)d_ws;
#if MK_MULTI
    for (int p = 0; p < N_PHASES; ++p) { a.ph_lo = p; a.ph_hi = p + 1; hipLaunchKernelGGL(mk_fwd, dim3(grid), dim3(NWAVES * 64), LDS_BYTES, stream, a); }
#else
    a.ph_lo = 0; a.ph_hi = N_PHASES;
    hipLaunchKernelGGL(mk_fwd, dim3(grid), dim3(NWAVES * 64), LDS_BYTES, stream, a);
#endif
    const hipError_t le = hipPeekAtLastError();
    if (le != hipSuccess) fprintf(stderr, "kernel_launch: launch failed: %s\n", hipGetErrorName(le));
}
```

```cpp
#include <hip/hip_runtime.h>
#include <cstdio>
#include <cstdint>
namespace wv {
typedef unsigned u32x2_t __attribute__((ext_vector_type(2)));
#define WV_DPP(v, ctrl) __uint_as_float((unsigned)__builtin_amdgcn_update_dpp(0, (int)__float_as_uint(v), (ctrl), 0xf, 0xf, true))
__device__ __forceinline__ float swap16_a(float x, float& other) { const u32x2_t r = __builtin_amdgcn_permlane16_swap(__float_as_uint(x), __float_as_uint(x), false, false); other = __uint_as_float(r[1]); return __uint_as_float(r[0]); }
__device__ __forceinline__ float swap32_a(float x, float& other) { const u32x2_t r = __builtin_amdgcn_permlane32_swap(__float_as_uint(x), __float_as_uint(x), false, false); other = __uint_as_float(r[1]); return __uint_as_float(r[0]); }
__device__ __forceinline__ float quad_sum(float x) { float o; float a = swap16_a(x, o); x = a + o; a = swap32_a(x, o); return a + o; }
__device__ __forceinline__ float quad_max(float x) { float o; float a = swap16_a(x, o); x = fmaxf(a, o); a = swap32_a(x, o); return fmaxf(a, o); }
__device__ __forceinline__ float row_sum(float v) { v += WV_DPP(v, 0xB1); v += WV_DPP(v, 0x4E); v += WV_DPP(v, 0x141); v += WV_DPP(v, 0x140); return v; }
__device__ __forceinline__ float row_max(float v) { v = fmaxf(v, WV_DPP(v, 0xB1)); v = fmaxf(v, WV_DPP(v, 0x4E)); v = fmaxf(v, WV_DPP(v, 0x141)); v = fmaxf(v, WV_DPP(v, 0x140)); return v; }
__device__ __forceinline__ float wave_sum(float v) { return quad_sum(row_sum(v)); }
__device__ __forceinline__ float wave_max(float v) { return quad_max(row_max(v)); }
__device__ __forceinline__ float lane_up(float v, int d, int lane) { return __uint_as_float((unsigned)__builtin_amdgcn_ds_bpermute((lane - d) << 2, (int)__float_as_uint(v))); }
__device__ __forceinline__ float lane_get(float v, int src) { return __uint_as_float((unsigned)__builtin_amdgcn_readlane((int)__float_as_uint(v), src)); }
}
namespace pg8 {
#define PG8_LAS __attribute__((address_space(3)))
typedef unsigned short bf16_t;
typedef short bf16x8 __attribute__((ext_vector_type(8)));
typedef float f32x4 __attribute__((ext_vector_type(4)));
typedef unsigned u32x4 __attribute__((ext_vector_type(4)));
constexpr int BM = 256, BK = 64, HALF = 128, HTB = HALF * BK * 2  , STAGE_BYTES = 8 * HTB, NXCD = 8, WGM = 8;

__host__ __device__ __forceinline__ int lds_byte(int r, int c) { const int st = (r >> 4) * 2 + (c >> 5), rr = r & 15, cc = c & 31, ob = rr * 64 + cc * 2; return st * 1024 + (ob ^ (((ob >> 9) & 1) << 5)); }
__host__ __device__ __forceinline__ void stage_rc(int b, int& R, int& C) { const int st = b / 1024, sb = b % 1024, swz = sb ^ (((sb >> 9) & 1) << 5); R = (st >> 1) * 16 + swz / 64; C = (st & 1) * 32 + (swz % 64) / 2; }
__host__ __device__ __forceinline__ int perm32(int rho) { const int n = rho >> 4, i = rho & 15; return 8 * (i >> 2) + 4 * n + (i & 3); }

struct Unit { int pm, pn; };
struct Gemm { const bf16_t* A; const bf16_t* Bt; int M, N, K; };

struct StaticOrder {
    int nM, nN, nwg, G, c;
    __host__ __device__ void init(int M, int N, int G_, int c_) { nM = M / BM; nN = N / BM; nwg = nM * nN; G = G_; c = c_; }
    __host__ __device__ bool next(int i, Unit& u) const {
        const long L = (long)i * G + c; if (L >= nwg) return false;
        int wgid = (int)L; { const int q = nwg / NXCD, r = nwg % NXCD, xcd = wgid % NXCD, off = wgid / NXCD; wgid = (xcd < r ? xcd * (q + 1) : r * (q + 1) + (xcd - r) * q) + off; }
        const int nig = WGM * nN, gid = wgid / nig, fm = gid * WGM, gsz = (nM - fm) < WGM ? (nM - fm) : WGM;
        u.pm = fm + ((wgid % nig) % gsz); u.pn = (wgid % nig) / gsz; return true;
    }
    __device__ __forceinline__ void a_ready(const Unit&) const {}
    __device__ __forceinline__ void done(const Unit&) const {}
};

__device__ __forceinline__ unsigned cvt_pk_bf16(float lo, float hi) { unsigned r; asm volatile("v_cvt_pk_bf16_f32 %0, %1, %2" : "=v"(r) : "v"(lo), "v"(hi)); return r; }
typedef float f32x2 __attribute__((ext_vector_type(2)));
#define PG8_GAS __attribute__((address_space(1)))
constexpr float RMS_EPS_F = 1e-6f;
__device__ __forceinline__ void load_rstd(const float* ssq, int row0, int fq, float (&rs)[2][4]) {
    f32x4 raw[2][4][2];
#pragma unroll
    for (int ai = 0; ai < 2; ++ai)
#pragma unroll
        for (int m = 0; m < 4; ++m) {
            const PG8_GAS f32x4* p = (const PG8_GAS f32x4*)(ssq + (size_t)(row0 + ai * HALF + m * 16) * 32 + fq * 8);
            raw[ai][m][0] = p[0]; raw[ai][m][1] = p[1];
        }
    asm volatile("" ::: "memory");
#pragma unroll
    for (int ai = 0; ai < 2; ++ai)
#pragma unroll
        for (int m = 0; m < 4; ++m) {
            const f32x4 a = raw[ai][m][0], b = raw[ai][m][1];
            float s = ((a[0] + a[1]) + (a[2] + a[3])) + ((b[0] + b[1]) + (b[2] + b[3]));
            s = wv::quad_sum(s);
            rs[ai][m] = __builtin_amdgcn_rsqf(s * (1.0f / 2048.0f) + RMS_EPS_F);
        }
}
__device__ __forceinline__ float sigmoid_f(float x) { return __builtin_amdgcn_rcpf(1.0f + __builtin_amdgcn_exp2f(-1.4426950408889634f * x)); }

struct EpiSwiGLU {
    static constexpr bool PERM = true, AFTER_DRAIN = false, INIT = false;
    bf16_t* act; const float* ssq; int ldc;
    __device__ __forceinline__ void operator()(const f32x4 (&acc)[2][2][4][2], const Unit& u, int wr, int wc, int fr, int fq) const {
        const int row0 = u.pm * BM + wr * 64 + fr, col0 = u.pn * HALF + wc * 32 + 8 * fq;
        float rs[2][4]; load_rstd(ssq, row0, fq, rs);
#pragma unroll
        for (int ai = 0; ai < 2; ++ai)
#pragma unroll
            for (int m = 0; m < 4; ++m) {
                const float s = rs[ai][m]; float v[8];
#pragma unroll
                for (int n = 0; n < 2; ++n)
#pragma unroll
                    for (int j = 0; j < 4; ++j) { const float g = acc[ai][0][m][n][j] * s, up = acc[ai][1][m][n][j] * s; v[n * 4 + j] = g * sigmoid_f(g) * up; }
                u32x4 w; w.x = cvt_pk_bf16(v[0], v[1]); w.y = cvt_pk_bf16(v[2], v[3]); w.z = cvt_pk_bf16(v[4], v[5]); w.w = cvt_pk_bf16(v[6], v[7]);
                __builtin_nontemporal_store(w, (PG8_GAS u32x4*)(act + (size_t)(row0 + ai * HALF + m * 16) * ldc + col0));
            }
    }
};
struct EpiScaleBf16 {
    static constexpr bool PERM = true, AFTER_DRAIN = false, INIT = false;
    bf16_t* O; const float* ssq; int ldc;
    __device__ __forceinline__ void operator()(const f32x4 (&acc)[2][2][4][2], const Unit& u, int wr, int wc, int fr, int fq) const {
        const int row0 = u.pm * BM + wr * 64 + fr, col0 = u.pn * BM + wc * 32 + 8 * fq;
        float rs[2][4];
        if (ssq) load_rstd(ssq, row0, fq, rs);
        else {
#pragma unroll
            for (int ai = 0; ai < 2; ++ai)
#pragma unroll
                for (int m = 0; m < 4; ++m) rs[ai][m] = 1.0f; }
#pragma unroll
        for (int ai = 0; ai < 2; ++ai)
#pragma unroll
            for (int m = 0; m < 4; ++m) { const float s = rs[ai][m]; bf16_t* rowp = O + (size_t)(row0 + ai * HALF + m * 16) * ldc + col0;
#pragma unroll
                for (int bj = 0; bj < 2; ++bj) { const f32x4 v0 = acc[ai][bj][m][0] * s, v1 = acc[ai][bj][m][1] * s;
                    u32x4 w; w.x = cvt_pk_bf16(v0[0], v0[1]); w.y = cvt_pk_bf16(v0[2], v0[3]); w.z = cvt_pk_bf16(v1[0], v1[1]); w.w = cvt_pk_bf16(v1[2], v1[3]);
                    __builtin_nontemporal_store(w, (PG8_GAS u32x4*)(rowp + bj * HALF)); } }
    }
};
template <int MODE, int ALPHA_X2> struct EpiResid {
    static constexpr bool PERM = true, AFTER_DRAIN = false, INIT = (MODE == 0);
    static constexpr float alpha = 0.5f * ALPHA_X2;
    const bf16_t* hin; bf16_t* hb; float* ssq_out; const float* ssq_in; const bf16_t* pp;
    static __device__ __forceinline__ float lo16(unsigned w) { return __uint_as_float(w << 16); }
    static __device__ __forceinline__ float hi16(unsigned w) { return __uint_as_float(w & 0xffff0000u); }
    __device__ __forceinline__ void init(f32x4 (&acc)[2][2][4][2], const Unit& u, int wr, int wc, int fr, int fq) const {
        const int row0 = u.pm * BM + wr * 64 + fr, col0 = u.pn * BM + wc * 32 + 8 * fq; constexpr float ia = 1.0f / alpha;
        u32x4 w[2][4][2];
#pragma unroll
        for (int ai = 0; ai < 2; ++ai)
#pragma unroll
            for (int m = 0; m < 4; ++m)
#pragma unroll
                for (int bj = 0; bj < 2; ++bj) w[ai][m][bj] = *(const PG8_GAS u32x4*)(hin + (size_t)(row0 + ai * HALF + m * 16) * 2048 + col0 + bj * HALF);
#pragma unroll
        for (int ai = 0; ai < 2; ++ai)
#pragma unroll
            for (int m = 0; m < 4; ++m)
#pragma unroll
                for (int bj = 0; bj < 2; ++bj) { const u32x4 v = w[ai][m][bj];
                    acc[ai][bj][m][0] = (f32x4){lo16(v.x), hi16(v.x), lo16(v.y), hi16(v.y)} * ia; acc[ai][bj][m][1] = (f32x4){lo16(v.z), hi16(v.z), lo16(v.w), hi16(v.w)} * ia; }
    }
    __device__ __forceinline__ float put(unsigned eoff, const f32x4& a, const f32x4& b) const {
        u32x4 w; w.x = cvt_pk_bf16(a[0], a[1]); w.y = cvt_pk_bf16(a[2], a[3]); w.z = cvt_pk_bf16(b[0], b[1]); w.w = cvt_pk_bf16(b[2], b[3]);
        *(PG8_GAS u32x4*)((PG8_GAS char*)hb + 2u * eoff) = w;
        const float a0 = lo16(w.x), a1 = hi16(w.x), a2 = lo16(w.y), a3 = hi16(w.y), b0 = lo16(w.z), b1 = hi16(w.z), b2 = lo16(w.w), b3 = hi16(w.w);
        return ((a0 * a0 + a1 * a1) + (a2 * a2 + a3 * a3)) + ((b0 * b0 + b1 * b1) + (b2 * b2 + b3 * b3));
    }
    __device__ __forceinline__ void operator()(const f32x4 (&acc)[2][2][4][2], const Unit& u, int wr, int wc, int fr, int fq) const {
        const int row0 = u.pm * BM + wr * 64 + fr, col0 = u.pn * BM + wc * 32 + 8 * fq;
        const unsigned e0 = (unsigned)(row0 * 2048 + col0);
        if constexpr (MODE == 0) {
#pragma unroll
            for (int ai = 0; ai < 2; ++ai)
#pragma unroll
                for (int m = 0; m < 4; ++m) {
                    const int r = row0 + ai * HALF + m * 16; float q = 0.f;
#pragma unroll
                    for (int bj = 0; bj < 2; ++bj) q += put(e0 + (unsigned)((ai * HALF + m * 16) * 2048 + bj * HALF), acc[ai][bj][m][0] * alpha, acc[ai][bj][m][1] * alpha);
                    q = wv::quad_sum(q);
                    if (fq == 0) *(PG8_GAS float*)(ssq_out + (size_t)r * 32 + u.pn * 4 + wc) = q;
                }
        } else {
            float rs[2][4]; load_rstd(ssq_in, row0, fq, rs);
            const PG8_GAS char* hB = (const PG8_GAS char*)hin; const PG8_GAS char* pB = (const PG8_GAS char*)pp;
            u32x4 hv[2][2], pv[2][2];
#define RES_LD(IT, BUF) { _Pragma("unroll") for (int bj = 0; bj < 2; ++bj) { const unsigned bo = 2u * (e0 + (unsigned)(((((IT) >> 2) * HALF + ((IT) & 3) * 16) * 2048 + bj * HALF))); \
                hv[BUF][bj] = *(const PG8_GAS u32x4*)(hB + bo); pv[BUF][bj] = *(const PG8_GAS u32x4*)(pB + bo); } }
            RES_LD(0, 0)
#pragma unroll
            for (int it = 0; it < 8; ++it) {
                const int ai = it >> 2, m = it & 3, cb = it & 1;
                if (it + 1 < 8) RES_LD(it + 1, cb ^ 1)
                asm volatile("" ::: "memory");
                const int r = row0 + ai * HALF + m * 16; float q = 0.f; const float s = rs[ai][m];
#pragma unroll
                for (int bj = 0; bj < 2; ++bj) {
                    const u32x4 hw = hv[cb][bj], pw = pv[cb][bj];
                    f32x4 a = (f32x4){lo16(hw.x), hi16(hw.x), lo16(hw.y), hi16(hw.y)}, b = (f32x4){lo16(hw.z), hi16(hw.z), lo16(hw.w), hi16(hw.w)};
#pragma unroll
                    for (int j = 0; j < 4; ++j) {
                        const unsigned w0 = pw[j >> 1], w1 = pw[2 + (j >> 1)];
                        const float p0 = (j & 1) ? hi16(w0) : lo16(w0), p1 = (j & 1) ? hi16(w1) : lo16(w1);
                        a[j] += sigmoid_f(acc[ai][bj][m][0][j] * s) * p0; b[j] += sigmoid_f(acc[ai][bj][m][1][j] * s) * p1; }
                    q += put(e0 + (unsigned)((ai * HALF + m * 16) * 2048 + bj * HALF), a, b);
                }
                q = wv::quad_sum(q);
                if (fq == 0) *(PG8_GAS float*)(ssq_out + (size_t)r * 32 + u.pn * 4 + wc) = q;
            }
#undef RES_LD
        }
    }
};
struct NoHook { __device__ __forceinline__ void operator()() const {} };
template <class Epi, class Sched, bool ALIGN_EPI = false, bool SP2 = false, class Hook = NoHook>
__device__ __forceinline__ void gemm_phase(PG8_LAS unsigned char* lds, const Gemm g, const Sched& S, const Epi& E, int wave_id, const Hook& hook = Hook()) {
    int wid_ = wave_id; asm volatile("" : "+s"(wid_)); int lane_; asm volatile("v_mbcnt_lo_u32_b32 %0, -1, 0\n\tv_mbcnt_hi_u32_b32 %0, -1, %0" : "=v"(lane_));
    const int wid = wid_, lane = lane_, tid = wid * 64 + lane, wr = wid >> 2, wc = wid & 3, fr = lane & 15, fq = lane >> 4;
    const int K = g.K, nt = K / BK;
    unsigned voffA[2], voffB[2];
#pragma unroll
    for (int i = 0; i < 2; ++i) { int R, C; stage_rc(tid * 16 + i * 8192, R, C); const int Rb = Epi::PERM ? ((R & ~31) + perm32(R & 31)) : R;
        voffA[i] = (unsigned)(R * K + C) * 2u; voffB[i] = (unsigned)(Rb * K + C) * 2u; }
    const size_t kstep = (size_t)(BK * 2);
    const size_t hstep = (size_t)HALF * K * 2;
    const size_t tstep = 2 * hstep;
    const unsigned ldsw = (unsigned)wid * 1024u;
    const int aoff = lds_byte(wr * 64 + fr, fq * 8), boff = lds_byte(wc * 32 + fr, fq * 8);
#define PG8_SA(b, h) (((b) * 2 + (h)) * HTB)
#define PG8_SB(b, h) ((4 + (b) * 2 + (h)) * HTB)
#define PG8_STAGE(bufoff, gbase, voff) do { _Pragma("unroll") for (int _i = 0; _i < 2; ++_i) \
        __builtin_amdgcn_global_load_lds((const unsigned*)((const char*)(gbase) + (voff)[_i]), (PG8_LAS unsigned*)(lds + (bufoff) + ldsw + _i * 8192), 16, 0, 0); } while (0)
#define PG8_LDA(dst, b, h) do { _Pragma("unroll") for (int m = 0; m < 4; ++m) _Pragma("unroll") for (int k = 0; k < 2; ++k) dst[m][k] = *(const PG8_LAS bf16x8*)(lds + PG8_SA(b, h) + aoff + m * 2048 + k * 1024); } while (0)
#define PG8_LDB(dst, b, h) do { _Pragma("unroll") for (int n = 0; n < 2; ++n) _Pragma("unroll") for (int k = 0; k < 2; ++k) dst[n][k] = *(const PG8_LAS bf16x8*)(lds + PG8_SB(b, h) + boff + n * 2048 + k * 1024); } while (0)
#define PG8_MMA(ai, bj, At, Bt) do { __builtin_amdgcn_s_setprio(1); _Pragma("unroll") for (int m = 0; m < 4; ++m) _Pragma("unroll") for (int n = 0; n < 2; ++n) _Pragma("unroll") for (int k = 0; k < 2; ++k) \
        acc[ai][bj][m][n] = __builtin_amdgcn_mfma_f32_16x16x32_bf16(Bt[n][k], At[m][k], acc[ai][bj][m][n], 0, 0, 0); __builtin_amdgcn_s_setprio(0); } while (0)
#define PG8_WAIT_V(n) asm volatile("s_waitcnt vmcnt(" #n ")" ::: "memory")
#define PG8_WAIT_L(n) asm volatile("s_waitcnt lgkmcnt(" #n ")" ::: "memory")
#define PG8_BAR __builtin_amdgcn_s_barrier()
#define PG8_SCHED __builtin_amdgcn_sched_barrier(0)
    Unit cur, nxt; int ui = 0;
    const bool has_unit = S.next(0, cur);
    f32x4 acc[2][2][4][2];
    if constexpr (Epi::INIT) { if (has_unit) E.init(acc, cur, wr, wc, fr, fq); }
    else {
#pragma unroll
    for (int a = 0; a < 2; ++a)
#pragma unroll
        for (int b = 0; b < 2; ++b)
#pragma unroll
            for (int m = 0; m < 4; ++m)
#pragma unroll
                for (int n = 0; n < 2; ++n) acc[a][b][m][n] = (f32x4){0.f, 0.f, 0.f, 0.f};
    }
    hook();
    if (!has_unit) return;
    bf16x8 At[4][2], B0[2][2], B1[2][2];
    const char* cA = (const char*)g.A + (size_t)cur.pm * tstep; const char* cB = (const char*)g.Bt + (size_t)cur.pn * tstep;
    S.a_ready(cur);
    if constexpr (SP2) {
        PG8_STAGE(PG8_SB(0, 0), cB, voffB); PG8_STAGE(PG8_SB(0, 1), cB + hstep, voffB); PG8_STAGE(PG8_SA(0, 0), cA, voffA); PG8_STAGE(PG8_SA(0, 1), cA + hstep, voffA);
        if (wr == 1) PG8_BAR;
        PG8_WAIT_V(2); PG8_BAR;
        PG8_STAGE(PG8_SB(1, 0), cB + kstep, voffB); PG8_STAGE(PG8_SA(1, 0), cA + kstep, voffA); PG8_STAGE(PG8_SB(1, 1), cB + hstep + kstep, voffB);
        PG8_WAIT_V(6); PG8_BAR;
    } else {
        PG8_STAGE(PG8_SB(0, 0), cB, voffB); PG8_STAGE(PG8_SA(0, 0), cA, voffA); PG8_STAGE(PG8_SB(0, 1), cB + hstep, voffB); PG8_STAGE(PG8_SA(0, 1), cA + hstep, voffA);
        if (wr == 1) PG8_BAR;
        PG8_WAIT_V(4); PG8_BAR;
        PG8_STAGE(PG8_SB(1, 0), cB + kstep, voffB); PG8_STAGE(PG8_SA(1, 0), cA + kstep, voffA); PG8_STAGE(PG8_SB(1, 1), cB + hstep + kstep, voffB);
        PG8_WAIT_V(6); PG8_BAR;
    }
    for (;;) {
        const bool has_next = S.next(ui + 1, nxt);
        const char* nA = has_next ? (const char*)g.A + (size_t)nxt.pm * tstep : cA; const char* nB = has_next ? (const char*)g.Bt + (size_t)nxt.pn * tstep : cB;
        for (int t = 0; t < nt; t += 2) {
            const bool last = (t == nt - 2);
            const char* a1 = cA + (size_t)(t + 1) * kstep;
            const char* a2 = last ? nA : cA + (size_t)(t + 2) * kstep; const char* b2 = last ? nB : cB + (size_t)(t + 2) * kstep;
            const char* a3 = a2 + kstep; const char* b3 = b2 + kstep;
            if (last && has_next) S.a_ready(nxt);
            if constexpr (SP2) {
            PG8_LDB(B0, 0, 0); PG8_LDB(B1, 0, 1); PG8_SCHED; PG8_LDA(At, 0, 0); PG8_STAGE(PG8_SA(1, 1), a1 + hstep, voffA);
            PG8_WAIT_V(8); PG8_WAIT_L(0); PG8_BAR; PG8_MMA(0, 0, At, B0); PG8_MMA(0, 1, At, B1); PG8_BAR; PG8_SCHED;
            PG8_LDA(At, 0, 1); PG8_STAGE(PG8_SB(0, 0), b2, voffB); PG8_STAGE(PG8_SB(0, 1), b2 + hstep, voffB); PG8_STAGE(PG8_SA(0, 0), a2, voffA);
            PG8_WAIT_V(8); PG8_WAIT_L(0); PG8_BAR; PG8_MMA(1, 0, At, B0); PG8_MMA(1, 1, At, B1); PG8_BAR; PG8_SCHED;
            PG8_LDB(B0, 1, 0); PG8_LDB(B1, 1, 1); PG8_SCHED; PG8_LDA(At, 1, 0); PG8_STAGE(PG8_SA(0, 1), a2 + hstep, voffA);
            PG8_WAIT_V(8); PG8_WAIT_L(0); PG8_BAR; PG8_MMA(0, 0, At, B0); PG8_MMA(0, 1, At, B1); PG8_BAR; PG8_SCHED;
            PG8_LDA(At, 1, 1); PG8_STAGE(PG8_SB(1, 0), b3, voffB); PG8_STAGE(PG8_SB(1, 1), b3 + hstep, voffB); PG8_STAGE(PG8_SA(1, 0), a3, voffA);
            PG8_WAIT_V(8); PG8_WAIT_L(0); PG8_BAR; PG8_MMA(1, 0, At, B0); PG8_MMA(1, 1, At, B1); PG8_BAR; PG8_SCHED;
            } else {
            PG8_LDB(B0, 0, 0); PG8_SCHED; PG8_LDA(At, 0, 0); PG8_STAGE(PG8_SA(1, 1), a1 + hstep, voffA);
            PG8_WAIT_L(8); PG8_BAR; PG8_WAIT_L(0); PG8_MMA(0, 0, At, B0); PG8_BAR; PG8_SCHED;
            PG8_LDB(B1, 0, 1); PG8_STAGE(PG8_SB(0, 0), b2, voffB);
            PG8_BAR; PG8_WAIT_L(0); PG8_MMA(0, 1, At, B1); PG8_BAR;
            PG8_LDA(At, 0, 1); PG8_STAGE(PG8_SA(0, 0), a2, voffA);
            PG8_BAR; PG8_WAIT_L(0); PG8_MMA(1, 0, At, B0); PG8_BAR; PG8_SCHED;
            PG8_STAGE(PG8_SB(0, 1), b2 + hstep, voffB);
            PG8_WAIT_V(6); PG8_BAR; PG8_MMA(1, 1, At, B1); PG8_BAR;
            PG8_LDB(B0, 1, 0); PG8_SCHED; PG8_LDA(At, 1, 0); PG8_STAGE(PG8_SA(0, 1), a2 + hstep, voffA);
            PG8_WAIT_L(8); PG8_BAR; PG8_WAIT_L(0); PG8_MMA(0, 0, At, B0); PG8_BAR; PG8_SCHED;
            PG8_LDB(B1, 1, 1); PG8_STAGE(PG8_SB(1, 0), b3, voffB);
            PG8_BAR; PG8_WAIT_L(0); PG8_MMA(0, 1, At, B1); PG8_BAR;
            PG8_LDA(At, 1, 1); PG8_STAGE(PG8_SA(1, 0), a3, voffA);
            PG8_BAR; PG8_WAIT_L(0); PG8_MMA(1, 0, At, B0); PG8_BAR; PG8_SCHED;
            PG8_STAGE(PG8_SB(1, 1), b3 + hstep, voffB);
            PG8_WAIT_V(6); PG8_BAR; PG8_MMA(1, 1, At, B1); PG8_BAR;
            }
        }
        if constexpr (ALIGN_EPI) { if (wr == 0) PG8_BAR; }
        if constexpr (!Epi::AFTER_DRAIN) { E(acc, cur, wr, wc, fr, fq); S.done(cur); }
        if (!has_next) break;
        if constexpr (Epi::INIT) E.init(acc, nxt, wr, wc, fr, fq);
        else {
#pragma unroll
        for (int a = 0; a < 2; ++a)
#pragma unroll
            for (int b = 0; b < 2; ++b)
#pragma unroll
                for (int m = 0; m < 4; ++m)
#pragma unroll
                    for (int n = 0; n < 2; ++n) acc[a][b][m][n] = (f32x4){0.f, 0.f, 0.f, 0.f};
        }
        cur = nxt; cA = nA; cB = nB; ++ui;
        if constexpr (ALIGN_EPI) { if (wr == 1) PG8_BAR; }
    }
    PG8_WAIT_V(0);
    if constexpr (!ALIGN_EPI) { if (wr == 0) PG8_BAR; }
    PG8_BAR;
    if constexpr (Epi::AFTER_DRAIN) { E.fused(acc, cur, wr, wc, fr, fq, lds, wid, lane); S.done(cur); }
#undef PG8_SA
#undef PG8_SB
#undef PG8_STAGE
#undef PG8_LDA
#undef PG8_LDB
#undef PG8_MMA
#undef PG8_WAIT_V
#undef PG8_WAIT_L
#undef PG8_BAR
#undef PG8_SCHED
}
}

constexpr int NBATCH = 4, T = 2048, D = 2048, M = NBATCH * T, DEPTH = 4, DFF = 5632, NUP = 2 * DFF, NIN = 6144, DIN = 6152, DPLE = 256;
constexpr int NH = 4, HD = 128, DKM = 128, DVM = 256, NBH = NBATCH * NH;
constexpr int ZQA = 0, ZKA = 512, ZVA = 1024, ZQC = 1536, ZKC = 2048, ZVC = 2560, ZQKM = 3072, ZVM = 4096, ZOM = 5120;
constexpr float RMS_EPS = 1e-6f, LOG2E = 1.4426950408889634f;
constexpr int NWAVES = 8;

constexpr size_t MiB = 1u << 20;
constexpr size_t WS_CTL = 0, CTL_ZERO_BYTES = 1 * MiB;
constexpr size_t WS_W = 2 * MiB, LW_UP1 = 0, LW_DN1 = 44 * MiB, LW_IN = 66 * MiB, LW_OUT = 90 * MiB, LW_UP2 = 98 * MiB, LW_DN2 = 142 * MiB, LW_G = 164 * MiB, LW_P = 172 * MiB, LW_STRIDE = 174 * MiB;
constexpr size_t WS_HB0 = 700 * MiB, WS_HB1 = 732 * MiB, WS_SSQ0 = 764 * MiB, WS_SSQ1 = 765 * MiB, WS_GATES = 766 * MiB, WS_BCUM = 767 * MiB;
constexpr size_t WS_ACT = 768 * MiB, WS_Z = 856 * MiB, WS_MIXED = 952 * MiB, WS_PP = 984 * MiB, WS_PB = 1016 * MiB;
constexpr size_t WS_QC = 1032 * MiB, WS_KC = 1040 * MiB, WS_KMEAN = 1048 * MiB, WS_DLSE = 1049 * MiB, WS_DOUT = 1056 * MiB;
constexpr size_t WS_BQ = 1050 * MiB, WS_AQ = WS_BQ + 131072, WS_BLAST = WS_AQ + 131072, WS_AMAX = WS_BLAST + 4096, WS_MST = WS_AMAX + 4096, WS_DN = 1051 * MiB, WS_NST = WS_DN + 262144;
constexpr size_t WS_DCT = 1104 * MiB, WS_CST = 1168 * MiB, WS_MOUT = 1200 * MiB, WS_MLSE = 1248 * MiB, WS_END = 1250 * MiB;
static_assert(WS_W + 4 * LW_STRIDE <= WS_HB0 && WS_ACT + (size_t)M * DFF * 2 <= WS_Z && WS_Z + (size_t)M * NIN * 2 <= WS_MIXED, "d_ws map");
constexpr int CW_BAR = 4096, CW_QUEUE = 8192;

constexpr int RING_OFF = 0, RING_BYTES = 131072;
constexpr int SCR_BYTES = 8 * 16640;
constexpr int LDSCTL_OFF = SCR_BYTES, MISC_OFF = LDSCTL_OFF + 320;
constexpr int LDS_BYTES = 147456;
static_assert(MISC_OFF + 128 <= LDS_BYTES && SCR_BYTES >= RING_BYTES, "LDS map");

#define GAS __attribute__((address_space(1)))
#define LAS __attribute__((address_space(3)))
typedef unsigned short bf16;
typedef unsigned v4u __attribute__((ext_vector_type(4)));
typedef unsigned v2u __attribute__((ext_vector_type(2)));
typedef float f32x4 __attribute__((ext_vector_type(4)));
typedef GAS unsigned gu32;
#define RLX_AGENT __ATOMIC_RELAXED, __HIP_MEMORY_SCOPE_AGENT
#define LDS_WAIT() asm volatile("s_waitcnt lgkmcnt(0)" ::: "memory")
#define VM_WAIT() asm volatile("s_waitcnt vmcnt(0)" ::: "memory")
__device__ __forceinline__ unsigned f2bf(float f) { unsigned u = __builtin_bit_cast(unsigned, f); return (u + 0x7fffu + ((u >> 16) & 1u)) >> 16; }
__device__ __forceinline__ unsigned pk2(float lo, float hi) { return f2bf(lo) | (f2bf(hi) << 16); }
__device__ __forceinline__ float bflo(unsigned w) { return __uint_as_float(w << 16); }
__device__ __forceinline__ float bfhi(unsigned w) { return __uint_as_float(w & 0xffff0000u); }
__device__ __forceinline__ float sigmoid_fast(float x) { return __builtin_amdgcn_rcpf(1.0f + __builtin_amdgcn_exp2f(-1.4426950408889634f * x)); }
__device__ __forceinline__ float bf2f(bf16 b) { return __uint_as_float(((unsigned)b) << 16); }

#define XB_TMO      128
#define XB_XCNT(j)  (256  + 64 * (j))
#define XB_XSUB(j)  (1280 + 64 * (j))
#define XB_XGEN(j)  (2304 + 64 * (j))
#define XB_TOP      3328
#define XB_TOPGEN   3392
#define XCD_BAR_WORDS 3456
#define XB_SPIN_CAP (1u << 18)

__device__ __forceinline__ unsigned xb_ld(unsigned* p)              { return __hip_atomic_load(p, __ATOMIC_RELAXED, __HIP_MEMORY_SCOPE_AGENT); }
__device__ __forceinline__ unsigned xb_add(unsigned* p, unsigned v) { return __hip_atomic_fetch_add(p, v, __ATOMIC_RELAXED, __HIP_MEMORY_SCOPE_AGENT); }
__device__ __forceinline__ unsigned xb_xcc_id() { return (unsigned)__builtin_amdgcn_s_getreg((3 << 11) | 20) & 0xFu; }
#define XB_SPIN(cond, bar) do { unsigned _sp = 0; while (cond) { __builtin_amdgcn_s_sleep(1); \
    if ((++_sp & 255u) == 0u) { if (xb_ld(&(bar)[XB_TMO])) break; if (_sp > XB_SPIN_CAP) { atomicAdd(&(bar)[XB_TMO], 1u); break; } } } } while (0)

struct XcdBarrier {
    unsigned* bar; unsigned x;
    volatile LAS unsigned* st;
};

__device__ __forceinline__ XcdBarrier xcd_barrier_post(unsigned* bar, volatile LAS unsigned* st) {
    XcdBarrier b; b.bar = bar; b.x = xb_xcc_id(); b.st = st;
    if (threadIdx.x == 0) (void)xb_add(&bar[XB_XCNT(b.x)], 1u);
    return b;
}
__device__ __forceinline__ void xcd_barrier_complete(unsigned* bar, unsigned x, unsigned& nloc, unsigned& nx) {
    const unsigned G = gridDim.x * gridDim.y * gridDim.z;
    unsigned sum, cnt, mine, sp = 0u;
    for (;;) {
        sum = 0u; cnt = 0u; mine = 0u;
#pragma unroll
        for (unsigned j = 0; j < 16; ++j) { const unsigned c = xb_ld(&bar[XB_XCNT(j)]); sum += c; cnt += (c > 0u) ? 1u : 0u; mine = (j == x) ? c : mine; }
        if (sum == G) break;
        __builtin_amdgcn_s_sleep(1);
        if ((++sp & 255u) == 0u) { if (xb_ld(&bar[XB_TMO])) break; if (sp > XB_SPIN_CAP) { atomicAdd(&bar[XB_TMO], 1u); break; } }
    }
    nloc = mine > 0u ? mine : 1u; nx = cnt > 0u ? cnt : 1u;
}

__device__ __forceinline__ void xcd_barrier(const XcdBarrier& b) {
    asm volatile("s_waitcnt vmcnt(0)" ::: "memory");
    __syncthreads();
    if (threadIdx.x == 0) {
        unsigned* bar = b.bar;
        __builtin_amdgcn_s_waitcnt(0);
        unsigned nloc = b.st[0], nx = b.st[1];
        if (nloc == 0u) { xcd_barrier_complete(bar, b.x, nloc, nx); b.st[0] = nloc; b.st[1] = nx; }
        const unsigned old = xb_add(&bar[XB_XSUB(b.x)], 1u);
        const unsigned gen = old / nloc;
        if (old + 1u == (gen + 1u) * nloc) {
            __builtin_amdgcn_fence(__ATOMIC_RELEASE, "agent");
            asm volatile("s_waitcnt vmcnt(0)" ::: "memory");
            const unsigned og = xb_add(&bar[XB_TOP], 1u);
            const unsigned tg = og / nx;
            if (og + 1u == (tg + 1u) * nx) xb_add(&bar[XB_TOPGEN], 1u);
            else XB_SPIN(xb_ld(&bar[XB_TOPGEN]) == tg, bar);
            __builtin_amdgcn_fence(__ATOMIC_ACQUIRE, "agent");
            xb_add(&bar[XB_XGEN(b.x)], 1u);
            asm volatile("s_waitcnt vmcnt(0)" ::: "memory");
        } else {
            XB_SPIN(xb_ld(&bar[XB_XGEN(b.x)]) == gen, bar);
            __builtin_amdgcn_fence(__ATOMIC_ACQUIRE, "agent");
            asm volatile("s_waitcnt vmcnt(0)" ::: "memory");
        }
    }
    __syncthreads();
}


struct BarHook { const XcdBarrier& b; bool on; __device__ __forceinline__ void operator()() const { if (on) xcd_barrier(b); } };
struct Args { const float* in[20]; float* out; unsigned char* ws; int ph_lo, ph_hi; };
struct Frame {
    LAS unsigned char* lds;
    volatile LAS unsigned* MISC;
    gu32* ctl;
    int tid, lane, wave, wave0;
    int vcu, G;
    float* out; unsigned char* ws;
};
__device__ __forceinline__ float wave_sum(float v) { return wv::wave_sum(v); }
__device__ __forceinline__ float wave_max(float v) { return wv::wave_max(v); }
__device__ __forceinline__ bf16* wptr(Frame& F, int layer, size_t off) { return (bf16*)(F.ws + WS_W + (size_t)layer * LW_STRIDE + off); }
#define WPTR(off) ((bf16*)(ws + WS_W + (size_t)L * LW_STRIDE + (off)))

#define OPAQUE_TID(F) do { int w_ = (F).wave0; asm volatile("" : "+s"(w_)); int l_; asm volatile("v_mbcnt_lo_u32_b32 %0, -1, 0\n\tv_mbcnt_hi_u32_b32 %0, -1, %0" : "=v"(l_)); (F).lane = l_; (F).wave = w_; (F).tid = w_ * 64 + l_; } while (0)
struct ItemDesc { const float* W; const float* g; bf16* WT; int K, ldn, upmap, k0, n0; };
struct ItemRegs { f32x4 v[16], g0, g1; };
__device__ __forceinline__ void item_load(const ItemDesc& d, int lane, ItemRegs& R) {
    const int kq = lane >> 4, nc = (lane & 15) * 4, c = lane & 7;
    const float* src = d.W + (size_t)(d.k0 + kq) * d.ldn + d.n0 + nc;
    const float* gp = d.g ? d.g + d.k0 + 8 * c : src;
    R.g0 = *(const GAS f32x4*)gp; R.g1 = *(const GAS f32x4*)(gp + 4);
#pragma unroll
    for (int i = 0; i < 16; ++i) R.v[i] = __builtin_nontemporal_load((const GAS f32x4*)(src + (size_t)(4 * i) * d.ldn));
}
__device__ __forceinline__ void item_finish(const ItemDesc& d, LAS float* scr, int lane, const ItemRegs& R) {
    const int kq = lane >> 4, nc = (lane & 15) * 4;
#pragma unroll
    for (int i = 0; i < 16; ++i) { LAS float* p = scr + (4 * i + kq) * 65 + nc; p[0] = R.v[i][0]; p[1] = R.v[i][1]; p[2] = R.v[i][2]; p[3] = R.v[i][3]; }
    int drow0 = d.n0;
    if (d.upmap) { const int bj = d.n0 / DFF, j = d.n0 - bj * DFF; drow0 = 256 * (j >> 7) + 128 * bj + (j & 127); }
    const int c = lane & 7;
    const f32x4 one4 = (f32x4){1.f, 1.f, 1.f, 1.f}; const f32x4 g0 = d.g ? R.g0 : one4, g1 = d.g ? R.g1 : one4;
    LDS_WAIT(); asm volatile("" ::: "memory");
#pragma unroll
    for (int j = 0; j < 8; ++j) { const int n = (lane >> 3) + 8 * j; const LAS float* s_ = scr + (8 * c) * 65 + n;
        v4u o; o.x = pk2(s_[0 * 65] * g0[0], s_[1 * 65] * g0[1]); o.y = pk2(s_[2 * 65] * g0[2], s_[3 * 65] * g0[3]); o.z = pk2(s_[4 * 65] * g1[0], s_[5 * 65] * g1[1]); o.w = pk2(s_[6 * 65] * g1[2], s_[7 * 65] * g1[3]);
        *(GAS v4u*)(d.WT + (size_t)(drow0 + n) * d.K + d.k0 + 8 * c) = o; }
    LDS_WAIT(); asm volatile("" ::: "memory");
}
constexpr int I_UP = (D / 64) * (NUP / 64), I_DN = (DFF / 64) * (D / 64), I_IN = (D / 64) * (NIN / 64), I_SQ = (D / 64) * (D / 64), I_P = (DPLE / 64) * (D / 64);
constexpr int I_LAYER = 2 * I_UP + 2 * I_DN + I_IN + 2 * I_SQ + I_P, I_SPLIT = 12544;
__device__ __forceinline__ ItemDesc decode_item(Frame& F, const Args& A, int l, int it) {
    ItemDesc d; int r = it, nblk;
    if (r < I_UP) { d.W = A.in[3] + (size_t)l * D * NUP; d.K = D; d.ldn = NUP; d.g = A.in[2] + l * D; d.WT = wptr(F, l, LW_UP1); d.upmap = 1; nblk = NUP / 64; }
    else if ((r -= I_UP) < I_DN) { d.W = A.in[4] + (size_t)l * DFF * D; d.K = DFF; d.ldn = D; d.g = nullptr; d.WT = wptr(F, l, LW_DN1); d.upmap = 0; nblk = D / 64; }
    else if ((r -= I_DN) < I_IN) { d.W = A.in[6] + (size_t)l * D * DIN; d.K = D; d.ldn = DIN; d.g = A.in[5] + l * D; d.WT = wptr(F, l, LW_IN); d.upmap = 0; nblk = NIN / 64; }
    else if ((r -= I_IN) < I_SQ) { d.W = A.in[12] + (size_t)l * D * D; d.K = D; d.ldn = D; d.g = nullptr; d.WT = wptr(F, l, LW_OUT); d.upmap = 0; nblk = D / 64; }
    else if ((r -= I_SQ) < I_UP) { d.W = A.in[14] + (size_t)l * D * NUP; d.K = D; d.ldn = NUP; d.g = A.in[13] + l * D; d.WT = wptr(F, l, LW_UP2); d.upmap = 1; nblk = NUP / 64; }
    else if ((r -= I_UP) < I_DN) { d.W = A.in[15] + (size_t)l * DFF * D; d.K = DFF; d.ldn = D; d.g = nullptr; d.WT = wptr(F, l, LW_DN2); d.upmap = 0; nblk = D / 64; }
    else if ((r -= I_DN) < I_SQ) { d.W = A.in[17] + (size_t)l * D * D; d.K = D; d.ldn = D; d.g = A.in[16] + l * D; d.WT = wptr(F, l, LW_G); d.upmap = 0; nblk = D / 64; }
    else { r -= I_SQ; d.W = A.in[18] + (size_t)l * DPLE * D; d.K = DPLE; d.ldn = D; d.g = nullptr; d.WT = wptr(F, l, LW_P); d.upmap = 0; nblk = D / 64; }
    const int kb = r / nblk; d.k0 = 64 * kb; d.n0 = 64 * (r - kb * nblk);
    return d;
}
__device__ __forceinline__ void convert_items_lw(Frame& F, const Args& A, int l, int it_lo, int it_hi, int wv, int nwv, int wave_, int lane_) {
    LAS float* scr = (LAS float*)(F.lds + wave_ * 16640);
    int it = it_lo + wv;
    if (it >= it_hi) return;
    ItemRegs R0, R1;
    ItemDesc d0 = decode_item(F, A, l, it), d1 = d0;
    item_load(d0, lane_, R0);
    for (;;) {
        const int n1 = it + nwv;
        if (n1 < it_hi) { d1 = decode_item(F, A, l, n1); item_load(d1, lane_, R1); }
        item_finish(d0, scr, lane_, R0);
        if (n1 >= it_hi) break;
        const int n2 = n1 + nwv;
        if (n2 < it_hi) { d0 = decode_item(F, A, l, n2); item_load(d0, lane_, R0); }
        item_finish(d1, scr, lane_, R1);
        if (n2 >= it_hi) break;
        it = n2;
    }
}
__device__ __forceinline__ void convert_items(Frame& F, const Args& A, int l, int it_lo, int it_hi, int wv, int nwv) { convert_items_lw(F, A, l, it_lo, it_hi, wv, nwv, F.wave, F.lane); }
__device__ __forceinline__ void convert_part(Frame& F, const Args& A, int l, int part, int wv, int nwv) {
    if (part) convert_items(F, A, l, I_SPLIT, I_LAYER - I_P, wv, nwv);
    else { convert_items(F, A, l, 0, I_SPLIT, wv, nwv); convert_items(F, A, l, I_LAYER - I_P, I_LAYER, wv, nwv); }
}
#ifndef CONV_NA
#define CONV_NA 3584
#define CONV_ND0 6400
#endif
constexpr int CONV_CH = 32;
constexpr int CQ_N1 = (I_LAYER - I_P - I_SPLIT) - CONV_NA, CQ_U1 = (CQ_N1 + CONV_CH - 1) / CONV_CH, CQ_U2 = (CONV_ND0 + CONV_CH - 1) / CONV_CH;
__device__ __forceinline__ void convert_tail(Frame& F, const Args& A, int l, int part, int bx) {
    OPAQUE_TID(F);
    if (l >= DEPTH) return;
    const int wv = (bx - 128) * NWAVES + F.wave, nwv = 128 * NWAVES;
    if (part) convert_items(F, A, l, I_SPLIT, I_SPLIT + CONV_NA, wv, nwv);
    else { convert_items(F, A, l, CONV_ND0, I_SPLIT, wv, nwv); convert_items(F, A, l, I_LAYER - I_P, I_LAYER, wv, nwv); }
    __syncthreads();
}
__device__ __forceinline__ void convert_queue_unit(Frame& F, const Args& A, int layer, int cu) {
    int l, lo, hi;
    if (cu < CQ_U1) { l = layer; lo = I_SPLIT + CONV_NA + cu * CONV_CH; hi = lo + CONV_CH < I_LAYER - I_P ? lo + CONV_CH : I_LAYER - I_P; }
    else { l = layer + 1; lo = (cu - CQ_U1) * CONV_CH; hi = lo + CONV_CH < CONV_ND0 ? lo + CONV_CH : CONV_ND0; }
    int w_ = F.wave0; asm volatile("" : "+s"(w_)); int l_; asm volatile("v_mbcnt_lo_u32_b32 %0, -1, 0\n\tv_mbcnt_hi_u32_b32 %0, -1, %0" : "=v"(l_));
    convert_items_lw(F, A, l, lo, hi, w_, NWAVES, w_, l_);
}
__device__ __forceinline__ void p0_prologue(Frame& F, const Args& A) {
    OPAQUE_TID(F);
    const int gw = F.vcu * NWAVES + F.wave, NGW = F.G * NWAVES;
    if (F.G == 256) convert_part(F, A, 0, 0, gw, NGW);
    else for (int l = 0; l < DEPTH; ++l) convert_items(F, A, l, 0, I_LAYER, gw, NGW);
    bf16* hb = (bf16*)(F.ws + WS_HB0); float* ssq = (float*)(F.ws + WS_SSQ0);
    for (int m0 = gw; m0 < M; m0 += 4 * NGW) {
        f32x4 xv[4][8];
#pragma unroll
        for (int r = 0; r < 4; ++r) { const int m = m0 + r * NGW < M ? m0 + r * NGW : m0; const GAS f32x4* xr = (const GAS f32x4*)(A.in[0] + (size_t)m * D) + F.lane;
#pragma unroll
            for (int j = 0; j < 8; ++j) xv[r][j] = xr[64 * j]; }
        asm volatile("" ::: "memory");
#pragma unroll
        for (int r = 0; r < 4; ++r) { const int m = m0 + r * NGW; if (m >= M) break;
            GAS v2u* br = (GAS v2u*)(hb + (size_t)m * D) + F.lane; float s = 0.f;
#pragma unroll
            for (int j = 0; j < 8; ++j) { const f32x4 v = xv[r][j]; v2u o; o.x = pk2(v[0], v[1]); o.y = pk2(v[2], v[3]); br[64 * j] = o;
                const float r0 = bflo(o.x), r1 = bfhi(o.x), r2 = bflo(o.y), r3 = bfhi(o.y); s += (r0 * r0 + r1 * r1) + (r2 * r2 + r3 * r3); }
            s = wave_sum(s);
            if (F.lane < 32) ssq[(size_t)m * 32 + F.lane] = F.lane == 0 ? s : 0.f; }
    }
    { const size_t n8 = (size_t)DEPTH * M * DPLE / 8, st = (size_t)NGW * 64; const float* p = A.in[1]; bf16* pb = (bf16*)(F.ws + WS_PB);
      for (size_t i0 = (size_t)gw * 64 + F.lane; i0 < n8; i0 += 8 * st) {
          f32x4 a[8], b[8];
#pragma unroll
          for (int u = 0; u < 8; ++u) { const size_t i = i0 + u * st < n8 ? i0 + u * st : i0; a[u] = *(const GAS f32x4*)(p + i * 8); b[u] = *(const GAS f32x4*)(p + i * 8 + 4); }
          asm volatile("" ::: "memory");
#pragma unroll
          for (int u = 0; u < 8; ++u) { const size_t i = i0 + u * st; if (i >= n8) break;
              v4u o; o.x = pk2(a[u][0], a[u][1]); o.y = pk2(a[u][2], a[u][3]); o.z = pk2(b[u][0], b[u][1]); o.w = pk2(b[u][2], b[u][3]); *(GAS v4u*)(pb + i * 8) = o; } } }
}

__device__ __forceinline__ void gates_phase(Frame& F, const Args& A, int layer, const float* ssq, const bf16* hbs) {
    OPAQUE_TID(F);
    const float* w = A.in[6] + (size_t)layer * D * DIN + NIN; const float* g = A.in[5] + layer * D; float* gates = (float*)(F.ws + WS_GATES);
    LAS float* Wt = (LAS float*)F.lds;
    __syncthreads();
    { float gk[4]; f32x4 w0[4], w1[4];
#pragma unroll
      for (int i = 0; i < 4; ++i) { const int k = F.tid + 512 * i; gk[i] = g[k]; w0[i] = *(const GAS f32x4*)(w + (size_t)k * DIN); w1[i] = *(const GAS f32x4*)(w + (size_t)k * DIN + 4); }
      asm volatile("" ::: "memory");
#pragma unroll
      for (int i = 0; i < 4; ++i) { const int k = F.tid + 512 * i;
#pragma unroll
        for (int j = 0; j < 4; ++j) { Wt[j * 2048 + k] = w0[i][j] * gk[i]; Wt[(4 + j) * 2048 + k] = w1[i][j] * gk[i]; } } }
    __syncthreads();
    for (int rg = F.vcu; rg < M / 32; rg += F.G) {
        const int row0 = rg * 32 + F.wave * 4;
        float sqv[4];
#pragma unroll
        for (int r = 0; r < 4; ++r) sqv[r] = F.lane < 32 ? ssq[(size_t)(row0 + r) * 32 + F.lane] : 0.f;
        float acc[4][8];
#pragma unroll
        for (int r = 0; r < 4; ++r)
#pragma unroll
            for (int j = 0; j < 8; ++j) acc[r][j] = 0.f;
        v2u hw[8][4];
#pragma unroll
        for (int i = 0; i < 8; ++i)
#pragma unroll
            for (int r = 0; r < 4; ++r) hw[i][r] = *(const GAS v2u*)(hbs + (size_t)(row0 + r) * D + 4 * F.lane + 256 * i);
        asm volatile("" ::: "memory");
#pragma unroll
        for (int i = 0; i < 8; ++i) {
            f32x4 hv[4];
#pragma unroll
            for (int r = 0; r < 4; ++r) hv[r] = (f32x4){bflo(hw[i][r].x), bfhi(hw[i][r].x), bflo(hw[i][r].y), bfhi(hw[i][r].y)};
#pragma unroll
            for (int j = 0; j < 8; ++j) { const f32x4 wv_ = *(const LAS f32x4*)(Wt + j * 2048 + 4 * F.lane + 256 * i);
#pragma unroll
                for (int r = 0; r < 4; ++r) acc[r][j] += (hv[r][0] * wv_[0] + hv[r][1] * wv_[1]) + (hv[r][2] * wv_[2] + hv[r][3] * wv_[3]); }
        }
        float val = 0.f;
#pragma unroll
        for (int r = 0; r < 4; ++r) {
            const float sq = wave_sum(sqv[r]);
            const float rstd = __builtin_amdgcn_rsqf(sq * (1.0f / D) + RMS_EPS);
#pragma unroll
            for (int j = 0; j < 8; ++j) { const float t_ = wave_sum(acc[r][j]) * rstd; if (F.lane == r * 8 + j) val = t_; }
        }
        if (F.lane < 32) { const int j = F.lane & 7; const float bias = j < 4 ? A.in[9][layer * 4 + j] : A.in[10][layer * 4 + j - 4]; gates[(size_t)row0 * 8 + F.lane] = val + bias; }
    }
    __syncthreads();
}
__device__ __forceinline__ void final_norm(Frame& F, const Args& A) {
    OPAQUE_TID(F);
    const int gw = F.vcu * NWAVES + F.wave, NGW = F.G * NWAVES; const float* g = A.in[19];
    const bf16* hfin = (const bf16*)(F.ws + ((DEPTH & 1) ? WS_HB1 : WS_HB0));
    f32x4 gv[8];
#pragma unroll
    for (int j = 0; j < 8; ++j) gv[j] = *((const GAS f32x4*)g + F.lane + 64 * j);
    for (int m0 = gw; m0 < M; m0 += 4 * NGW) {
        v2u hw[4][8];
#pragma unroll
        for (int r = 0; r < 4; ++r) { const int m = m0 + r * NGW < M ? m0 + r * NGW : m0; const GAS v2u* br = (const GAS v2u*)(hfin + (size_t)m * D) + F.lane;
#pragma unroll
            for (int j = 0; j < 8; ++j) hw[r][j] = br[64 * j]; }
        asm volatile("" ::: "memory");
#pragma unroll
        for (int r = 0; r < 4; ++r) { const int m = m0 + r * NGW; if (m >= M) break;
            GAS f32x4* hr = (GAS f32x4*)(F.out + (size_t)m * D) + F.lane; f32x4 v[8]; float s = 0.f;
#pragma unroll
            for (int j = 0; j < 8; ++j) { v[j] = (f32x4){bflo(hw[r][j].x), bfhi(hw[r][j].x), bflo(hw[r][j].y), bfhi(hw[r][j].y)}; s += (v[j][0] * v[j][0] + v[j][1] * v[j][1]) + (v[j][2] * v[j][2] + v[j][3] * v[j][3]); }
            const float rstd = 1.0f / sqrtf(wave_sum(s) * (1.0f / D) + RMS_EPS);
#pragma unroll
            for (int j = 0; j < 8; ++j) hr[64 * j] = v[j] * rstd * gv[j]; }
    }
}


namespace att {
typedef short bf16x8 __attribute__((ext_vector_type(8)));
typedef short s16x4 __attribute__((ext_vector_type(4)));
constexpr int KP = 272, VP = 288, OFF_K0 = 0, OFF_K1 = 64 * KP, OFF_V0 = 128 * KP, OFF_V1 = 128 * KP + 64 * VP, OFF_MISC = 128 * KP + 128 * VP, OFF_KM = 73728;
constexpr float NEG = -1.0e30f, MASKED = -2.0e30f;
struct TileRegs { v4u k[2], v[2]; };
__device__ __forceinline__ void tile_load(TileRegs& R, const bf16* kbase, const bf16* vbase, size_t stride, int key0, int nkeys, int tid) {
#pragma unroll
    for (int i = 0; i < 2; ++i) { const int c = tid + 512 * i, row = c >> 4, ch = c & 15; int key = key0 + row; key = key < 0 ? 0 : (key >= nkeys ? nkeys - 1 : key);
        R.k[i] = *(const GAS v4u*)(kbase + (size_t)key * stride + ch * 8); R.v[i] = *(const GAS v4u*)(vbase + (size_t)key * stride + ch * 8); }
}
__device__ __forceinline__ void tile_store(LAS unsigned char* lds, int buf, const TileRegs& R, int tid) {
#pragma unroll
    for (int i = 0; i < 2; ++i) { const int c = tid + 512 * i, row = c >> 4, ch = c & 15;
        *(LAS v4u*)(lds + (buf ? OFF_K1 : OFF_K0) + row * KP + ch * 16) = R.k[i]; *(LAS v4u*)(lds + (buf ? OFF_V1 : OFF_V0) + row * VP + ch * 16) = R.v[i]; }
}
__device__ __forceinline__ float quad_max(float x) { return wv::quad_max(x); }
__device__ __forceinline__ float quad_sum(float x) { return wv::quad_sum(x); }
__device__ __forceinline__ void qk_tile(const LAS unsigned char* kt, const bf16x8 (&Qf)[4], int fr, int g, f32x4 (&s)[4]) {
    bf16x8 kf[4][4];
#pragma unroll
    for (int kb = 0; kb < 4; ++kb)
#pragma unroll
        for (int ks = 0; ks < 4; ++ks) kf[kb][ks] = *(const LAS bf16x8*)(kt + (16 * kb + fr) * KP + (4 * ks + g) * 16);
#pragma unroll
    for (int kb = 0; kb < 4; ++kb) s[kb] = (f32x4){0.f, 0.f, 0.f, 0.f};
#pragma unroll
    for (int ks = 0; ks < 4; ++ks)
#pragma unroll
        for (int kb = 0; kb < 4; ++kb) s[kb] = __builtin_amdgcn_mfma_f32_16x16x32_bf16(kf[kb][ks], Qf[ks], s[kb], 0, 0, 0);
}
__device__ __forceinline__ void pv_tile(const LAS unsigned char* vt, const f32x4 (&p)[4], int fr, int g, f32x4 (&O)[8]) {
    const int q = fr >> 2, pp = fr & 3;
#pragma unroll
    for (int t = 0; t < 2; ++t) {
        bf16x8 pf; { v4u w; w.x = pg8::cvt_pk_bf16(p[2 * t][0], p[2 * t][1]); w.y = pg8::cvt_pk_bf16(p[2 * t][2], p[2 * t][3]); w.z = pg8::cvt_pk_bf16(p[2 * t + 1][0], p[2 * t + 1][1]); w.w = pg8::cvt_pk_bf16(p[2 * t + 1][2], p[2 * t + 1][3]); pf = __builtin_bit_cast(bf16x8, w); }
        const LAS unsigned char* base = vt + (32 * t + 4 * g + q) * VP + 8 * pp;
        s16x4 lo[8], hi[8];
#pragma unroll
        for (int db = 0; db < 8; ++db) { lo[db] = __builtin_amdgcn_ds_read_tr16_b64_v4i16((LAS s16x4*)(base + db * 32)); hi[db] = __builtin_amdgcn_ds_read_tr16_b64_v4i16((LAS s16x4*)(base + 16 * VP + db * 32)); }
#pragma unroll
        for (int db = 0; db < 8; ++db) { const bf16x8 vf = __builtin_shufflevector(lo[db], hi[db], 0, 1, 2, 3, 4, 5, 6, 7); O[db] = __builtin_amdgcn_mfma_f32_16x16x32_bf16(vf, pf, O[db], 0, 0, 0); }
    }
}
__device__ __forceinline__ void softmax_step(f32x4 (&sc)[4], float& m, float& lsum, f32x4 (&O)[8]) {
    float tm = fmaxf(fmaxf(sc[0][0], sc[0][1]), fmaxf(sc[0][2], sc[0][3]));
#pragma unroll
    for (int kb = 1; kb < 4; ++kb) tm = fmaxf(tm, fmaxf(fmaxf(sc[kb][0], sc[kb][1]), fmaxf(sc[kb][2], sc[kb][3])));
    tm = quad_max(tm);
    const float mn = fmaxf(m, tm), alpha = __builtin_amdgcn_exp2f(m - mn); float ps = 0.f;
#pragma unroll
    for (int kb = 0; kb < 4; ++kb)
#pragma unroll
        for (int r = 0; r < 4; ++r) { const float pv = __builtin_amdgcn_exp2f(sc[kb][r] - mn); sc[kb][r] = pv; ps += pv; }
    lsum = lsum * alpha + ps; m = mn;
#pragma unroll
    for (int db = 0; db < 8; ++db) O[db] = O[db] * alpha;
}
__device__ __forceinline__ void load_q(bf16x8 (&Qf)[4], const bf16* qrow, int g) {
#pragma unroll
    for (int ks = 0; ks < 4; ++ks) Qf[ks] = __builtin_bit_cast(bf16x8, *(const GAS v4u*)(qrow + 32 * ks + 8 * g));
}


template <class MaskF>
__device__ __forceinline__ void tile_step(const LAS unsigned char* kt, const LAS unsigned char* vt, const bf16x8 (&Qf)[2][4], int fr, int g, float (&m)[2], float (&lsum)[2], f32x4 (&O)[2][8], const MaskF& maskf) {
    f32x4 s[2][4];
    {
#pragma unroll
        for (int ga = 0; ga < 2; ++ga)
#pragma unroll
            for (int kb = 0; kb < 4; ++kb) s[ga][kb] = (f32x4){0.f, 0.f, 0.f, 0.f};
#pragma unroll
        for (int ks = 0; ks < 4; ++ks) {
            bf16x8 kf[4];
#pragma unroll
            for (int kb = 0; kb < 4; ++kb) kf[kb] = *(const LAS bf16x8*)(kt + (16 * kb + fr) * KP + (4 * ks + g) * 16);
#pragma unroll
            for (int kb = 0; kb < 4; ++kb) { s[0][kb] = __builtin_amdgcn_mfma_f32_16x16x32_bf16(kf[kb], Qf[0][ks], s[0][kb], 0, 0, 0); s[1][kb] = __builtin_amdgcn_mfma_f32_16x16x32_bf16(kf[kb], Qf[1][ks], s[1][kb], 0, 0, 0); }
        }
    }
#pragma unroll
    for (int ga = 0; ga < 2; ++ga) {
#pragma unroll
        for (int kb = 0; kb < 4; ++kb)
#pragma unroll
            for (int r = 0; r < 4; ++r) s[ga][kb][r] = maskf(ga, kb, r, s[ga][kb][r]);
        softmax_step(s[ga], m[ga], lsum[ga], O[ga]);
    }
    const int q = fr >> 2, pp = fr & 3;
#pragma unroll
    for (int t = 0; t < 2; ++t) {
        bf16x8 pf[2];
#pragma unroll
        for (int ga = 0; ga < 2; ++ga) { v4u w; w.x = pg8::cvt_pk_bf16(s[ga][2 * t][0], s[ga][2 * t][1]); w.y = pg8::cvt_pk_bf16(s[ga][2 * t][2], s[ga][2 * t][3]); w.z = pg8::cvt_pk_bf16(s[ga][2 * t + 1][0], s[ga][2 * t + 1][1]); w.w = pg8::cvt_pk_bf16(s[ga][2 * t + 1][2], s[ga][2 * t + 1][3]); pf[ga] = __builtin_bit_cast(bf16x8, w); }
        const LAS unsigned char* base = vt + (32 * t + 4 * g + q) * VP + 8 * pp;
#pragma unroll
        for (int db = 0; db < 8; ++db) { const s16x4 lo = __builtin_amdgcn_ds_read_tr16_b64_v4i16((LAS s16x4*)(base + db * 32)), hi = __builtin_amdgcn_ds_read_tr16_b64_v4i16((LAS s16x4*)(base + 16 * VP + db * 32));
            const bf16x8 vf = __builtin_shufflevector(lo, hi, 0, 1, 2, 3, 4, 5, 6, 7);
            O[0][db] = __builtin_amdgcn_mfma_f32_16x16x32_bf16(vf, pf[0], O[0][db], 0, 0, 0); O[1][db] = __builtin_amdgcn_mfma_f32_16x16x32_bf16(vf, pf[1], O[1][db], 0, 0, 0); }
    }
}

__device__ __forceinline__ void moba_unit(LAS unsigned char* lds, const bf16* z, const float* kmean, bf16* mixed, float* pbuf, float* plse, int bh, int cur, int part, int tid) {
    const int lane = tid & 63, w = __builtin_amdgcn_readfirstlane(tid >> 6), fr = lane & 15, g = lane >> 4;
    const int b = bh >> 2, hh = bh & 3, q0 = 256 * cur;
    const bf16* zb = z + (size_t)b * T * NIN;
    const float slope2 = exp2f(-(float)(2 * hh + 1)) * LOG2E, c1 = 0.08838834764831845f * LOG2E;
    int t[2]; bf16x8 Qf[2][4]; unsigned sel[2];
    const int nown = part == 0 ? 4 : 0, pb_lo = part == 0 ? 0 : 3 * part - 1, pb_hi_ = part == 0 ? 2 : 3 * part + 2, pb_hi = pb_hi_ < cur ? pb_hi_ : cur;
    const int npast = pb_hi > pb_lo ? 4 * (pb_hi - pb_lo) : 0, ntl = nown + npast;
    auto tile_key0 = [&](int i) -> int { return i < nown ? q0 + 64 * i : pb_lo * 256 + 64 * (i - nown); };
    const bf16* kbase = zb + ZKA + hh * 128; const bf16* vbase = zb + ZVA + hh * 128;
    TileRegs R; tile_load(R, kbase, vbase, NIN, tile_key0(0), T, tid);
#pragma unroll
    for (int ga = 0; ga < 2; ++ga) { t[ga] = q0 + 32 * w + 16 * ga + fr; load_q(Qf[ga], zb + (size_t)t[ga] * NIN + ZQA + hh * 128, g); }
    f32x4 kmv = (f32x4){0.f, 0.f, 0.f, 0.f};
    if (tid < 256) kmv = *(const GAS f32x4*)(kmean + (size_t)bh * 1024 + 4 * tid);
    f32x4 O[2][8];
#pragma unroll
    for (int ga = 0; ga < 2; ++ga)
#pragma unroll
        for (int db = 0; db < 8; ++db) O[ga][db] = (f32x4){0.f, 0.f, 0.f, 0.f};
    float m[2] = {NEG, NEG}, lsum[2] = {0.f, 0.f};
    __syncthreads();
    tile_store(lds, 0, R, tid);
    if (tid < 256) *(LAS f32x4*)(lds + OFF_KM + 16 * tid) = kmv;
    __syncthreads();
    if (1 < ntl) tile_load(R, kbase, vbase, NIN, tile_key0(1), T, tid);
    {
        float gt[2][8];
#pragma unroll
        for (int n = 0; n < 8; ++n) { float a0 = 0.f, a1 = 0.f; const LAS unsigned char* km = lds + OFF_KM + (n * 128 + 8 * g) * 4;
#pragma unroll
            for (int ks = 0; ks < 4; ++ks) { const f32x4 k0 = *(const LAS f32x4*)(km + 128 * ks), k1 = *(const LAS f32x4*)(km + 128 * ks + 16);
                const v4u qa = __builtin_bit_cast(v4u, Qf[0][ks]), qb = __builtin_bit_cast(v4u, Qf[1][ks]);
                a0 += (bflo(qa.x) * k0[0] + bfhi(qa.x) * k0[1]) + (bflo(qa.y) * k0[2] + bfhi(qa.y) * k0[3]) + (bflo(qa.z) * k1[0] + bfhi(qa.z) * k1[1]) + (bflo(qa.w) * k1[2] + bfhi(qa.w) * k1[3]);
                a1 += (bflo(qb.x) * k0[0] + bfhi(qb.x) * k0[1]) + (bflo(qb.y) * k0[2] + bfhi(qb.y) * k0[3]) + (bflo(qb.z) * k1[0] + bfhi(qb.z) * k1[1]) + (bflo(qb.w) * k1[2] + bfhi(qb.w) * k1[3]); }
            a0 = quad_sum(a0); a1 = quad_sum(a1); gt[0][n] = n < cur ? a0 : NEG; gt[1][n] = n < cur ? a1 : NEG; }
        const int nsel = cur < 3 ? cur : 3;
#pragma unroll
        for (int ga = 0; ga < 2; ++ga) { unsigned sl = 0u;
            for (int k = 0; k < nsel; ++k) { float best = 0.f; int bi = -1;
#pragma unroll
                for (int n = 0; n < 8; ++n) { const bool ok = n < cur && !((sl >> n) & 1u) && (bi < 0 || gt[ga][n] > best); if (ok) { best = gt[ga][n]; bi = n; } }
                sl |= 1u << bi; }
            sel[ga] = sl; }
    }
    for (int i = 0; i < ntl; ++i) {
        const int key0 = tile_key0(i), nb = key0 >> 8;
        const bool skip = nb == cur && key0 > q0 + 32 * w + 31;
        if (!skip) {
            const LAS unsigned char* kt = lds + ((i & 1) ? OFF_K1 : OFF_K0); const LAS unsigned char* vt = lds + ((i & 1) ? OFF_V1 : OFF_V0);
            float base[2]; int lim[2];
#pragma unroll
            for (int ga = 0; ga < 2; ++ga) { const int cl = t[ga] - key0 - 4 * g; base[ga] = -slope2 * (float)cl; lim[ga] = nb == cur ? cl : (((sel[ga] >> nb) & 1u) ? 9999 : -1); }
            tile_step(kt, vt, Qf, fr, g, m, lsum, O, [&](int ga, int kb, int r, float sv) -> float { const float v = fmaf((float)(16 * kb + r), slope2, fmaf(sv, c1, base[ga])); return (16 * kb + r <= lim[ga]) ? v : MASKED; });
        }
        if (i + 1 < ntl) tile_store(lds, (i + 1) & 1, R, tid);
        __syncthreads();
        if (i + 2 < ntl) tile_load(R, kbase, vbase, NIN, tile_key0(i + 2), T, tid);
    }
    const bool direct = cur <= 2;
#pragma unroll
    for (int ga = 0; ga < 2; ++ga) {
        const float ls = quad_sum(lsum[ga]); const float inv = ls > 0.f ? 1.0f / ls : 0.f; const size_t row = (size_t)b * T + t[ga];
        if (direct) { bf16* orow = mixed + row * D + hh * 128 + 4 * g;
#pragma unroll
            for (int db = 0; db < 8; ++db) { v2u o; o.x = pg8::cvt_pk_bf16(O[ga][db][0] * inv, O[ga][db][1] * inv); o.y = pg8::cvt_pk_bf16(O[ga][db][2] * inv, O[ga][db][3] * inv); *(GAS v2u*)(orow + 16 * db) = o; } }
        else { bf16* orow = (bf16*)pbuf + ((size_t)part * M + row) * 512 + hh * 128 + 4 * g;
#pragma unroll
            for (int db = 0; db < 8; ++db) { v2u o; o.x = pg8::cvt_pk_bf16(O[ga][db][0] * inv, O[ga][db][1] * inv); o.y = pg8::cvt_pk_bf16(O[ga][db][2] * inv, O[ga][db][3] * inv); *(GAS v2u*)(orow + 16 * db) = o; }
            if (g == 0) plse[((size_t)part * M + row) * 4 + hh] = ls > 0.f ? m[ga] + __builtin_amdgcn_logf(ls) : NEG; }
    }
}

__device__ __forceinline__ void dil_unit(LAS unsigned char* lds, const bf16* z, float* obuf, float* lsebuf, int bh, int p, int r, int qt, int tid) {
    const int lane = tid & 63, w = __builtin_amdgcn_readfirstlane(tid >> 6), fr = lane & 15, g = lane >> 4;
    const int b = bh >> 2, hh = bh & 3, dil = p == 0 ? 1 : (p == 1 ? 4 : 16), L = T / dil, u0 = 256 * qt;
    const bf16* zb = z + ((size_t)b * T + r) * NIN; const size_t stride = (size_t)dil * NIN;
    const float slope2 = exp2f(-(float)(2 * hh + 2)) * LOG2E * (float)dil, c1 = 0.08838834764831845f * LOG2E;
    int uq[2]; bf16x8 Qf[2][4];
#pragma unroll
    for (int ga = 0; ga < 2; ++ga) { uq[ga] = u0 + 32 * w + 16 * ga + fr; const int uc = uq[ga] < L ? uq[ga] : L - 1; load_q(Qf[ga], zb + (size_t)uc * stride + ZQC + hh * 128, g); }
    const bf16* kbase = zb + ZKC + hh * 128; const bf16* vbase = zb + ZVC + hh * 128;
    f32x4 O[2][8];
#pragma unroll
    for (int ga = 0; ga < 2; ++ga)
#pragma unroll
        for (int db = 0; db < 8; ++db) O[ga][db] = (f32x4){0.f, 0.f, 0.f, 0.f};
    float m[2] = {NEG, NEG}, lsum[2] = {0.f, 0.f};
    const int j0 = u0 >= 128 ? 0 : 2, qend = u0 + 256 < L ? u0 + 256 : L, j1 = (qend - (u0 - 128) + 63) >> 6;
    TileRegs R; tile_load(R, kbase, vbase, stride, u0 - 128 + 64 * j0, L, tid);
    __syncthreads();
    tile_store(lds, 0, R, tid);
    __syncthreads();
    const int uw = u0 + 32 * w;
    for (int j = j0; j < j1; ++j) {
        const int key0 = u0 - 128 + 64 * j, bi = (j - j0) & 1;
        if (j + 1 < j1) tile_load(R, kbase, vbase, stride, key0 + 64, L, tid);
        const bool skip = (key0 > uw + 31) || (key0 + 63 < uw - 128) || uw >= L;
        if (!skip) {
            int d0[2]; float base[2];
#pragma unroll
            for (int ga = 0; ga < 2; ++ga) { d0[ga] = uq[ga] - key0 - 4 * g; base[ga] = -slope2 * (float)d0[ga]; }
            tile_step(lds + (bi ? OFF_K1 : OFF_K0), lds + (bi ? OFF_V1 : OFF_V0), Qf, fr, g, m, lsum, O,
                      [&](int ga, int kb, int rr, float sv) -> float { const int d = d0[ga] - (16 * kb + rr); const float v = fmaf((float)(16 * kb + rr), slope2, fmaf(sv, c1, base[ga])); return (d >= 0 && d <= 128) ? v : MASKED; });
        }
        if (j + 1 < j1) tile_store(lds, bi ^ 1, R, tid);
        __syncthreads();
    }
#pragma unroll
    for (int ga = 0; ga < 2; ++ga) {
        const float ls = quad_sum(lsum[ga]);
        if (uq[ga] < L) {
            const float inv = 1.0f / ls; const size_t row = (size_t)b * T + (size_t)uq[ga] * dil + r;
            bf16* orow = (bf16*)obuf + ((size_t)p * M + row) * 512 + hh * 128 + 4 * g;
#pragma unroll
            for (int db = 0; db < 8; ++db) { v2u o; o.x = pg8::cvt_pk_bf16(O[ga][db][0] * inv, O[ga][db][1] * inv); o.y = pg8::cvt_pk_bf16(O[ga][db][2] * inv, O[ga][db][3] * inv); *(GAS v2u*)(orow + 16 * db) = o; }
            if (g == 0) lsebuf[((size_t)p * M + row) * 4 + hh] = m[ga] + __builtin_amdgcn_logf(ls);
        }
    }
}
}

__device__ __forceinline__ void dil_combine(Frame& F) {
    OPAQUE_TID(F);
    const float* obuf = (const float*)(F.ws + WS_DOUT); const float* lse = (const float*)(F.ws + WS_DLSE); bf16* mixed = (bf16*)(F.ws + WS_MIXED);
    const float* pbuf = (const float*)(F.ws + WS_MOUT); const float* plse = (const float*)(F.ws + WS_MLSE);
    const size_t gt = (size_t)F.vcu * 512 + F.tid, NT = (size_t)F.G * 512;
    for (size_t i0 = gt; i0 < (size_t)M * 128; i0 += 4 * NT) {
        const bf16* o0_[4]; const bf16* o1_[4]; const bf16* o2_[4]; const float* l0_[4]; const float* l1_[4]; const float* l2_[4]; bool on_[4], three_[4]; size_t dst_[4];
#pragma unroll
        for (int k = 0; k < 4; ++k) {
            const size_t i = i0 + (size_t)k * NT; bool on = i < (size_t)M * 128;
            const bool mo = on && i >= (size_t)M * 64; const size_t ii = on ? (mo ? i - (size_t)M * 64 : i) : 0;
            size_t row = ii >> 6; int c8 = (int)(ii & 63); int np = 3;
            if (mo) { const int cur = (int)((row & (T - 1)) >> 8); if (cur <= 2) on = false; np = cur <= 5 ? 2 : 3; }
            const bool mox = mo && on; if (!on) { row = 0; c8 = 0; np = 3; }
            const int hh = c8 >> 4; const bf16* ob = (const bf16*)(mox ? pbuf : obuf); const float* lb = mox ? plse : lse;
            on_[k] = on; three_[k] = np == 3; dst_[k] = row * D + (mox ? 0 : 1536) + c8 * 8;
            l0_[k] = lb + (0 * (size_t)M + row) * 4 + hh; l1_[k] = lb + (1 * (size_t)M + row) * 4 + hh; l2_[k] = lb + ((np == 3 ? 2 : 1) * (size_t)M + row) * 4 + hh;
            o0_[k] = ob + (0 * (size_t)M + row) * 512 + c8 * 8; o1_[k] = ob + (1 * (size_t)M + row) * 512 + c8 * 8; o2_[k] = ob + ((np == 3 ? 2 : 1) * (size_t)M + row) * 512 + c8 * 8;
        }
        float lv[4][3]; v4u ow[4][3];
#pragma unroll
        for (int k = 0; k < 4; ++k) { lv[k][0] = *(const GAS float*)l0_[k]; lv[k][1] = *(const GAS float*)l1_[k]; lv[k][2] = *(const GAS float*)l2_[k];
            ow[k][0] = *(const GAS v4u*)o0_[k]; ow[k][1] = *(const GAS v4u*)o1_[k]; ow[k][2] = *(const GAS v4u*)o2_[k]; }
#pragma unroll
        for (int k = 0; k < 4; ++k) {
            const float l0 = lv[k][0], l1 = lv[k][1], l2 = three_[k] ? lv[k][2] : att::NEG;
            const float mx = fmaxf(l0, fmaxf(l1, l2)); float w0 = __builtin_amdgcn_exp2f(l0 - mx), w1 = __builtin_amdgcn_exp2f(l1 - mx), w2 = three_[k] ? __builtin_amdgcn_exp2f(l2 - mx) : 0.f;
            const float inv = 1.0f / (w0 + w1 + w2); w0 *= inv; w1 *= inv; w2 *= inv;
            f32x4 av, bv;
            { const v4u x = ow[k][0], y = ow[k][1], z_ = ow[k][2];
              av[0] = bflo(x.x) * w0 + bflo(y.x) * w1 + bflo(z_.x) * w2; av[1] = bfhi(x.x) * w0 + bfhi(y.x) * w1 + bfhi(z_.x) * w2; av[2] = bflo(x.y) * w0 + bflo(y.y) * w1 + bflo(z_.y) * w2; av[3] = bfhi(x.y) * w0 + bfhi(y.y) * w1 + bfhi(z_.y) * w2;
              bv[0] = bflo(x.z) * w0 + bflo(y.z) * w1 + bflo(z_.z) * w2; bv[1] = bfhi(x.z) * w0 + bfhi(y.z) * w1 + bfhi(z_.z) * w2; bv[2] = bflo(x.w) * w0 + bflo(y.w) * w1 + bflo(z_.w) * w2; bv[3] = bfhi(x.w) * w0 + bfhi(y.w) * w1 + bfhi(z_.w) * w2; }
            if (on_[k]) { v4u o; o.x = pg8::cvt_pk_bf16(av[0], av[1]); o.y = pg8::cvt_pk_bf16(av[2], av[3]); o.z = pg8::cvt_pk_bf16(bv[0], bv[1]); o.w = pg8::cvt_pk_bf16(bv[2], bv[3]);
                *(GAS v4u*)(mixed + dst_[k]) = o; }
        }
    }
}
__device__ __forceinline__ void attn_phase(Frame& F, const Args& A, int layer, int nconv) {
    OPAQUE_TID(F);
    const bf16* z = (const bf16*)(F.ws + WS_Z); const float* kmean = (const float*)(F.ws + WS_KMEAN); bf16* mixed = (bf16*)(F.ws + WS_MIXED);
    float* obuf = (float*)(F.ws + WS_DOUT); float* lse = (float*)(F.ws + WS_DLSE); float* pbuf = (float*)(F.ws + WS_MOUT); float* plse = (float*)(F.ws + WS_MLSE);
    unsigned* qctr = (unsigned*)(F.ctl + CW_QUEUE + 64 * layer);
    LAS unsigned* slot = (LAS unsigned*)(F.lds + att::OFF_MISC + 64);
    const int R = 752 - 256 + nconv;
    int idx = F.vcu;
    while (idx < 752 + nconv) {
        int u = idx, cu = -1;
        if (idx >= 256 && nconv > 0) { const int j = idx - 256; const int c0 = (int)(((long)j * nconv) / R), c1 = (int)(((long)(j + 1) * nconv) / R); if (c1 > c0) cu = c0; else u = 256 + j - c0; }
        if (cu >= 0) convert_queue_unit(F, A, layer, cu);
        else {
        const int bh = u & 15; int k = u >> 4;
        bool is_moba; int p0, p1, p2 = 0;
        if (k < 9) { is_moba = true; p0 = (int)((0x776655432ull >> (4 * k)) & 15ull); p1 = (0x150 >> k) & 1; }
        else if (k < 20) { is_moba = false; k -= 9; if (k < 7) { p0 = 0; p1 = 0; p2 = k + 1; } else { p0 = 1; p1 = k - 7; p2 = 1; } }
        else if (k < 23) { is_moba = true; k -= 20; p0 = k == 0 ? 1 : (k == 1 ? 4 : 7); p1 = k; }
        else if (k < 26) { is_moba = true; k -= 23; p0 = 3 * k; p1 = k; }
        else if (k < 31) { is_moba = false; k -= 26; if (k == 0) { p0 = 0; p1 = 0; } else { p0 = 1; p1 = k - 1; } }
        else { is_moba = false; p0 = 2; p1 = k - 31; }
        int tid_ = F.tid; asm volatile("" : "+v"(tid_));
        if (is_moba) att::moba_unit(F.lds, z, kmean, mixed, pbuf, plse, bh, p0, p1, tid_);
        else att::dil_unit(F.lds, z, obuf, lse, bh, p0, p1, p2, tid_);
        }
        __syncthreads();
        if (F.tid == 0) *slot = (unsigned)F.G + __hip_atomic_fetch_add(qctr, 1u, __ATOMIC_RELAXED, __HIP_MEMORY_SCOPE_AGENT);
        __syncthreads();
        idx = (int)*slot;
        __syncthreads();
    }
}


namespace ml {
typedef short bf16x8 __attribute__((ext_vector_type(8)));
typedef short s16x4 __attribute__((ext_vector_type(4)));
typedef float f32x2_t __attribute__((ext_vector_type(2)));
constexpr int CH = 128, NCH = T / CH;
constexpr int KP = 288, VP = 544, KRP = 272;
constexpr int OFF_KT = 0, OFF_VT = CH * KP, OFF_SM = OFF_VT + CH * VP;
__device__ __forceinline__ bf16x8 tr_frag(const LAS unsigned char* p, int pitch) {
    const s16x4 lo = __builtin_amdgcn_ds_read_tr16_b64_v4i16((LAS s16x4*)p), hi = __builtin_amdgcn_ds_read_tr16_b64_v4i16((LAS s16x4*)(p + 16 * pitch));
    return __builtin_shufflevector(lo, hi, 0, 1, 2, 3, 4, 5, 6, 7);
}
__device__ __forceinline__ float fexp(float x) { return __builtin_amdgcn_exp2f(x * LOG2E); }
__device__ __forceinline__ float logsig(float x) { return fminf(x, 0.f) - 0.6931471805599453f * __builtin_amdgcn_logf(1.0f + fexp(-fabsf(x))); }

__device__ __forceinline__ void m1_unit(LAS unsigned char* lds, const Args& A, unsigned char* ws, int layer, int unit, int tid) {
    const int lane = tid & 63, w = __builtin_amdgcn_readfirstlane(tid >> 6), fr = lane & 15, g = lane >> 4;
    const int bh = unit / NCH, c = unit - bh * NCH, b = bh >> 2, hh = bh & 3, t0 = c * CH;
    const bf16* z = (const bf16*)(ws + WS_Z); const float* gates = (const float*)(ws + WS_GATES);
    bf16* qc = (bf16*)(ws + WS_QC); bf16* kc = (bf16*)(ws + WS_KC);
    float* bq = (float*)(ws + WS_BQ); float* aq = (float*)(ws + WS_AQ); float* blast = (float*)(ws + WS_BLAST); float* amaxp = (float*)(ws + WS_AMAX);
    float* dCT = (float*)(ws + WS_DCT) + (size_t)unit * 32768; float* dn = (float*)(ws + WS_DN) + (size_t)unit * 128;
    LAS float* wl = (LAS float*)(lds + OFF_SM);
    __syncthreads();
    v4u vr[8];
#pragma unroll
    for (int i = 0; i < 8; ++i) { const int cc = tid + 512 * i, row = cc >> 5, ch = cc & 31; vr[i] = *(const GAS v4u*)(z + (size_t)(b * T + t0 + row) * NIN + ZVM + hh * 256 + ch * 8); }
    const int chunk = tid & 31, isk = chunk >> 4, ch = (chunk & 15) * 8, zc = ZQKM + isk * 512 + hh * 128 + ch, cwc = isk * 512 + hh * 128 + ch, s0 = 8 * (tid >> 5);
    v4u zw[11];
#pragma unroll
    for (int j = 0; j < 11; ++j) { const int tt = t0 + s0 - 3 + j; zw[j] = (v4u){0u, 0u, 0u, 0u}; if (tt >= 0) zw[j] = *(const GAS v4u*)(z + (size_t)(b * T + tt) * NIN + zc); }
    float wt[4][8], bias[8];
    {
        const float* cw = A.in[7] + (size_t)layer * 4096 + cwc; const float* cb = A.in[8] + (size_t)layer * 1024 + cwc;
#pragma unroll
        for (int j = 0; j < 4; ++j) { const f32x4 a0 = *(const GAS f32x4*)(cw + j * 1024), a1 = *(const GAS f32x4*)(cw + j * 1024 + 4);
#pragma unroll
            for (int e = 0; e < 4; ++e) { wt[j][e] = a0[e]; wt[j][4 + e] = a1[e]; } }
        const f32x4 a0 = *(const GAS f32x4*)cb, a1 = *(const GAS f32x4*)(cb + 4);
#pragma unroll
        for (int e = 0; e < 4; ++e) { bias[e] = a0[e]; bias[4 + e] = a1[e]; }
    }
    if (w == 0) {
        const size_t row = (size_t)b * T + t0 + 2 * lane;
        const f32x4 g0a = *(const GAS f32x4*)(gates + row * 8), g0b = *(const GAS f32x4*)(gates + row * 8 + 4), g1a = *(const GAS f32x4*)(gates + row * 8 + 8), g1b = *(const GAS f32x4*)(gates + row * 8 + 12);
        const float f0 = hh == 0 ? g0b[0] : (hh == 1 ? g0b[1] : (hh == 2 ? g0b[2] : g0b[3])), f1 = hh == 0 ? g1b[0] : (hh == 1 ? g1b[1] : (hh == 2 ? g1b[2] : g1b[3]));
        const float li0 = hh == 0 ? g0a[0] : (hh == 1 ? g0a[1] : (hh == 2 ? g0a[2] : g0a[3])), li1 = hh == 0 ? g1a[0] : (hh == 1 ? g1a[1] : (hh == 2 ? g1a[2] : g1a[3]));
        const float lf0 = logsig(f0), lf1 = logsig(f1);
        float v = lf0 + lf1;
#pragma unroll
        for (int o = 1; o < 64; o <<= 1) { const float n = wv::lane_up(v, o, lane); if (lane >= o) v += n; }
        const float b1 = v, b0 = v - lf1, a0 = li0 - b0, a1 = li1 - b1, am = wave_max(fmaxf(a0, a1));
        *(GAS f32x2_t*)(bq + (size_t)bh * T + t0 + 2 * lane) = (f32x2_t){b0, b1}; *(GAS f32x2_t*)(aq + (size_t)bh * T + t0 + 2 * lane) = (f32x2_t){a0, a1};
        wl[2 * lane] = fexp(a0 - am); wl[2 * lane + 1] = fexp(a1 - am);
        if (lane == 63) blast[unit] = b1; if (lane == 0) amaxp[unit] = am;
    }
#pragma unroll
    for (int i = 0; i < 8; ++i) { const int cc = tid + 512 * i, row = cc >> 5, ch2 = cc & 31; *(LAS v4u*)(lds + OFF_VT + row * VP + ch2 * 16) = vr[i]; }
    __syncthreads();
#pragma unroll
    for (int i = 0; i < 8; ++i) {
        const int s = s0 + i, t = t0 + s; float y[8];
#pragma unroll
        for (int e = 0; e < 8; ++e) y[e] = bias[e];
#pragma unroll
        for (int j = 0; j < 4; ++j) { const v4u q4 = zw[i + j];
            y[0] += wt[j][0] * bflo(q4.x); y[1] += wt[j][1] * bfhi(q4.x); y[2] += wt[j][2] * bflo(q4.y); y[3] += wt[j][3] * bfhi(q4.y);
            y[4] += wt[j][4] * bflo(q4.z); y[5] += wt[j][5] * bfhi(q4.z); y[6] += wt[j][6] * bflo(q4.w); y[7] += wt[j][7] * bfhi(q4.w); }
#pragma unroll
        for (int e = 0; e < 8; ++e) y[e] = y[e] * sigmoid_fast(y[e]);
        if (isk) {
#pragma unroll
            for (int e = 0; e < 8; ++e) y[e] *= 0.08838834764831845f;
            v4u o; o.x = pg8::cvt_pk_bf16(y[0], y[1]); o.y = pg8::cvt_pk_bf16(y[2], y[3]); o.z = pg8::cvt_pk_bf16(y[4], y[5]); o.w = pg8::cvt_pk_bf16(y[6], y[7]);
            *(GAS v4u*)(kc + ((size_t)bh * T + t) * 128 + ch) = o;
            const float ws_ = wl[s];
            v4u o2; o2.x = pg8::cvt_pk_bf16(y[0] * ws_, y[1] * ws_); o2.y = pg8::cvt_pk_bf16(y[2] * ws_, y[3] * ws_); o2.z = pg8::cvt_pk_bf16(y[4] * ws_, y[5] * ws_); o2.w = pg8::cvt_pk_bf16(y[6] * ws_, y[7] * ws_);
            *(LAS v4u*)(lds + OFF_KT + s * KP + ch * 2) = o2;
        } else {
            v4u o; o.x = pg8::cvt_pk_bf16(y[0], y[1]); o.y = pg8::cvt_pk_bf16(y[2], y[3]); o.z = pg8::cvt_pk_bf16(y[4], y[5]); o.w = pg8::cvt_pk_bf16(y[6], y[7]);
            *(GAS v4u*)(qc + ((size_t)bh * T + t) * 128 + ch) = o;
        }
    }
    __syncthreads();
    {
        f32x4 acc[2][8], accn = (f32x4){0.f, 0.f, 0.f, 0.f};
#pragma unroll
        for (int e = 0; e < 2; ++e)
#pragma unroll
            for (int db = 0; db < 8; ++db) acc[e][db] = (f32x4){0.f, 0.f, 0.f, 0.f};
        const int q = fr >> 2, pp = fr & 3;
        unsigned one2 = 0x3f803f80u; asm volatile("" : "+v"(one2));
        const bf16x8 ones = __builtin_bit_cast(bf16x8, (v4u){one2, one2, one2, one2});
#pragma unroll
        for (int t = 0; t < CH / 32; ++t) {
            const LAS unsigned char* kb_ = lds + OFF_KT + (32 * t + 4 * g + q) * KP + 8 * pp; const LAS unsigned char* vb_ = lds + OFF_VT + (32 * t + 4 * g + q) * VP + 8 * pp;
            bf16x8 bf[2];
#pragma unroll
            for (int e = 0; e < 2; ++e) bf[e] = tr_frag(vb_ + (2 * w + e) * 32, VP);
#pragma unroll
            for (int db = 0; db < 8; ++db) { const bf16x8 af = tr_frag(kb_ + db * 32, KP);
#pragma unroll
                for (int e = 0; e < 2; ++e) acc[e][db] = __builtin_amdgcn_mfma_f32_16x16x32_bf16(af, bf[e], acc[e][db], 0, 0, 0);
                if (db == w) accn = __builtin_amdgcn_mfma_f32_16x16x32_bf16(af, ones, accn, 0, 0, 0); }
        }
#pragma unroll
        for (int e = 0; e < 2; ++e)
#pragma unroll
            for (int db = 0; db < 8; ++db) *(GAS f32x4*)(dCT + (size_t)(16 * (2 * w + e) + fr) * 128 + 16 * db + 4 * g) = acc[e][db];
        if (fr == 0) *(GAS f32x4*)(dn + 16 * w + 4 * g) = accn;
    }
}

__device__ __forceinline__ void m2_phase(LAS unsigned char* lds, unsigned char* ws, int vcu, int G, int tid) {
    const float* blast = (const float*)(ws + WS_BLAST); const float* amaxp = (const float*)(ws + WS_AMAX); float* mst = (float*)(ws + WS_MST);
    const float* dCT = (const float*)(ws + WS_DCT); bf16* CstT = (bf16*)(ws + WS_CST); const float* dn = (const float*)(ws + WS_DN); float* nst = (float*)(ws + WS_NST);
    LAS float* wo = (LAS float*)lds; LAS float* fk = wo + 32;
    const int lane = tid & 63;
    for (int blk = vcu; blk < NBH * 16; blk += G) {
        const int bh = blk >> 4, sub = blk & 15;
        __syncthreads();
        const size_t e = (size_t)(sub * 512 + tid) * 4;
        f32x4 v[NCH];
#pragma unroll
        for (int i = 0; i < NCH; ++i) v[i] = *(const GAS f32x4*)(dCT + (size_t)(bh * NCH + i) * 32768 + e);
        if (tid < 64) {
            const int cl = lane & (NCH - 1); const float bl = blast[bh * NCH + cl], ml = bl + amaxp[bh * NCH + cl];
            float m = 0.f, mywo = 0.f, myfk = 0.f, mym = 0.f;
#pragma unroll
            for (int c = 0; c < NCH; ++c) { const float blc = wv::lane_get(bl, c), mlc = wv::lane_get(ml, c), mn = fmaxf(blc + m, mlc), w_ = fexp(blc + m - mn), f_ = fexp(mlc - mn);
                if (lane == c) { mywo = w_; myfk = f_; mym = m; } m = mn; }
            if (lane < NCH) { wo[lane] = mywo; fk[lane] = myfk; if (sub == 0) mst[bh * NCH + lane] = mym; }
        }
        __syncthreads();
        {
            float z0 = 0.f; asm volatile("" : "+v"(z0)); f32x4 C = (f32x4){z0, z0, z0, z0};
#pragma unroll
            for (int c = 0; c < NCH; ++c) { v2u o; o.x = pg8::cvt_pk_bf16(C[0], C[1]); o.y = pg8::cvt_pk_bf16(C[2], C[3]);
                *(GAS v2u*)(CstT + (size_t)(bh * NCH + c) * 32768 + e) = o; C = C * wo[c] + v[c] * fk[c]; }
        }
        if (sub == 0 && tid < 32) {
            float z0 = 0.f; asm volatile("" : "+v"(z0)); f32x4 C = (f32x4){z0, z0, z0, z0};
            f32x4 dv[NCH];
#pragma unroll
            for (int c = 0; c < NCH; ++c) dv[c] = *(const GAS f32x4*)(dn + (size_t)(bh * NCH + c) * 128 + tid * 4);
#pragma unroll
            for (int c = 0; c < NCH; ++c) { *(GAS f32x4*)(nst + (size_t)(bh * NCH + c) * 128 + tid * 4) = C; C = C * wo[c] + dv[c] * fk[c]; }
        }
    }
    __syncthreads();
}

__device__ __forceinline__ void m3_unit(LAS unsigned char* lds, const Args& A, unsigned char* ws, int layer, int unit, int tid) {
    const int lane = tid & 63, w = __builtin_amdgcn_readfirstlane(tid >> 6), fr = lane & 15, g = lane >> 4;
    const int bh = unit / NCH, c = unit - bh * NCH, b = bh >> 2, hh = bh & 3, t0 = c * CH, tp = w & 3, half = w >> 2;
    const bf16* z = (const bf16*)(ws + WS_Z); const bf16* qc = (const bf16*)(ws + WS_QC); const bf16* kc = (const bf16*)(ws + WS_KC);
    const float* bq = (const float*)(ws + WS_BQ); const float* aq = (const float*)(ws + WS_AQ); const float* mst = (const float*)(ws + WS_MST);
    const bf16* CstT = (const bf16*)(ws + WS_CST) + (size_t)unit * 32768; const float* nst = (const float*)(ws + WS_NST) + (size_t)unit * 128; bf16* mixed = (bf16*)(ws + WS_MIXED);
    LAS float* U = (LAS float*)(lds + OFF_SM); LAS float* A2 = U + CH; LAS float* WI = U + 2 * CH; LAS float* EM = U + 3 * CH; LAS float* RS = U + 4 * CH;
    __syncthreads();
    v4u kr[4], vr[8];
#pragma unroll
    for (int i = 0; i < 4; ++i) { const int cc = tid + 512 * i, row = cc >> 4, ch = cc & 15; kr[i] = *(const GAS v4u*)(kc + ((size_t)bh * T + t0 + row) * 128 + ch * 8); }
#pragma unroll
    for (int i = 0; i < 8; ++i) { const int cc = tid + 512 * i, row = cc >> 5, ch = cc & 31; vr[i] = *(const GAS v4u*)(z + (size_t)(b * T + t0 + row) * NIN + ZVM + hh * 256 + ch * 8); }
    int tq[2]; bf16x8 Qf[2][4];
#pragma unroll
    for (int ga = 0; ga < 2; ++ga) { tq[ga] = 16 * (2 * tp + ga) + fr;
#pragma unroll
        for (int ks = 0; ks < 4; ++ks) Qf[ga][ks] = __builtin_bit_cast(bf16x8, *(const GAS v4u*)(qc + ((size_t)bh * T + t0 + tq[ga]) * 128 + 32 * ks + 8 * g)); }
    f32x4 nv[4][2];
#pragma unroll
    for (int ks = 0; ks < 4; ++ks) { nv[ks][0] = *(const GAS f32x4*)(nst + 32 * ks + 8 * g); nv[ks][1] = *(const GAS f32x4*)(nst + 32 * ks + 8 * g + 4); }
    if (w == 0) {
        const f32x2_t bt = *(const GAS f32x2_t*)(bq + (size_t)bh * T + t0 + 2 * lane), a = *(const GAS f32x2_t*)(aq + (size_t)bh * T + t0 + 2 * lane); const float ms = mst[unit];
        float pmx = fmaxf(a[0], a[1]);
#pragma unroll
        for (int o = 1; o < 64; o <<= 1) { const float n = wv::lane_up(pmx, o, lane); if (lane >= o) pmx = fmaxf(pmx, n); }
        float ex = wv::lane_up(pmx, 1, lane); if (lane == 0) ex = -3.0e38f;
        const float pm0 = fmaxf(ex, a[0]), pm1 = fmaxf(pm0, a[1]), mt0 = bt[0] + fmaxf(ms, pm0), mt1 = bt[1] + fmaxf(ms, pm1);
        U[2 * lane] = (bt[0] - mt0) * LOG2E; U[2 * lane + 1] = (bt[1] - mt1) * LOG2E; A2[2 * lane] = a[0] * LOG2E; A2[2 * lane + 1] = a[1] * LOG2E;
        WI[2 * lane] = fexp(bt[0] + ms - mt0); WI[2 * lane + 1] = fexp(bt[1] + ms - mt1); EM[2 * lane] = fexp(-mt0); EM[2 * lane + 1] = fexp(-mt1);
    }
#pragma unroll
    for (int i = 0; i < 4; ++i) { const int cc = tid + 512 * i, row = cc >> 4, ch = cc & 15; *(LAS v4u*)(lds + OFF_KT + row * KRP + ch * 16) = kr[i]; }
#pragma unroll
    for (int i = 0; i < 8; ++i) { const int cc = tid + 512 * i, row = cc >> 5, ch = cc & 31; *(LAS v4u*)(lds + OFF_VT + row * VP + ch * 16) = vr[i]; }
    float qn[2] = {0.f, 0.f};
#pragma unroll
    for (int ks = 0; ks < 4; ++ks) { const f32x4 n0 = nv[ks][0], n1 = nv[ks][1];
#pragma unroll
        for (int ga = 0; ga < 2; ++ga) { const v4u qw = __builtin_bit_cast(v4u, Qf[ga][ks]);
            qn[ga] += (bflo(qw.x) * n0[0] + bfhi(qw.x) * n0[1]) + (bflo(qw.y) * n0[2] + bfhi(qw.y) * n0[3]) + (bflo(qw.z) * n1[0] + bfhi(qw.z) * n1[1]) + (bflo(qw.w) * n1[2] + bfhi(qw.w) * n1[3]); } }
    f32x4 acc[2][8];
#pragma unroll
    for (int eh = 0; eh < 2; ++eh) {
        v4u cfw[4][4];
#pragma unroll
        for (int e4 = 0; e4 < 4; ++e4)
#pragma unroll
            for (int ks = 0; ks < 4; ++ks) cfw[e4][ks] = *(const GAS v4u*)(CstT + (size_t)(128 * half + 16 * (4 * eh + e4) + fr) * 128 + 32 * ks + 8 * g);
        asm volatile("" ::: "memory");
#pragma unroll
        for (int e4 = 0; e4 < 4; ++e4) { const int eb = 4 * eh + e4; acc[0][eb] = (f32x4){0.f, 0.f, 0.f, 0.f}; acc[1][eb] = (f32x4){0.f, 0.f, 0.f, 0.f};
#pragma unroll
            for (int ks = 0; ks < 4; ++ks) { const bf16x8 cf = __builtin_bit_cast(bf16x8, cfw[e4][ks]);
                acc[0][eb] = __builtin_amdgcn_mfma_f32_16x16x32_bf16(cf, Qf[0][ks], acc[0][eb], 0, 0, 0); acc[1][eb] = __builtin_amdgcn_mfma_f32_16x16x32_bf16(cf, Qf[1][ks], acc[1][eb], 0, 0, 0); } }
    }
    __syncthreads();
    float wi[2], ut[2], dsum[2] = {0.f, 0.f};
#pragma unroll
    for (int ga = 0; ga < 2; ++ga) { qn[ga] = att::quad_sum(qn[ga]); wi[ga] = WI[tq[ga]]; ut[ga] = U[tq[ga]];
#pragma unroll
        for (int eb = 0; eb < 8; ++eb) acc[ga][eb] = acc[ga][eb] * wi[ga]; }
    const int q = fr >> 2, pp = fr & 3;
#pragma unroll
    for (int kt = 0; kt < CH / 32; ++kt) if (kt <= tp) {
        f32x4 P[2][2];
#pragma unroll
        for (int j = 0; j < 2; ++j) { const int sb = 2 * kt + j;
            P[0][j] = (f32x4){0.f, 0.f, 0.f, 0.f}; P[1][j] = (f32x4){0.f, 0.f, 0.f, 0.f};
            if (sb <= 2 * tp + 1) {
                bf16x8 kf[4];
#pragma unroll
                for (int ks = 0; ks < 4; ++ks) kf[ks] = *(const LAS bf16x8*)(lds + OFF_KT + (16 * sb + fr) * KRP + (4 * ks + g) * 16);
                const f32x4 a2 = *(const LAS f32x4*)(A2 + 16 * sb + 4 * g);
#pragma unroll
                for (int ga = 0; ga < 2; ++ga) if (sb <= 2 * tp + ga) {
                    f32x4 s = (f32x4){0.f, 0.f, 0.f, 0.f};
#pragma unroll
                    for (int ks = 0; ks < 4; ++ks) s = __builtin_amdgcn_mfma_f32_16x16x32_bf16(kf[ks], Qf[ga][ks], s, 0, 0, 0);
#pragma unroll
                    for (int r = 0; r < 4; ++r) { const int sidx = 16 * sb + 4 * g + r; const float pv = sidx <= tq[ga] ? s[r] * __builtin_amdgcn_exp2f(ut[ga] + a2[r]) : 0.f; P[ga][j][r] = pv; dsum[ga] += pv; }
                }
            }
        }
        bf16x8 pf[2];
#pragma unroll
        for (int ga = 0; ga < 2; ++ga) { v4u wv; wv.x = pg8::cvt_pk_bf16(P[ga][0][0], P[ga][0][1]); wv.y = pg8::cvt_pk_bf16(P[ga][0][2], P[ga][0][3]); wv.z = pg8::cvt_pk_bf16(P[ga][1][0], P[ga][1][1]); wv.w = pg8::cvt_pk_bf16(P[ga][1][2], P[ga][1][3]); pf[ga] = __builtin_bit_cast(bf16x8, wv); }
        const LAS unsigned char* vb_ = lds + OFF_VT + (32 * kt + 4 * g + q) * VP + 8 * pp + half * 256;
#pragma unroll
        for (int eb = 0; eb < 8; ++eb) { const bf16x8 vf = tr_frag(vb_ + eb * 32, VP);
            acc[0][eb] = __builtin_amdgcn_mfma_f32_16x16x32_bf16(vf, pf[0], acc[0][eb], 0, 0, 0); acc[1][eb] = __builtin_amdgcn_mfma_f32_16x16x32_bf16(vf, pf[1], acc[1][eb], 0, 0, 0); }
    }
#pragma unroll
    for (int ga = 0; ga < 2; ++ga) {
        const float den = wi[ga] * qn[ga] + att::quad_sum(dsum[ga]), dinv = 1.0f / fmaxf(fabsf(den), EM[tq[ga]]);
        float ss = 0.f;
#pragma unroll
        for (int eb = 0; eb < 8; ++eb) { acc[ga][eb] = acc[ga][eb] * dinv; ss += (acc[ga][eb][0] * acc[ga][eb][0] + acc[ga][eb][1] * acc[ga][eb][1]) + (acc[ga][eb][2] * acc[ga][eb][2] + acc[ga][eb][3] * acc[ga][eb][3]); }
        ss = att::quad_sum(ss);
        if (g == 0) RS[tq[ga] * 2 + half] = ss;
    }
    __syncthreads();
#pragma unroll
    for (int ga = 0; ga < 2; ++ga) {
        const float rn = __builtin_amdgcn_rsqf((RS[tq[ga] * 2] + RS[tq[ga] * 2 + 1]) * (1.0f / 256.0f) + RMS_EPS);
        const size_t row = (size_t)b * T + t0 + tq[ga]; const float* gh = A.in[11] + (size_t)layer * 1024 + hh * 256 + 128 * half + 4 * g;
        const bf16* orow = z + row * NIN + ZOM + hh * 256 + 128 * half + 4 * g; bf16* mrow = mixed + row * D + 512 + hh * 256 + 128 * half + 4 * g;
        f32x4 gvv[8]; v2u oww[8];
#pragma unroll
        for (int eb = 0; eb < 8; ++eb) { gvv[eb] = *(const GAS f32x4*)(gh + 16 * eb); oww[eb] = *(const GAS v2u*)(orow + 16 * eb); }
        asm volatile("" ::: "memory");
#pragma unroll
        for (int eb = 0; eb < 8; ++eb) { const f32x4 gv = gvv[eb]; const v2u ow = oww[eb];
            const float r0 = acc[ga][eb][0] * rn * gv[0] * sigmoid_fast(bflo(ow.x)), r1 = acc[ga][eb][1] * rn * gv[1] * sigmoid_fast(bfhi(ow.x)), r2 = acc[ga][eb][2] * rn * gv[2] * sigmoid_fast(bflo(ow.y)), r3 = acc[ga][eb][3] * rn * gv[3] * sigmoid_fast(bfhi(ow.y));
            v2u o; o.x = pg8::cvt_pk_bf16(r0, r1); o.y = pg8::cvt_pk_bf16(r2, r3); *(GAS v2u*)(mrow + 16 * eb) = o; }
    }
}
}

struct KmeanRegs { v4u kv[8]; };
__device__ __forceinline__ void kmean_load(Frame& F, int it, KmeanRegs& R) {
    const bf16* z = (const bf16*)(F.ws + WS_Z);
    const int bh = it >> 3, blk = it & 7, b = bh >> 2, hh = bh & 3, r = F.lane >> 4, c = F.lane & 15;
    const bf16* base = z + (size_t)(b * T + blk * 256 + 32 * F.wave + r) * NIN + ZKA + hh * 128 + 8 * c;
#pragma unroll
    for (int i = 0; i < 8; ++i) R.kv[i] = *(const GAS v4u*)(base + (size_t)(4 * i) * NIN);
}
__device__ __forceinline__ void kmean_finish(Frame& F, int it, const KmeanRegs& R) {
    float* kmean = (float*)(F.ws + WS_KMEAN); LAS float* part = (LAS float*)F.lds;
    const int r = F.lane >> 4, c = F.lane & 15;
    float a[8];
#pragma unroll
    for (int e = 0; e < 8; ++e) a[e] = 0.f;
#pragma unroll
    for (int i = 0; i < 8; ++i) { a[0] += bflo(R.kv[i].x); a[1] += bfhi(R.kv[i].x); a[2] += bflo(R.kv[i].y); a[3] += bfhi(R.kv[i].y); a[4] += bflo(R.kv[i].z); a[5] += bfhi(R.kv[i].z); a[6] += bflo(R.kv[i].w); a[7] += bfhi(R.kv[i].w); }
#pragma unroll
    for (int e = 0; e < 8; ++e) a[e] = wv::quad_sum(a[e]);
    __syncthreads();
    if (r == 0) {
#pragma unroll
        for (int e = 0; e < 8; ++e) part[F.wave * 128 + 8 * c + e] = a[e]; }
    __syncthreads();
    if (F.tid < 128) { float s_ = 0.f;
#pragma unroll
        for (int w_ = 0; w_ < 8; ++w_) s_ += part[w_ * 128 + F.tid];
        kmean[(size_t)it * 128 + F.tid] = s_ * (1.0f / 256.0f); }
}
__device__ __forceinline__ void m1_phase(Frame& F, const Args& A, int layer) {
    OPAQUE_TID(F);
    for (int it = F.vcu; it < NBH * 8 || it < NBH * ml::NCH; it += F.G) {
        KmeanRegs KR; const bool hk = it < NBH * 8;
        if (hk) kmean_load(F, it, KR);
        if (it < NBH * ml::NCH) ml::m1_unit(F.lds, A, F.ws, layer, it, F.tid);
        if (hk) kmean_finish(F, it, KR);
    }
    __syncthreads();
}
__device__ __forceinline__ void m3_phase(Frame& F, const Args& A, int layer) {
    OPAQUE_TID(F);
    for (int u = F.vcu; u < NBH * ml::NCH; u += F.G) ml::m3_unit(F.lds, A, F.ws, layer, u, F.tid);
    __syncthreads();
}

constexpr int N_PHASES = 2 + 10 * DEPTH;
__global__ void __launch_bounds__(NWAVES * 64, 2) mk_fwd(Args args) {
    extern __shared__ __attribute__((aligned(16))) unsigned char lds[];
    Frame F;
    F.lds = (LAS unsigned char*)lds;
    F.MISC = (volatile LAS unsigned*)(F.lds + MISC_OFF);
    F.tid = threadIdx.x; F.lane = F.tid & 63; F.wave = __builtin_amdgcn_readfirstlane(F.tid >> 6); F.wave0 = F.wave;
    F.G = gridDim.x; { const int bx = blockIdx.x; F.vcu = (F.G % 8 == 0) ? (bx % 8) * (F.G / 8) + bx / 8 : bx; }
    F.ws = args.ws; F.out = args.out; F.ctl = (gu32*)(args.ws + WS_CTL);
    for (int u = F.tid; u < (LDS_BYTES - LDSCTL_OFF) / 4; u += NWAVES * 64) ((LAS unsigned*)(F.lds + LDSCTL_OFF))[u] = 0u;
    __syncthreads();
    XcdBarrier bar = xcd_barrier_post((unsigned*)(F.ctl + CW_BAR), F.MISC + 8);
    const int lo = args.ph_lo, hi = args.ph_hi;
#define IN(k) (lo <= (k) && (k) < hi)
#define SEAM(k) do { if (IN((k) + 1)) xcd_barrier(bar); } while (0)
#define PH_BEGIN int L = layer; asm volatile("" : "+s"(L)); int BX = blockIdx.x; asm volatile("" : "+s"(BX)); int GG = gridDim.x; asm volatile("" : "+s"(GG)); unsigned char* ws = args.ws; asm volatile("" : "+s"(ws)); \
    bf16* hb_cur = (bf16*)(ws + ((L & 1) ? WS_HB1 : WS_HB0)); bf16* hb_nxt = (bf16*)(ws + ((L & 1) ? WS_HB0 : WS_HB1)); \
    float* ssq0 = (float*)(ws + WS_SSQ0); float* ssq1 = (float*)(ws + WS_SSQ1); \
    bf16* act = (bf16*)(ws + WS_ACT); bf16* z = (bf16*)(ws + WS_Z); bf16* mixed = (bf16*)(ws + WS_MIXED); bf16* pp = (bf16*)(ws + WS_PP); \
    (void)hb_cur; (void)hb_nxt; (void)ssq0; (void)ssq1; (void)act; (void)z; (void)mixed; (void)pp;

    if (IN(0)) { p0_prologue(F, args); SEAM(0); }

    for (int layer = 0; layer < DEPTH; ++layer) {
        const int pb = 1 + 10 * layer;
        if (IN(pb + 0)) { PH_BEGIN
            pg8::Gemm g{hb_cur, WPTR(LW_UP1), M, NUP, D}; pg8::StaticOrder S; S.init(M, NUP, GG, BX);
            pg8::EpiSwiGLU E{act, ssq0, DFF};
            pg8::gemm_phase<pg8::EpiSwiGLU, pg8::StaticOrder, true, true>(F.lds + RING_OFF, g, S, E, F.wave0);
            if (GG == 256 && BX >= 128) {
                pg8::Gemm g2{(const bf16*)(ws + WS_PB) + (size_t)L * M * DPLE, WPTR(LW_P), M, D, DPLE}; pg8::StaticOrder S2; S2.init(M, D, 128, BX - 128);
                pg8::EpiScaleBf16 E2{pp, nullptr, D};
                pg8::gemm_phase<pg8::EpiScaleBf16, pg8::StaticOrder, true, true>(F.lds + RING_OFF, g2, S2, E2, F.wave0);
                convert_tail(F, args, L, 1, BX);
            }
            if (!IN(pb + 1)) {}
        }
        if (IN(pb + 1)) { PH_BEGIN
            pg8::Gemm g{act, WPTR(LW_DN1), M, D, DFF}; pg8::StaticOrder S; S.init(M, D, GG, BX);
            pg8::EpiResid<0, 1> E{hb_cur, hb_cur, ssq1, nullptr, nullptr};
            pg8::gemm_phase<pg8::EpiResid<0, 1>, pg8::StaticOrder, true, true, BarHook>(F.lds + RING_OFF, g, S, E, F.wave0, BarHook{bar, IN(pb + 0)});
            SEAM(pb + 1);
        }
        if (IN(pb + 2)) { PH_BEGIN
            pg8::Gemm g{hb_cur, WPTR(LW_IN), M, NIN, D}; pg8::StaticOrder S; S.init(M, NIN, GG, BX);
            pg8::EpiScaleBf16 E{z, ssq1, NIN};
            pg8::gemm_phase<pg8::EpiScaleBf16, pg8::StaticOrder, true, true>(F.lds + RING_OFF, g, S, E, F.wave0);
            gates_phase(F, args, L, ssq1, hb_cur);
            SEAM(pb + 2);
        }
        if (IN(pb + 3)) { PH_BEGIN
            pg8::Gemm g{(const bf16*)(F.ws + WS_PB) + (size_t)L * M * DPLE, WPTR(LW_P), M, D, DPLE}; pg8::StaticOrder S; S.init(M, D, GG, BX);
            pg8::EpiScaleBf16 E{pp, nullptr, D};
            if (GG != 256) pg8::gemm_phase<pg8::EpiScaleBf16, pg8::StaticOrder, true, true>(F.lds + RING_OFF, g, S, E, F.wave0);
            m1_phase(F, args, L);
            SEAM(pb + 3);
        }
        if (IN(pb + 4)) { PH_BEGIN OPAQUE_TID(F); ml::m2_phase(F.lds, ws, F.vcu, GG, F.tid); attn_phase(F, args, L, GG == 256 ? CQ_U1 + (L + 1 < DEPTH ? CQ_U2 : 0) : 0); SEAM(pb + 4); }
        if (IN(pb + 5)) { PH_BEGIN m3_phase(F, args, L); dil_combine(F); }
        if (IN(pb + 6)) { PH_BEGIN
            pg8::Gemm g{mixed, WPTR(LW_OUT), M, D, D}; pg8::StaticOrder S; S.init(M, D, GG, BX);
            pg8::EpiResid<0, 2> E{hb_cur, hb_cur, ssq0, nullptr, nullptr};
            pg8::gemm_phase<pg8::EpiResid<0, 2>, pg8::StaticOrder, true, true, BarHook>(F.lds + RING_OFF, g, S, E, F.wave0, BarHook{bar, IN(pb + 5)});
            SEAM(pb + 6);
        }
        if (IN(pb + 7)) { PH_BEGIN
            pg8::Gemm g{hb_cur, WPTR(LW_UP2), M, NUP, D}; pg8::StaticOrder S; S.init(M, NUP, GG, BX);
            pg8::EpiSwiGLU E{act, ssq0, DFF};
            pg8::gemm_phase<pg8::EpiSwiGLU, pg8::StaticOrder, true, true>(F.lds + RING_OFF, g, S, E, F.wave0);
            if (GG == 256 && BX >= 128) convert_tail(F, args, L + 1, 0, BX);
        }
        if (IN(pb + 8)) { PH_BEGIN
            pg8::Gemm g{act, WPTR(LW_DN2), M, D, DFF}; pg8::StaticOrder S; S.init(M, D, GG, BX);
            pg8::EpiResid<0, 1> E{hb_cur, hb_cur, ssq1, nullptr, nullptr};
            pg8::gemm_phase<pg8::EpiResid<0, 1>, pg8::StaticOrder, true, true, BarHook>(F.lds + RING_OFF, g, S, E, F.wave0, BarHook{bar, IN(pb + 7)});
            SEAM(pb + 8);
        }
        if (IN(pb + 9)) { PH_BEGIN
            pg8::Gemm g{hb_cur, WPTR(LW_G), M, D, D}; pg8::StaticOrder S; S.init(M, D, GG, BX);
            pg8::EpiResid<1, 2> E{hb_cur, hb_nxt, ssq0, ssq1, pp};
            pg8::gemm_phase<pg8::EpiResid<1, 2>, pg8::StaticOrder, true, true>(F.lds + RING_OFF, g, S, E, F.wave0);
            SEAM(pb + 9);
        }
    }
    if (IN(N_PHASES - 1)) final_norm(F, args);
#undef IN
#undef SEAM
#undef PH_BEGIN
}

#ifndef MK_MULTI
#define MK_MULTI 0
#endif
extern "C" void kernel_launch(void* const* d_in, const int* in_sizes, int n_in, void* d_out, int out_size, void* d_ws, size_t ws_size, hipStream_t stream) {
    static int grid = 0;
    if (grid == 0) {
        if (n_in != 20 || in_sizes[0] != M * D || out_size != M * D || ws_size < WS_END) { fprintf(stderr, "kernel_launch: unexpected shapes: n_in %d in0 %d out %d ws %zu (need %zu)\n", n_in, n_in > 0 ? in_sizes[0] : -1, out_size, ws_size, (size_t)WS_END); grid = -1; return; }
        int dev = 0, cus = 0, per_cu = 0;
        if (hipGetDevice(&dev) != hipSuccess || hipDeviceGetAttribute(&cus, hipDeviceAttributeMultiprocessorCount, dev) != hipSuccess) { grid = -1; return; }
        if (hipFuncSetAttribute((const void*)mk_fwd, hipFuncAttributeMaxDynamicSharedMemorySize, LDS_BYTES) != hipSuccess) { fprintf(stderr, "kernel_launch: hipFuncSetAttribute failed\n"); grid = -1; return; }
        if (hipOccupancyMaxActiveBlocksPerMultiprocessor(&per_cu, (const void*)mk_fwd, NWAVES * 64, LDS_BYTES) != hipSuccess || per_cu < 1) { fprintf(stderr, "kernel_launch: occupancy query says %d blocks per CU\n", per_cu); }
        (void)hipGetLastError();
        grid = cus;
    }
    if (grid < 0) return;
    if (hipMemsetAsync((char*)d_ws + WS_CTL, 0, CTL_ZERO_BYTES, stream) != hipSuccess) return;
    Args a{};
    for (int i = 0; i < 20; ++i) a.in[i] = (const float*)d_in[i];
    a.out = (float*)d_out; a.ws = (unsigned char*)d_ws;
#if MK_MULTI
    for (int p = 0; p < N_PHASES; ++p) { a.ph_lo = p; a.ph_hi = p + 1; hipLaunchKernelGGL(mk_fwd, dim3(grid), dim3(NWAVES * 64), LDS_BYTES, stream, a); }
#else
    a.ph_lo = 0; a.ph_hi = N_PHASES;
    hipLaunchKernelGGL(mk_fwd, dim3(grid), dim3(NWAVES * 64), LDS_BYTES, stream, a);
#endif
    const hipError_t le = hipPeekAtLastError();
    if (le != hipSuccess) fprintf(stderr, "kernel_launch: launch failed: %s\n", hipGetErrorName(le));
}
```

```cpp
#include <hip/hip_runtime.h>
#include <cstdio>
#include <cstdint>
namespace wv {
typedef unsigned u32x2_t __attribute__((ext_vector_type(2)));
#define WV_DPP(v, ctrl) __uint_as_float((unsigned)__builtin_amdgcn_update_dpp(0, (int)__float_as_uint(v), (ctrl), 0xf, 0xf, true))
__device__ __forceinline__ float swap16_a(float x, float& other) { const u32x2_t r = __builtin_amdgcn_permlane16_swap(__float_as_uint(x), __float_as_uint(x), false, false); other = __uint_as_float(r[1]); return __uint_as_float(r[0]); }
__device__ __forceinline__ float swap32_a(float x, float& other) { const u32x2_t r = __builtin_amdgcn_permlane32_swap(__float_as_uint(x), __float_as_uint(x), false, false); other = __uint_as_float(r[1]); return __uint_as_float(r[0]); }
__device__ __forceinline__ float quad_sum(float x) { float o; float a = swap16_a(x, o); x = a + o; a = swap32_a(x, o); return a + o; }
__device__ __forceinline__ float quad_max(float x) { float o; float a = swap16_a(x, o); x = fmaxf(a, o); a = swap32_a(x, o); return fmaxf(a, o); }
__device__ __forceinline__ float row_sum(float v) { v += WV_DPP(v, 0xB1); v += WV_DPP(v, 0x4E); v += WV_DPP(v, 0x141); v += WV_DPP(v, 0x140); return v; }
__device__ __forceinline__ float row_max(float v) { v = fmaxf(v, WV_DPP(v, 0xB1)); v = fmaxf(v, WV_DPP(v, 0x4E)); v = fmaxf(v, WV_DPP(v, 0x141)); v = fmaxf(v, WV_DPP(v, 0x140)); return v; }
__device__ __forceinline__ float wave_sum(float v) { return quad_sum(row_sum(v)); }
__device__ __forceinline__ float wave_max(float v) { return quad_max(row_max(v)); }
__device__ __forceinline__ float lane_up(float v, int d, int lane) { return __uint_as_float((unsigned)__builtin_amdgcn_ds_bpermute((lane - d) << 2, (int)__float_as_uint(v))); }
__device__ __forceinline__ float lane_get(float v, int src) { return __uint_as_float((unsigned)__builtin_amdgcn_readlane((int)__float_as_uint(v), src)); }
}
namespace pg8 {
#define PG8_LAS __attribute__((address_space(3)))
typedef unsigned short bf16_t;
typedef short bf16x8 __attribute__((ext_vector_type(8)));
typedef float f32x4 __attribute__((ext_vector_type(4)));
typedef unsigned u32x4 __attribute__((ext_vector_type(4)));
constexpr int BM = 256, BK = 64, HALF = 128, HTB = HALF * BK * 2  , STAGE_BYTES = 8 * HTB, NXCD = 8, WGM = 8;

__host__ __device__ __forceinline__ int lds_byte(int r, int c) { const int st = (r >> 4) * 2 + (c >> 5), rr = r & 15, cc = c & 31, ob = rr * 64 + cc * 2; return st * 1024 + (ob ^ (((ob >> 9) & 1) << 5)); }
__host__ __device__ __forceinline__ void stage_rc(int b, int& R, int& C) { const int st = b / 1024, sb = b % 1024, swz = sb ^ (((sb >> 9) & 1) << 5); R = (st >> 1) * 16 + swz / 64; C = (st & 1) * 32 + (swz % 64) / 2; }
__host__ __device__ __forceinline__ int perm32(int rho) { const int n = rho >> 4, i = rho & 15; return 8 * (i >> 2) + 4 * n + (i & 3); }

struct Unit { int pm, pn; };
struct Gemm { const bf16_t* A; const bf16_t* Bt; int M, N, K; };

struct StaticOrder {
    int nM, nN, nwg, G, c;
    __host__ __device__ void init(int M, int N, int G_, int c_) { nM = M / BM; nN = N / BM; nwg = nM * nN; G = G_; c = c_; }
    __host__ __device__ bool next(int i, Unit& u) const {
        const long L = (long)i * G + c; if (L >= nwg) return false;
        int wgid = (int)L; { const int q = nwg / NXCD, r = nwg % NXCD, xcd = wgid % NXCD, off = wgid / NXCD; wgid = (xcd < r ? xcd * (q + 1) : r * (q + 1) + (xcd - r) * q) + off; }
        const int nig = WGM * nN, gid = wgid / nig, fm = gid * WGM, gsz = (nM - fm) < WGM ? (nM - fm) : WGM;
        u.pm = fm + ((wgid % nig) % gsz); u.pn = (wgid % nig) / gsz; return true;
    }
    __device__ __forceinline__ void a_ready(const Unit&) const {}
    __device__ __forceinline__ void done(const Unit&) const {}
};

__device__ __forceinline__ unsigned cvt_pk_bf16(float lo, float hi) { unsigned r; asm volatile("v_cvt_pk_bf16_f32 %0, %1, %2" : "=v"(r) : "v"(lo), "v"(hi)); return r; }
typedef float f32x2 __attribute__((ext_vector_type(2)));
#define PG8_GAS __attribute__((address_space(1)))
constexpr float RMS_EPS_F = 1e-6f;
__device__ __forceinline__ void load_rstd(const float* ssq, int row0, int fq, float (&rs)[2][4]) {
    f32x4 raw[2][4][2];
#pragma unroll
    for (int ai = 0; ai < 2; ++ai)
#pragma unroll
        for (int m = 0; m < 4; ++m) {
            const PG8_GAS f32x4* p = (const PG8_GAS f32x4*)(ssq + (size_t)(row0 + ai * HALF + m * 16) * 32 + fq * 8);
            raw[ai][m][0] = p[0]; raw[ai][m][1] = p[1];
        }
    asm volatile("" ::: "memory");
#pragma unroll
    for (int ai = 0; ai < 2; ++ai)
#pragma unroll
        for (int m = 0; m < 4; ++m) {
            const f32x4 a = raw[ai][m][0], b = raw[ai][m][1];
            float s = ((a[0] + a[1]) + (a[2] + a[3])) + ((b[0] + b[1]) + (b[2] + b[3]));
            s = wv::quad_sum(s);
            rs[ai][m] = __builtin_amdgcn_rsqf(s * (1.0f / 2048.0f) + RMS_EPS_F);
        }
}
__device__ __forceinline__ float sigmoid_f(float x) { return __builtin_amdgcn_rcpf(1.0f + __builtin_amdgcn_exp2f(-1.4426950408889634f * x)); }

struct EpiSwiGLU {
    static constexpr bool PERM = true, AFTER_DRAIN = false, INIT = false;
    bf16_t* act; const float* ssq; int ldc;
    __device__ __forceinline__ void operator()(const f32x4 (&acc)[2][2][4][2], const Unit& u, int wr, int wc, int fr, int fq) const {
        const int row0 = u.pm * BM + wr * 64 + fr, col0 = u.pn * HALF + wc * 32 + 8 * fq;
        float rs[2][4]; load_rstd(ssq, row0, fq, rs);
#pragma unroll
        for (int ai = 0; ai < 2; ++ai)
#pragma unroll
            for (int m = 0; m < 4; ++m) {
                const float s = rs[ai][m]; float v[8];
#pragma unroll
                for (int n = 0; n < 2; ++n)
#pragma unroll
                    for (int j = 0; j < 4; ++j) { const float g = acc[ai][0][m][n][j] * s, up = acc[ai][1][m][n][j] * s; v[n * 4 + j] = g * sigmoid_f(g) * up; }
                u32x4 w; w.x = cvt_pk_bf16(v[0], v[1]); w.y = cvt_pk_bf16(v[2], v[3]); w.z = cvt_pk_bf16(v[4], v[5]); w.w = cvt_pk_bf16(v[6], v[7]);
                *(PG8_GAS u32x4*)(act + (size_t)(row0 + ai * HALF + m * 16) * ldc + col0) = w;
            }
    }
};
struct EpiScaleBf16 {
    static constexpr bool PERM = true, AFTER_DRAIN = false, INIT = false;
    bf16_t* O; const float* ssq; int ldc;
    __device__ __forceinline__ void operator()(const f32x4 (&acc)[2][2][4][2], const Unit& u, int wr, int wc, int fr, int fq) const {
        const int row0 = u.pm * BM + wr * 64 + fr, col0 = u.pn * BM + wc * 32 + 8 * fq;
        float rs[2][4];
        if (ssq) load_rstd(ssq, row0, fq, rs);
        else {
#pragma unroll
            for (int ai = 0; ai < 2; ++ai)
#pragma unroll
                for (int m = 0; m < 4; ++m) rs[ai][m] = 1.0f; }
#pragma unroll
        for (int ai = 0; ai < 2; ++ai)
#pragma unroll
            for (int m = 0; m < 4; ++m) { const float s = rs[ai][m]; bf16_t* rowp = O + (size_t)(row0 + ai * HALF + m * 16) * ldc + col0;
#pragma unroll
                for (int bj = 0; bj < 2; ++bj) { const f32x4 v0 = acc[ai][bj][m][0] * s, v1 = acc[ai][bj][m][1] * s;
                    u32x4 w; w.x = cvt_pk_bf16(v0[0], v0[1]); w.y = cvt_pk_bf16(v0[2], v0[3]); w.z = cvt_pk_bf16(v1[0], v1[1]); w.w = cvt_pk_bf16(v1[2], v1[3]);
                    *(PG8_GAS u32x4*)(rowp + bj * HALF) = w; } }
    }
};
template <int MODE, int ALPHA_X2> struct EpiResid {
    static constexpr bool PERM = true, AFTER_DRAIN = false, INIT = (MODE == 0);
    static constexpr float alpha = 0.5f * ALPHA_X2;
    const bf16_t* hin; bf16_t* hb; float* ssq_out; const float* ssq_in; const bf16_t* pp;
    static __device__ __forceinline__ float lo16(unsigned w) { return __uint_as_float(w << 16); }
    static __device__ __forceinline__ float hi16(unsigned w) { return __uint_as_float(w & 0xffff0000u); }
    __device__ __forceinline__ void init(f32x4 (&acc)[2][2][4][2], const Unit& u, int wr, int wc, int fr, int fq) const {
        const int row0 = u.pm * BM + wr * 64 + fr, col0 = u.pn * BM + wc * 32 + 8 * fq; constexpr float ia = 1.0f / alpha;
        u32x4 w[2][4][2];
#pragma unroll
        for (int ai = 0; ai < 2; ++ai)
#pragma unroll
            for (int m = 0; m < 4; ++m)
#pragma unroll
                for (int bj = 0; bj < 2; ++bj) w[ai][m][bj] = *(const PG8_GAS u32x4*)(hin + (size_t)(row0 + ai * HALF + m * 16) * 2048 + col0 + bj * HALF);
#pragma unroll
        for (int ai = 0; ai < 2; ++ai)
#pragma unroll
            for (int m = 0; m < 4; ++m)
#pragma unroll
                for (int bj = 0; bj < 2; ++bj) { const u32x4 v = w[ai][m][bj];
                    acc[ai][bj][m][0] = (f32x4){lo16(v.x), hi16(v.x), lo16(v.y), hi16(v.y)} * ia; acc[ai][bj][m][1] = (f32x4){lo16(v.z), hi16(v.z), lo16(v.w), hi16(v.w)} * ia; }
    }
    __device__ __forceinline__ float put(unsigned eoff, const f32x4& a, const f32x4& b) const {
        u32x4 w; w.x = cvt_pk_bf16(a[0], a[1]); w.y = cvt_pk_bf16(a[2], a[3]); w.z = cvt_pk_bf16(b[0], b[1]); w.w = cvt_pk_bf16(b[2], b[3]);
        *(PG8_GAS u32x4*)((PG8_GAS char*)hb + 2u * eoff) = w;
        const float a0 = lo16(w.x), a1 = hi16(w.x), a2 = lo16(w.y), a3 = hi16(w.y), b0 = lo16(w.z), b1 = hi16(w.z), b2 = lo16(w.w), b3 = hi16(w.w);
        return ((a0 * a0 + a1 * a1) + (a2 * a2 + a3 * a3)) + ((b0 * b0 + b1 * b1) + (b2 * b2 + b3 * b3));
    }
    __device__ __forceinline__ void operator()(const f32x4 (&acc)[2][2][4][2], const Unit& u, int wr, int wc, int fr, int fq) const {
        const int row0 = u.pm * BM + wr * 64 + fr, col0 = u.pn * BM + wc * 32 + 8 * fq;
        const unsigned e0 = (unsigned)(row0 * 2048 + col0);
        if constexpr (MODE == 0) {
#pragma unroll
            for (int ai = 0; ai < 2; ++ai)
#pragma unroll
                for (int m = 0; m < 4; ++m) {
                    const int r = row0 + ai * HALF + m * 16; float q = 0.f;
#pragma unroll
                    for (int bj = 0; bj < 2; ++bj) q += put(e0 + (unsigned)((ai * HALF + m * 16) * 2048 + bj * HALF), acc[ai][bj][m][0] * alpha, acc[ai][bj][m][1] * alpha);
                    q = wv::quad_sum(q);
                    if (fq == 0) *(PG8_GAS float*)(ssq_out + (size_t)r * 32 + u.pn * 4 + wc) = q;
                }
        } else {
            float rs[2][4]; load_rstd(ssq_in, row0, fq, rs);
            const PG8_GAS char* hB = (const PG8_GAS char*)hin; const PG8_GAS char* pB = (const PG8_GAS char*)pp;
            u32x4 hv[2][2], pv[2][2];
#define RES_LD(IT, BUF) { _Pragma("unroll") for (int bj = 0; bj < 2; ++bj) { const unsigned bo = 2u * (e0 + (unsigned)(((((IT) >> 2) * HALF + ((IT) & 3) * 16) * 2048 + bj * HALF))); \
                hv[BUF][bj] = *(const PG8_GAS u32x4*)(hB + bo); pv[BUF][bj] = *(const PG8_GAS u32x4*)(pB + bo); } }
            RES_LD(0, 0)
#pragma unroll
            for (int it = 0; it < 8; ++it) {
                const int ai = it >> 2, m = it & 3, cb = it & 1;
                if (it + 1 < 8) RES_LD(it + 1, cb ^ 1)
                asm volatile("" ::: "memory");
                const int r = row0 + ai * HALF + m * 16; float q = 0.f; const float s = rs[ai][m];
#pragma unroll
                for (int bj = 0; bj < 2; ++bj) {
                    const u32x4 hw = hv[cb][bj], pw = pv[cb][bj];
                    f32x4 a = (f32x4){lo16(hw.x), hi16(hw.x), lo16(hw.y), hi16(hw.y)}, b = (f32x4){lo16(hw.z), hi16(hw.z), lo16(hw.w), hi16(hw.w)};
#pragma unroll
                    for (int j = 0; j < 4; ++j) {
                        const unsigned w0 = pw[j >> 1], w1 = pw[2 + (j >> 1)];
                        const float p0 = (j & 1) ? hi16(w0) : lo16(w0), p1 = (j & 1) ? hi16(w1) : lo16(w1);
                        a[j] += sigmoid_f(acc[ai][bj][m][0][j] * s) * p0; b[j] += sigmoid_f(acc[ai][bj][m][1][j] * s) * p1; }
                    q += put(e0 + (unsigned)((ai * HALF + m * 16) * 2048 + bj * HALF), a, b);
                }
                q = wv::quad_sum(q);
                if (fq == 0) *(PG8_GAS float*)(ssq_out + (size_t)r * 32 + u.pn * 4 + wc) = q;
            }
#undef RES_LD
        }
    }
};
struct NoHook { __device__ __forceinline__ void operator()() const {} };
template <class Epi, class Sched, bool ALIGN_EPI = false, bool SP2 = false, class Hook = NoHook>
__device__ __forceinline__ void gemm_phase(PG8_LAS unsigned char* lds, const Gemm g, const Sched& S, const Epi& E, int wave_id, const Hook& hook = Hook()) {
    int wid_ = wave_id; asm volatile("" : "+s"(wid_)); int lane_; asm volatile("v_mbcnt_lo_u32_b32 %0, -1, 0\n\tv_mbcnt_hi_u32_b32 %0, -1, %0" : "=v"(lane_));
    const int wid = wid_, lane = lane_, tid = wid * 64 + lane, wr = wid >> 2, wc = wid & 3, fr = lane & 15, fq = lane >> 4;
    const int K = g.K, nt = K / BK;
    unsigned voffA[2], voffB[2];
#pragma unroll
    for (int i = 0; i < 2; ++i) { int R, C; stage_rc(tid * 16 + i * 8192, R, C); const int Rb = Epi::PERM ? ((R & ~31) + perm32(R & 31)) : R;
        voffA[i] = (unsigned)(R * K + C) * 2u; voffB[i] = (unsigned)(Rb * K + C) * 2u; }
    const size_t kstep = (size_t)(BK * 2);
    const size_t hstep = (size_t)HALF * K * 2;
    const size_t tstep = 2 * hstep;
    const unsigned ldsw = (unsigned)wid * 1024u;
    const int aoff = lds_byte(wr * 64 + fr, fq * 8), boff = lds_byte(wc * 32 + fr, fq * 8);
#define PG8_SA(b, h) (((b) * 2 + (h)) * HTB)
#define PG8_SB(b, h) ((4 + (b) * 2 + (h)) * HTB)
#define PG8_STAGE(bufoff, gbase, voff) do { _Pragma("unroll") for (int _i = 0; _i < 2; ++_i) \
        __builtin_amdgcn_global_load_lds((const unsigned*)((const char*)(gbase) + (voff)[_i]), (PG8_LAS unsigned*)(lds + (bufoff) + ldsw + _i * 8192), 16, 0, 0); } while (0)
#define PG8_LDA(dst, b, h) do { _Pragma("unroll") for (int m = 0; m < 4; ++m) _Pragma("unroll") for (int k = 0; k < 2; ++k) dst[m][k] = *(const PG8_LAS bf16x8*)(lds + PG8_SA(b, h) + aoff + m * 2048 + k * 1024); } while (0)
#define PG8_LDB(dst, b, h) do { _Pragma("unroll") for (int n = 0; n < 2; ++n) _Pragma("unroll") for (int k = 0; k < 2; ++k) dst[n][k] = *(const PG8_LAS bf16x8*)(lds + PG8_SB(b, h) + boff + n * 2048 + k * 1024); } while (0)
#define PG8_MMA(ai, bj, At, Bt) do { __builtin_amdgcn_s_setprio(1); _Pragma("unroll") for (int m = 0; m < 4; ++m) _Pragma("unroll") for (int n = 0; n < 2; ++n) _Pragma("unroll") for (int k = 0; k < 2; ++k) \
        acc[ai][bj][m][n] = __builtin_amdgcn_mfma_f32_16x16x32_bf16(Bt[n][k], At[m][k], acc[ai][bj][m][n], 0, 0, 0); __builtin_amdgcn_s_setprio(0); } while (0)
#define PG8_WAIT_V(n) asm volatile("s_waitcnt vmcnt(" #n ")" ::: "memory")
#define PG8_WAIT_L(n) asm volatile("s_waitcnt lgkmcnt(" #n ")" ::: "memory")
#define PG8_BAR __builtin_amdgcn_s_barrier()
#define PG8_SCHED __builtin_amdgcn_sched_barrier(0)
    Unit cur, nxt; int ui = 0;
    const bool has_unit = S.next(0, cur);
    f32x4 acc[2][2][4][2];
    if constexpr (Epi::INIT) { if (has_unit) E.init(acc, cur, wr, wc, fr, fq); }
    else {
#pragma unroll
    for (int a = 0; a < 2; ++a)
#pragma unroll
        for (int b = 0; b < 2; ++b)
#pragma unroll
            for (int m = 0; m < 4; ++m)
#pragma unroll
                for (int n = 0; n < 2; ++n) acc[a][b][m][n] = (f32x4){0.f, 0.f, 0.f, 0.f};
    }
    hook();
    if (!has_unit) return;
    bf16x8 At[4][2], B0[2][2], B1[2][2];
    const char* cA = (const char*)g.A + (size_t)cur.pm * tstep; const char* cB = (const char*)g.Bt + (size_t)cur.pn * tstep;
    S.a_ready(cur);
    if constexpr (SP2) {
        PG8_STAGE(PG8_SB(0, 0), cB, voffB); PG8_STAGE(PG8_SB(0, 1), cB + hstep, voffB); PG8_STAGE(PG8_SA(0, 0), cA, voffA); PG8_STAGE(PG8_SA(0, 1), cA + hstep, voffA);
        if (wr == 1) PG8_BAR;
        PG8_WAIT_V(2); PG8_BAR;
        PG8_STAGE(PG8_SB(1, 0), cB + kstep, voffB); PG8_STAGE(PG8_SA(1, 0), cA + kstep, voffA); PG8_STAGE(PG8_SB(1, 1), cB + hstep + kstep, voffB);
        PG8_WAIT_V(6); PG8_BAR;
    } else {
        PG8_STAGE(PG8_SB(0, 0), cB, voffB); PG8_STAGE(PG8_SA(0, 0), cA, voffA); PG8_STAGE(PG8_SB(0, 1), cB + hstep, voffB); PG8_STAGE(PG8_SA(0, 1), cA + hstep, voffA);
        if (wr == 1) PG8_BAR;
        PG8_WAIT_V(4); PG8_BAR;
        PG8_STAGE(PG8_SB(1, 0), cB + kstep, voffB); PG8_STAGE(PG8_SA(1, 0), cA + kstep, voffA); PG8_STAGE(PG8_SB(1, 1), cB + hstep + kstep, voffB);
        PG8_WAIT_V(6); PG8_BAR;
    }
    for (;;) {
        const bool has_next = S.next(ui + 1, nxt);
        const char* nA = has_next ? (const char*)g.A + (size_t)nxt.pm * tstep : cA; const char* nB = has_next ? (const char*)g.Bt + (size_t)nxt.pn * tstep : cB;
        for (int t = 0; t < nt; t += 2) {
            const bool last = (t == nt - 2);
            const char* a1 = cA + (size_t)(t + 1) * kstep;
            const char* a2 = last ? nA : cA + (size_t)(t + 2) * kstep; const char* b2 = last ? nB : cB + (size_t)(t + 2) * kstep;
            const char* a3 = a2 + kstep; const char* b3 = b2 + kstep;
            if (last && has_next) S.a_ready(nxt);
            if constexpr (SP2) {
            PG8_LDB(B0, 0, 0); PG8_LDB(B1, 0, 1); PG8_SCHED; PG8_LDA(At, 0, 0); PG8_STAGE(PG8_SA(1, 1), a1 + hstep, voffA);
            PG8_WAIT_V(8); PG8_WAIT_L(0); PG8_BAR; PG8_MMA(0, 0, At, B0); PG8_MMA(0, 1, At, B1); PG8_BAR; PG8_SCHED;
            PG8_LDA(At, 0, 1); PG8_STAGE(PG8_SB(0, 0), b2, voffB); PG8_STAGE(PG8_SB(0, 1), b2 + hstep, voffB); PG8_STAGE(PG8_SA(0, 0), a2, voffA);
            PG8_WAIT_V(8); PG8_WAIT_L(0); PG8_BAR; PG8_MMA(1, 0, At, B0); PG8_MMA(1, 1, At, B1); PG8_BAR; PG8_SCHED;
            PG8_LDB(B0, 1, 0); PG8_LDB(B1, 1, 1); PG8_SCHED; PG8_LDA(At, 1, 0); PG8_STAGE(PG8_SA(0, 1), a2 + hstep, voffA);
            PG8_WAIT_V(8); PG8_WAIT_L(0); PG8_BAR; PG8_MMA(0, 0, At, B0); PG8_MMA(0, 1, At, B1); PG8_BAR; PG8_SCHED;
            PG8_LDA(At, 1, 1); PG8_STAGE(PG8_SB(1, 0), b3, voffB); PG8_STAGE(PG8_SB(1, 1), b3 + hstep, voffB); PG8_STAGE(PG8_SA(1, 0), a3, voffA);
            PG8_WAIT_V(8); PG8_WAIT_L(0); PG8_BAR; PG8_MMA(1, 0, At, B0); PG8_MMA(1, 1, At, B1); PG8_BAR; PG8_SCHED;
            } else {
            PG8_LDB(B0, 0, 0); PG8_SCHED; PG8_LDA(At, 0, 0); PG8_STAGE(PG8_SA(1, 1), a1 + hstep, voffA);
            PG8_WAIT_L(8); PG8_BAR; PG8_WAIT_L(0); PG8_MMA(0, 0, At, B0); PG8_BAR; PG8_SCHED;
            PG8_LDB(B1, 0, 1); PG8_STAGE(PG8_SB(0, 0), b2, voffB);
            PG8_BAR; PG8_WAIT_L(0); PG8_MMA(0, 1, At, B1); PG8_BAR;
            PG8_LDA(At, 0, 1); PG8_STAGE(PG8_SA(0, 0), a2, voffA);
            PG8_BAR; PG8_WAIT_L(0); PG8_MMA(1, 0, At, B0); PG8_BAR; PG8_SCHED;
            PG8_STAGE(PG8_SB(0, 1), b2 + hstep, voffB);
            PG8_WAIT_V(6); PG8_BAR; PG8_MMA(1, 1, At, B1); PG8_BAR;
            PG8_LDB(B0, 1, 0); PG8_SCHED; PG8_LDA(At, 1, 0); PG8_STAGE(PG8_SA(0, 1), a2 + hstep, voffA);
            PG8_WAIT_L(8); PG8_BAR; PG8_WAIT_L(0); PG8_MMA(0, 0, At, B0); PG8_BAR; PG8_SCHED;
            PG8_LDB(B1, 1, 1); PG8_STAGE(PG8_SB(1, 0), b3, voffB);
            PG8_BAR; PG8_WAIT_L(0); PG8_MMA(0, 1, At, B1); PG8_BAR;
            PG8_LDA(At, 1, 1); PG8_STAGE(PG8_SA(1, 0), a3, voffA);
            PG8_BAR; PG8_WAIT_L(0); PG8_MMA(1, 0, At, B0); PG8_BAR; PG8_SCHED;
            PG8_STAGE(PG8_SB(1, 1), b3 + hstep, voffB);
            PG8_WAIT_V(6); PG8_BAR; PG8_MMA(1, 1, At, B1); PG8_BAR;
            }
        }
        if constexpr (ALIGN_EPI) { if (wr == 0) PG8_BAR; }
        if constexpr (!Epi::AFTER_DRAIN) { E(acc, cur, wr, wc, fr, fq); S.done(cur); }
        if (!has_next) break;
        if constexpr (Epi::INIT) E.init(acc, nxt, wr, wc, fr, fq);
        else {
#pragma unroll
        for (int a = 0; a < 2; ++a)
#pragma unroll
            for (int b = 0; b < 2; ++b)
#pragma unroll
                for (int m = 0; m < 4; ++m)
#pragma unroll
                    for (int n = 0; n < 2; ++n) acc[a][b][m][n] = (f32x4){0.f, 0.f, 0.f, 0.f};
        }
        cur = nxt; cA = nA; cB = nB; ++ui;
        if constexpr (ALIGN_EPI) { if (wr == 1) PG8_BAR; }
    }
    PG8_WAIT_V(0);
    if constexpr (!ALIGN_EPI) { if (wr == 0) PG8_BAR; }
    PG8_BAR;
    if constexpr (Epi::AFTER_DRAIN) { E.fused(acc, cur, wr, wc, fr, fq, lds, wid, lane); S.done(cur); }
#undef PG8_SA
#undef PG8_SB
#undef PG8_STAGE
#undef PG8_LDA
#undef PG8_LDB
#undef PG8_MMA
#undef PG8_WAIT_V
#undef PG8_WAIT_L
#undef PG8_BAR
#undef PG8_SCHED
}
}

constexpr int NBATCH = 4, T = 2048, D = 2048, M = NBATCH * T, DEPTH = 4, DFF = 5632, NUP = 2 * DFF, NIN = 6144, DIN = 6152, DPLE = 256;
constexpr int NH = 4, HD = 128, DKM = 128, DVM = 256, NBH = NBATCH * NH;
constexpr int ZQA = 0, ZKA = 512, ZVA = 1024, ZQC = 1536, ZKC = 2048, ZVC = 2560, ZQKM = 3072, ZVM = 4096, ZOM = 5120;
constexpr float RMS_EPS = 1e-6f, LOG2E = 1.4426950408889634f;
constexpr int NWAVES = 8;

constexpr size_t MiB = 1u << 20;
constexpr size_t WS_CTL = 0, CTL_ZERO_BYTES = 1 * MiB;
constexpr size_t WS_W = 2 * MiB, LW_UP1 = 0, LW_DN1 = 44 * MiB, LW_IN = 66 * MiB, LW_OUT = 90 * MiB, LW_UP2 = 98 * MiB, LW_DN2 = 142 * MiB, LW_G = 164 * MiB, LW_P = 172 * MiB, LW_STRIDE = 174 * MiB;
constexpr size_t WS_HB0 = 700 * MiB, WS_HB1 = 732 * MiB, WS_SSQ0 = 764 * MiB, WS_SSQ1 = 765 * MiB, WS_GATES = 766 * MiB, WS_BCUM = 767 * MiB;
constexpr size_t WS_ACT = 768 * MiB, WS_Z = 856 * MiB, WS_MIXED = 952 * MiB, WS_PP = 984 * MiB, WS_PB = 1016 * MiB;
constexpr size_t WS_QC = 1032 * MiB, WS_KC = 1040 * MiB, WS_KMEAN = 1048 * MiB, WS_DLSE = 1049 * MiB, WS_DOUT = 1056 * MiB;
constexpr size_t WS_BQ = 1050 * MiB, WS_AQ = WS_BQ + 131072, WS_BLAST = WS_AQ + 131072, WS_AMAX = WS_BLAST + 4096, WS_MST = WS_AMAX + 4096, WS_DN = 1051 * MiB, WS_NST = WS_DN + 262144;
constexpr size_t WS_DCT = 1104 * MiB, WS_CST = 1168 * MiB, WS_MOUT = 1200 * MiB, WS_MLSE = 1248 * MiB, WS_END = 1250 * MiB;
static_assert(WS_W + 4 * LW_STRIDE <= WS_HB0 && WS_ACT + (size_t)M * DFF * 2 <= WS_Z && WS_Z + (size_t)M * NIN * 2 <= WS_MIXED, "d_ws map");
constexpr int CW_BAR = 4096, CW_QUEUE = 8192;

constexpr int RING_OFF = 0, RING_BYTES = 131072;
constexpr int SCR_BYTES = 8 * 16640;
constexpr int LDSCTL_OFF = SCR_BYTES, MISC_OFF = LDSCTL_OFF + 320;
constexpr int LDS_BYTES = 147456;
static_assert(MISC_OFF + 128 <= LDS_BYTES && SCR_BYTES >= RING_BYTES, "LDS map");

#define GAS __attribute__((address_space(1)))
#define LAS __attribute__((address_space(3)))
typedef unsigned short bf16;
typedef unsigned v4u __attribute__((ext_vector_type(4)));
typedef unsigned v2u __attribute__((ext_vector_type(2)));
typedef float f32x4 __attribute__((ext_vector_type(4)));
typedef GAS unsigned gu32;
#define RLX_AGENT __ATOMIC_RELAXED, __HIP_MEMORY_SCOPE_AGENT
#define LDS_WAIT() asm volatile("s_waitcnt lgkmcnt(0)" ::: "memory")
#define VM_WAIT() asm volatile("s_waitcnt vmcnt(0)" ::: "memory")
__device__ __forceinline__ unsigned f2bf(float f) { unsigned u = __builtin_bit_cast(unsigned, f); return (u + 0x7fffu + ((u >> 16) & 1u)) >> 16; }
__device__ __forceinline__ unsigned pk2(float lo, float hi) { return f2bf(lo) | (f2bf(hi) << 16); }
__device__ __forceinline__ float bflo(unsigned w) { return __uint_as_float(w << 16); }
__device__ __forceinline__ float bfhi(unsigned w) { return __uint_as_float(w & 0xffff0000u); }
__device__ __forceinline__ float sigmoid_fast(float x) { return __builtin_amdgcn_rcpf(1.0f + __builtin_amdgcn_exp2f(-1.4426950408889634f * x)); }
__device__ __forceinline__ float bf2f(bf16 b) { return __uint_as_float(((unsigned)b) << 16); }

#define XB_TMO      128
#define XB_XCNT(j)  (256  + 64 * (j))
#define XB_XSUB(j)  (1280 + 64 * (j))
#define XB_XGEN(j)  (2304 + 64 * (j))
#define XB_TOP      3328
#define XB_TOPGEN   3392
#define XCD_BAR_WORDS 3456
#define XB_SPIN_CAP (1u << 18)

__device__ __forceinline__ unsigned xb_ld(unsigned* p)              { return __hip_atomic_load(p, __ATOMIC_RELAXED, __HIP_MEMORY_SCOPE_AGENT); }
__device__ __forceinline__ unsigned xb_add(unsigned* p, unsigned v) { return __hip_atomic_fetch_add(p, v, __ATOMIC_RELAXED, __HIP_MEMORY_SCOPE_AGENT); }
__device__ __forceinline__ unsigned xb_xcc_id() { return (unsigned)__builtin_amdgcn_s_getreg((3 << 11) | 20) & 0xFu; }
#define XB_SPIN(cond, bar) do { unsigned _sp = 0; while (cond) { __builtin_amdgcn_s_sleep(1); \
    if ((++_sp & 255u) == 0u) { if (xb_ld(&(bar)[XB_TMO])) break; if (_sp > XB_SPIN_CAP) { atomicAdd(&(bar)[XB_TMO], 1u); break; } } } } while (0)

struct XcdBarrier {
    unsigned* bar; unsigned x;
    volatile LAS unsigned* st;
};

__device__ __forceinline__ XcdBarrier xcd_barrier_post(unsigned* bar, volatile LAS unsigned* st) {
    XcdBarrier b; b.bar = bar; b.x = xb_xcc_id(); b.st = st;
    if (threadIdx.x == 0) (void)xb_add(&bar[XB_XCNT(b.x)], 1u);
    return b;
}
__device__ __forceinline__ void xcd_barrier_complete(unsigned* bar, unsigned x, unsigned& nloc, unsigned& nx) {
    const unsigned G = gridDim.x * gridDim.y * gridDim.z;
    unsigned sum, cnt, mine, sp = 0u;
    for (;;) {
        sum = 0u; cnt = 0u; mine = 0u;
#pragma unroll
        for (unsigned j = 0; j < 16; ++j) { const unsigned c = xb_ld(&bar[XB_XCNT(j)]); sum += c; cnt += (c > 0u) ? 1u : 0u; mine = (j == x) ? c : mine; }
        if (sum == G) break;
        __builtin_amdgcn_s_sleep(1);
        if ((++sp & 255u) == 0u) { if (xb_ld(&bar[XB_TMO])) break; if (sp > XB_SPIN_CAP) { atomicAdd(&bar[XB_TMO], 1u); break; } }
    }
    nloc = mine > 0u ? mine : 1u; nx = cnt > 0u ? cnt : 1u;
}

__device__ __forceinline__ void xcd_barrier(const XcdBarrier& b) {
    asm volatile("s_waitcnt vmcnt(0)" ::: "memory");
    __syncthreads();
    if (threadIdx.x == 0) {
        unsigned* bar = b.bar;
        __builtin_amdgcn_s_waitcnt(0);
        unsigned nloc = b.st[0], nx = b.st[1];
        if (nloc == 0u) { xcd_barrier_complete(bar, b.x, nloc, nx); b.st[0] = nloc; b.st[1] = nx; }
        const unsigned old = xb_add(&bar[XB_XSUB(b.x)], 1u);
        const unsigned gen = old / nloc;
        if (old + 1u == (gen + 1u) * nloc) {
            __builtin_amdgcn_fence(__ATOMIC_RELEASE, "agent");
            asm volatile("s_waitcnt vmcnt(0)" ::: "memory");
            const unsigned og = xb_add(&bar[XB_TOP], 1u);
            const unsigned tg = og / nx;
            if (og + 1u == (tg + 1u) * nx) xb_add(&bar[XB_TOPGEN], 1u);
            else XB_SPIN(xb_ld(&bar[XB_TOPGEN]) == tg, bar);
            __builtin_amdgcn_fence(__ATOMIC_ACQUIRE, "agent");
            xb_add(&bar[XB_XGEN(b.x)], 1u);
            asm volatile("s_waitcnt vmcnt(0)" ::: "memory");
        } else {
            XB_SPIN(xb_ld(&bar[XB_XGEN(b.x)]) == gen, bar);
            __builtin_amdgcn_fence(__ATOMIC_ACQUIRE, "agent");
            asm volatile("s_waitcnt vmcnt(0)" ::: "memory");
        }
    }
    __syncthreads();
}


struct BarHook { const XcdBarrier& b; bool on; __device__ __forceinline__ void operator()() const { if (on) xcd_barrier(b); } };
struct Args { const float* in[20]; float* out; unsigned char* ws; int ph_lo, ph_hi; };
struct Frame {
    LAS unsigned char* lds;
    volatile LAS unsigned* MISC;
    gu32* ctl;
    int tid, lane, wave, wave0;
    int vcu, G;
    float* out; unsigned char* ws;
};
__device__ __forceinline__ float wave_sum(float v) { return wv::wave_sum(v); }
__device__ __forceinline__ float wave_max(float v) { return wv::wave_max(v); }
__device__ __forceinline__ bf16* wptr(Frame& F, int layer, size_t off) { return (bf16*)(F.ws + WS_W + (size_t)layer * LW_STRIDE + off); }
#define WPTR(off) ((bf16*)(ws + WS_W + (size_t)L * LW_STRIDE + (off)))

#define OPAQUE_TID(F) do { int w_ = (F).wave0; asm volatile("" : "+s"(w_)); int l_; asm volatile("v_mbcnt_lo_u32_b32 %0, -1, 0\n\tv_mbcnt_hi_u32_b32 %0, -1, %0" : "=v"(l_)); (F).lane = l_; (F).wave = w_; (F).tid = w_ * 64 + l_; } while (0)
struct ItemDesc { const float* W; const float* g; bf16* WT; int K, ldn, upmap, k0, n0; };
struct ItemRegs { f32x4 v[16], g0, g1; };
__device__ __forceinline__ void item_load(const ItemDesc& d, int lane, ItemRegs& R) {
    const int kq = lane >> 4, nc = (lane & 15) * 4, c = lane & 7;
    const float* src = d.W + (size_t)(d.k0 + kq) * d.ldn + d.n0 + nc;
    const float* gp = d.g ? d.g + d.k0 + 8 * c : src;
    R.g0 = *(const GAS f32x4*)gp; R.g1 = *(const GAS f32x4*)(gp + 4);
#pragma unroll
    for (int i = 0; i < 16; ++i) R.v[i] = __builtin_nontemporal_load((const GAS f32x4*)(src + (size_t)(4 * i) * d.ldn));
}
__device__ __forceinline__ void item_finish(const ItemDesc& d, LAS float* scr, int lane, const ItemRegs& R) {
    const int kq = lane >> 4, nc = (lane & 15) * 4;
#pragma unroll
    for (int i = 0; i < 16; ++i) { LAS float* p = scr + (4 * i + kq) * 65 + nc; p[0] = R.v[i][0]; p[1] = R.v[i][1]; p[2] = R.v[i][2]; p[3] = R.v[i][3]; }
    int drow0 = d.n0;
    if (d.upmap) { const int bj = d.n0 / DFF, j = d.n0 - bj * DFF; drow0 = 256 * (j >> 7) + 128 * bj + (j & 127); }
    const int c = lane & 7;
    const f32x4 one4 = (f32x4){1.f, 1.f, 1.f, 1.f}; const f32x4 g0 = d.g ? R.g0 : one4, g1 = d.g ? R.g1 : one4;
    LDS_WAIT(); asm volatile("" ::: "memory");
#pragma unroll
    for (int j = 0; j < 8; ++j) { const int n = (lane >> 3) + 8 * j; const LAS float* s_ = scr + (8 * c) * 65 + n;
        v4u o; o.x = pk2(s_[0 * 65] * g0[0], s_[1 * 65] * g0[1]); o.y = pk2(s_[2 * 65] * g0[2], s_[3 * 65] * g0[3]); o.z = pk2(s_[4 * 65] * g1[0], s_[5 * 65] * g1[1]); o.w = pk2(s_[6 * 65] * g1[2], s_[7 * 65] * g1[3]);
        *(GAS v4u*)(d.WT + (size_t)(drow0 + n) * d.K + d.k0 + 8 * c) = o; }
    LDS_WAIT(); asm volatile("" ::: "memory");
}
constexpr int I_UP = (D / 64) * (NUP / 64), I_DN = (DFF / 64) * (D / 64), I_IN = (D / 64) * (NIN / 64), I_SQ = (D / 64) * (D / 64), I_P = (DPLE / 64) * (D / 64);
constexpr int I_LAYER = 2 * I_UP + 2 * I_DN + I_IN + 2 * I_SQ + I_P, I_SPLIT = 12544;
__device__ __forceinline__ ItemDesc decode_item(Frame& F, const Args& A, int l, int it) {
    ItemDesc d; int r = it, nblk;
    if (r < I_UP) { d.W = A.in[3] + (size_t)l * D * NUP; d.K = D; d.ldn = NUP; d.g = A.in[2] + l * D; d.WT = wptr(F, l, LW_UP1); d.upmap = 1; nblk = NUP / 64; }
    else if ((r -= I_UP) < I_DN) { d.W = A.in[4] + (size_t)l * DFF * D; d.K = DFF; d.ldn = D; d.g = nullptr; d.WT = wptr(F, l, LW_DN1); d.upmap = 0; nblk = D / 64; }
    else if ((r -= I_DN) < I_IN) { d.W = A.in[6] + (size_t)l * D * DIN; d.K = D; d.ldn = DIN; d.g = A.in[5] + l * D; d.WT = wptr(F, l, LW_IN); d.upmap = 0; nblk = NIN / 64; }
    else if ((r -= I_IN) < I_SQ) { d.W = A.in[12] + (size_t)l * D * D; d.K = D; d.ldn = D; d.g = nullptr; d.WT = wptr(F, l, LW_OUT); d.upmap = 0; nblk = D / 64; }
    else if ((r -= I_SQ) < I_UP) { d.W = A.in[14] + (size_t)l * D * NUP; d.K = D; d.ldn = NUP; d.g = A.in[13] + l * D; d.WT = wptr(F, l, LW_UP2); d.upmap = 1; nblk = NUP / 64; }
    else if ((r -= I_UP) < I_DN) { d.W = A.in[15] + (size_t)l * DFF * D; d.K = DFF; d.ldn = D; d.g = nullptr; d.WT = wptr(F, l, LW_DN2); d.upmap = 0; nblk = D / 64; }
    else if ((r -= I_DN) < I_SQ) { d.W = A.in[17] + (size_t)l * D * D; d.K = D; d.ldn = D; d.g = A.in[16] + l * D; d.WT = wptr(F, l, LW_G); d.upmap = 0; nblk = D / 64; }
    else { r -= I_SQ; d.W = A.in[18] + (size_t)l * DPLE * D; d.K = DPLE; d.ldn = D; d.g = nullptr; d.WT = wptr(F, l, LW_P); d.upmap = 0; nblk = D / 64; }
    const int kb = r / nblk; d.k0 = 64 * kb; d.n0 = 64 * (r - kb * nblk);
    return d;
}
__device__ __forceinline__ void convert_items_lw(Frame& F, const Args& A, int l, int it_lo, int it_hi, int wv, int nwv, int wave_, int lane_) {
    LAS float* scr = (LAS float*)(F.lds + wave_ * 16640);
    int it = it_lo + wv;
    if (it >= it_hi) return;
    ItemRegs R0, R1;
    ItemDesc d0 = decode_item(F, A, l, it), d1 = d0;
    item_load(d0, lane_, R0);
    for (;;) {
        const int n1 = it + nwv;
        if (n1 < it_hi) { d1 = decode_item(F, A, l, n1); item_load(d1, lane_, R1); }
        item_finish(d0, scr, lane_, R0);
        if (n1 >= it_hi) break;
        const int n2 = n1 + nwv;
        if (n2 < it_hi) { d0 = decode_item(F, A, l, n2); item_load(d0, lane_, R0); }
        item_finish(d1, scr, lane_, R1);
        if (n2 >= it_hi) break;
        it = n2;
    }
}
__device__ __forceinline__ void convert_items(Frame& F, const Args& A, int l, int it_lo, int it_hi, int wv, int nwv) { convert_items_lw(F, A, l, it_lo, it_hi, wv, nwv, F.wave, F.lane); }
__device__ __forceinline__ void convert_part(Frame& F, const Args& A, int l, int part, int wv, int nwv) {
    if (part) convert_items(F, A, l, I_SPLIT, I_LAYER - I_P, wv, nwv);
    else { convert_items(F, A, l, 0, I_SPLIT, wv, nwv); convert_items(F, A, l, I_LAYER - I_P, I_LAYER, wv, nwv); }
}
#ifndef CONV_NA
#define CONV_NA 3584
#define CONV_ND0 6400
#endif
constexpr int CONV_CH = 32;
constexpr int CQ_N1 = (I_LAYER - I_P - I_SPLIT) - CONV_NA, CQ_U1 = (CQ_N1 + CONV_CH - 1) / CONV_CH, CQ_U2 = (CONV_ND0 + CONV_CH - 1) / CONV_CH;
__device__ __forceinline__ void convert_tail(Frame& F, const Args& A, int l, int part, int bx) {
    OPAQUE_TID(F);
    if (l >= DEPTH) return;
    const int wv = (bx - 128) * NWAVES + F.wave, nwv = 128 * NWAVES;
    if (part) convert_items(F, A, l, I_SPLIT, I_SPLIT + CONV_NA, wv, nwv);
    else { convert_items(F, A, l, CONV_ND0, I_SPLIT, wv, nwv); convert_items(F, A, l, I_LAYER - I_P, I_LAYER, wv, nwv); }
    __syncthreads();
}
__device__ __forceinline__ void convert_queue_unit(Frame& F, const Args& A, int layer, int cu) {
    int l, lo, hi;
    if (cu < CQ_U1) { l = layer; lo = I_SPLIT + CONV_NA + cu * CONV_CH; hi = lo + CONV_CH < I_LAYER - I_P ? lo + CONV_CH : I_LAYER - I_P; }
    else { l = layer + 1; lo = (cu - CQ_U1) * CONV_CH; hi = lo + CONV_CH < CONV_ND0 ? lo + CONV_CH : CONV_ND0; }
    int w_ = F.wave0; asm volatile("" : "+s"(w_)); int l_; asm volatile("v_mbcnt_lo_u32_b32 %0, -1, 0\n\tv_mbcnt_hi_u32_b32 %0, -1, %0" : "=v"(l_));
    convert_items_lw(F, A, l, lo, hi, w_, NWAVES, w_, l_);
}
__device__ __forceinline__ void p0_prologue(Frame& F, const Args& A) {
    OPAQUE_TID(F);
    const int gw = F.vcu * NWAVES + F.wave, NGW = F.G * NWAVES;
    if (F.G == 256) convert_part(F, A, 0, 0, gw, NGW);
    else for (int l = 0; l < DEPTH; ++l) convert_items(F, A, l, 0, I_LAYER, gw, NGW);
    bf16* hb = (bf16*)(F.ws + WS_HB0); float* ssq = (float*)(F.ws + WS_SSQ0);
    for (int m0 = gw; m0 < M; m0 += 4 * NGW) {
        f32x4 xv[4][8];
#pragma unroll
        for (int r = 0; r < 4; ++r) { const int m = m0 + r * NGW < M ? m0 + r * NGW : m0; const GAS f32x4* xr = (const GAS f32x4*)(A.in[0] + (size_t)m * D) + F.lane;
#pragma unroll
            for (int j = 0; j < 8; ++j) xv[r][j] = xr[64 * j]; }
        asm volatile("" ::: "memory");
#pragma unroll
        for (int r = 0; r < 4; ++r) { const int m = m0 + r * NGW; if (m >= M) break;
            GAS v2u* br = (GAS v2u*)(hb + (size_t)m * D) + F.lane; float s = 0.f;
#pragma unroll
            for (int j = 0; j < 8; ++j) { const f32x4 v = xv[r][j]; v2u o; o.x = pk2(v[0], v[1]); o.y = pk2(v[2], v[3]); br[64 * j] = o;
                const float r0 = bflo(o.x), r1 = bfhi(o.x), r2 = bflo(o.y), r3 = bfhi(o.y); s += (r0 * r0 + r1 * r1) + (r2 * r2 + r3 * r3); }
            s = wave_sum(s);
            if (F.lane < 32) ssq[(size_t)m * 32 + F.lane] = F.lane == 0 ? s : 0.f; }
    }
    { const size_t n8 = (size_t)DEPTH * M * DPLE / 8, st = (size_t)NGW * 64; const float* p = A.in[1]; bf16* pb = (bf16*)(F.ws + WS_PB);
      for (size_t i0 = (size_t)gw * 64 + F.lane; i0 < n8; i0 += 8 * st) {
          f32x4 a[8], b[8];
#pragma unroll
          for (int u = 0; u < 8; ++u) { const size_t i = i0 + u * st < n8 ? i0 + u * st : i0; a[u] = *(const GAS f32x4*)(p + i * 8); b[u] = *(const GAS f32x4*)(p + i * 8 + 4); }
          asm volatile("" ::: "memory");
#pragma unroll
          for (int u = 0; u < 8; ++u) { const size_t i = i0 + u * st; if (i >= n8) break;
              v4u o; o.x = pk2(a[u][0], a[u][1]); o.y = pk2(a[u][2], a[u][3]); o.z = pk2(b[u][0], b[u][1]); o.w = pk2(b[u][2], b[u][3]); *(GAS v4u*)(pb + i * 8) = o; } } }
}

__device__ __forceinline__ void gates_phase(Frame& F, const Args& A, int layer, const float* ssq, const bf16* hbs) {
    OPAQUE_TID(F);
    const float* w = A.in[6] + (size_t)layer * D * DIN + NIN; const float* g = A.in[5] + layer * D; float* gates = (float*)(F.ws + WS_GATES);
    LAS float* Wt = (LAS float*)F.lds;
    __syncthreads();
    { float gk[4]; f32x4 w0[4], w1[4];
#pragma unroll
      for (int i = 0; i < 4; ++i) { const int k = F.tid + 512 * i; gk[i] = g[k]; w0[i] = *(const GAS f32x4*)(w + (size_t)k * DIN); w1[i] = *(const GAS f32x4*)(w + (size_t)k * DIN + 4); }
      asm volatile("" ::: "memory");
#pragma unroll
      for (int i = 0; i < 4; ++i) { const int k = F.tid + 512 * i;
#pragma unroll
        for (int j = 0; j < 4; ++j) { Wt[j * 2048 + k] = w0[i][j] * gk[i]; Wt[(4 + j) * 2048 + k] = w1[i][j] * gk[i]; } } }
    __syncthreads();
    for (int rg = F.vcu; rg < M / 32; rg += F.G) {
        const int row0 = rg * 32 + F.wave * 4;
        float sqv[4];
#pragma unroll
        for (int r = 0; r < 4; ++r) sqv[r] = F.lane < 32 ? ssq[(size_t)(row0 + r) * 32 + F.lane] : 0.f;
        float acc[4][8];
#pragma unroll
        for (int r = 0; r < 4; ++r)
#pragma unroll
            for (int j = 0; j < 8; ++j) acc[r][j] = 0.f;
        v2u hw[8][4];
#pragma unroll
        for (int i = 0; i < 8; ++i)
#pragma unroll
            for (int r = 0; r < 4; ++r) hw[i][r] = *(const GAS v2u*)(hbs + (size_t)(row0 + r) * D + 4 * F.lane + 256 * i);
        asm volatile("" ::: "memory");
#pragma unroll
        for (int i = 0; i < 8; ++i) {
            f32x4 hv[4];
#pragma unroll
            for (int r = 0; r < 4; ++r) hv[r] = (f32x4){bflo(hw[i][r].x), bfhi(hw[i][r].x), bflo(hw[i][r].y), bfhi(hw[i][r].y)};
#pragma unroll
            for (int j = 0; j < 8; ++j) { const f32x4 wv_ = *(const LAS f32x4*)(Wt + j * 2048 + 4 * F.lane + 256 * i);
#pragma unroll
                for (int r = 0; r < 4; ++r) acc[r][j] += (hv[r][0] * wv_[0] + hv[r][1] * wv_[1]) + (hv[r][2] * wv_[2] + hv[r][3] * wv_[3]); }
        }
        float val = 0.f;
#pragma unroll
        for (int r = 0; r < 4; ++r) {
            const float sq = wave_sum(sqv[r]);
            const float rstd = __builtin_amdgcn_rsqf(sq * (1.0f / D) + RMS_EPS);
#pragma unroll
            for (int j = 0; j < 8; ++j) { const float t_ = wave_sum(acc[r][j]) * rstd; if (F.lane == r * 8 + j) val = t_; }
        }
        if (F.lane < 32) { const int j = F.lane & 7; const float bias = j < 4 ? A.in[9][layer * 4 + j] : A.in[10][layer * 4 + j - 4]; gates[(size_t)row0 * 8 + F.lane] = val + bias; }
    }
    __syncthreads();
}
__device__ __forceinline__ void final_norm(Frame& F, const Args& A) {
    OPAQUE_TID(F);
    const int gw = F.vcu * NWAVES + F.wave, NGW = F.G * NWAVES; const float* g = A.in[19];
    const bf16* hfin = (const bf16*)(F.ws + ((DEPTH & 1) ? WS_HB1 : WS_HB0));
    f32x4 gv[8];
#pragma unroll
    for (int j = 0; j < 8; ++j) gv[j] = *((const GAS f32x4*)g + F.lane + 64 * j);
    for (int m0 = gw; m0 < M; m0 += 4 * NGW) {
        v2u hw[4][8];
#pragma unroll
        for (int r = 0; r < 4; ++r) { const int m = m0 + r * NGW < M ? m0 + r * NGW : m0; const GAS v2u* br = (const GAS v2u*)(hfin + (size_t)m * D) + F.lane;
#pragma unroll
            for (int j = 0; j < 8; ++j) hw[r][j] = br[64 * j]; }
        asm volatile("" ::: "memory");
#pragma unroll
        for (int r = 0; r < 4; ++r) { const int m = m0 + r * NGW; if (m >= M) break;
            GAS f32x4* hr = (GAS f32x4*)(F.out + (size_t)m * D) + F.lane; f32x4 v[8]; float s = 0.f;
#pragma unroll
            for (int j = 0; j < 8; ++j) { v[j] = (f32x4){bflo(hw[r][j].x), bfhi(hw[r][j].x), bflo(hw[r][j].y), bfhi(hw[r][j].y)}; s += (v[j][0] * v[j][0] + v[j][1] * v[j][1]) + (v[j][2] * v[j][2] + v[j][3] * v[j][3]); }
            const float rstd = 1.0f / sqrtf(wave_sum(s) * (1.0f / D) + RMS_EPS);
#pragma unroll
            for (int j = 0; j < 8; ++j) hr[64 * j] = v[j] * rstd * gv[j]; }
    }
}


namespace att {
typedef short bf16x8 __attribute__((ext_vector_type(8)));
typedef short s16x4 __attribute__((ext_vector_type(4)));
constexpr int KP = 272, VP = 288, OFF_K0 = 0, OFF_K1 = 64 * KP, OFF_V0 = 128 * KP, OFF_V1 = 128 * KP + 64 * VP, OFF_MISC = 128 * KP + 128 * VP, OFF_KM = 73728;
constexpr float NEG = -1.0e30f, MASKED = -2.0e30f;
struct TileRegs { v4u k[2], v[2]; };
__device__ __forceinline__ void tile_load(TileRegs& R, const bf16* kbase, const bf16* vbase, size_t stride, int key0, int nkeys, int tid) {
#pragma unroll
    for (int i = 0; i < 2; ++i) { const int c = tid + 512 * i, row = c >> 4, ch = c & 15; int key = key0 + row; key = key < 0 ? 0 : (key >= nkeys ? nkeys - 1 : key);
        R.k[i] = *(const GAS v4u*)(kbase + (size_t)key * stride + ch * 8); R.v[i] = *(const GAS v4u*)(vbase + (size_t)key * stride + ch * 8); }
}
__device__ __forceinline__ void tile_store(LAS unsigned char* lds, int buf, const TileRegs& R, int tid) {
#pragma unroll
    for (int i = 0; i < 2; ++i) { const int c = tid + 512 * i, row = c >> 4, ch = c & 15;
        *(LAS v4u*)(lds + (buf ? OFF_K1 : OFF_K0) + row * KP + ch * 16) = R.k[i]; *(LAS v4u*)(lds + (buf ? OFF_V1 : OFF_V0) + row * VP + ch * 16) = R.v[i]; }
}
__device__ __forceinline__ float quad_max(float x) { return wv::quad_max(x); }
__device__ __forceinline__ float quad_sum(float x) { return wv::quad_sum(x); }
__device__ __forceinline__ void qk_tile(const LAS unsigned char* kt, const bf16x8 (&Qf)[4], int fr, int g, f32x4 (&s)[4]) {
    bf16x8 kf[4][4];
#pragma unroll
    for (int kb = 0; kb < 4; ++kb)
#pragma unroll
        for (int ks = 0; ks < 4; ++ks) kf[kb][ks] = *(const LAS bf16x8*)(kt + (16 * kb + fr) * KP + (4 * ks + g) * 16);
#pragma unroll
    for (int kb = 0; kb < 4; ++kb) s[kb] = (f32x4){0.f, 0.f, 0.f, 0.f};
#pragma unroll
    for (int ks = 0; ks < 4; ++ks)
#pragma unroll
        for (int kb = 0; kb < 4; ++kb) s[kb] = __builtin_amdgcn_mfma_f32_16x16x32_bf16(kf[kb][ks], Qf[ks], s[kb], 0, 0, 0);
}
__device__ __forceinline__ void pv_tile(const LAS unsigned char* vt, const f32x4 (&p)[4], int fr, int g, f32x4 (&O)[8]) {
    const int q = fr >> 2, pp = fr & 3;
#pragma unroll
    for (int t = 0; t < 2; ++t) {
        bf16x8 pf; { v4u w; w.x = pg8::cvt_pk_bf16(p[2 * t][0], p[2 * t][1]); w.y = pg8::cvt_pk_bf16(p[2 * t][2], p[2 * t][3]); w.z = pg8::cvt_pk_bf16(p[2 * t + 1][0], p[2 * t + 1][1]); w.w = pg8::cvt_pk_bf16(p[2 * t + 1][2], p[2 * t + 1][3]); pf = __builtin_bit_cast(bf16x8, w); }
        const LAS unsigned char* base = vt + (32 * t + 4 * g + q) * VP + 8 * pp;
        s16x4 lo[8], hi[8];
#pragma unroll
        for (int db = 0; db < 8; ++db) { lo[db] = __builtin_amdgcn_ds_read_tr16_b64_v4i16((LAS s16x4*)(base + db * 32)); hi[db] = __builtin_amdgcn_ds_read_tr16_b64_v4i16((LAS s16x4*)(base + 16 * VP + db * 32)); }
#pragma unroll
        for (int db = 0; db < 8; ++db) { const bf16x8 vf = __builtin_shufflevector(lo[db], hi[db], 0, 1, 2, 3, 4, 5, 6, 7); O[db] = __builtin_amdgcn_mfma_f32_16x16x32_bf16(vf, pf, O[db], 0, 0, 0); }
    }
}
__device__ __forceinline__ void softmax_step(f32x4 (&sc)[4], float& m, float& lsum, f32x4 (&O)[8]) {
    float tm = fmaxf(fmaxf(sc[0][0], sc[0][1]), fmaxf(sc[0][2], sc[0][3]));
#pragma unroll
    for (int kb = 1; kb < 4; ++kb) tm = fmaxf(tm, fmaxf(fmaxf(sc[kb][0], sc[kb][1]), fmaxf(sc[kb][2], sc[kb][3])));
    tm = quad_max(tm);
    const float mn = fmaxf(m, tm), alpha = __builtin_amdgcn_exp2f(m - mn); float ps = 0.f;
#pragma unroll
    for (int kb = 0; kb < 4; ++kb)
#pragma unroll
        for (int r = 0; r < 4; ++r) { const float pv = __builtin_amdgcn_exp2f(sc[kb][r] - mn); sc[kb][r] = pv; ps += pv; }
    lsum = lsum * alpha + ps; m = mn;
#pragma unroll
    for (int db = 0; db < 8; ++db) O[db] = O[db] * alpha;
}
__device__ __forceinline__ void load_q(bf16x8 (&Qf)[4], const bf16* qrow, int g) {
#pragma unroll
    for (int ks = 0; ks < 4; ++ks) Qf[ks] = __builtin_bit_cast(bf16x8, *(const GAS v4u*)(qrow + 32 * ks + 8 * g));
}


template <class MaskF>
__device__ __forceinline__ void tile_step(const LAS unsigned char* kt, const LAS unsigned char* vt, const bf16x8 (&Qf)[2][4], int fr, int g, float (&m)[2], float (&lsum)[2], f32x4 (&O)[2][8], const MaskF& maskf) {
    f32x4 s[2][4];
    {
#pragma unroll
        for (int ga = 0; ga < 2; ++ga)
#pragma unroll
            for (int kb = 0; kb < 4; ++kb) s[ga][kb] = (f32x4){0.f, 0.f, 0.f, 0.f};
#pragma unroll
        for (int ks = 0; ks < 4; ++ks) {
            bf16x8 kf[4];
#pragma unroll
            for (int kb = 0; kb < 4; ++kb) kf[kb] = *(const LAS bf16x8*)(kt + (16 * kb + fr) * KP + (4 * ks + g) * 16);
#pragma unroll
            for (int kb = 0; kb < 4; ++kb) { s[0][kb] = __builtin_amdgcn_mfma_f32_16x16x32_bf16(kf[kb], Qf[0][ks], s[0][kb], 0, 0, 0); s[1][kb] = __builtin_amdgcn_mfma_f32_16x16x32_bf16(kf[kb], Qf[1][ks], s[1][kb], 0, 0, 0); }
        }
    }
#pragma unroll
    for (int ga = 0; ga < 2; ++ga) {
#pragma unroll
        for (int kb = 0; kb < 4; ++kb)
#pragma unroll
            for (int r = 0; r < 4; ++r) s[ga][kb][r] = maskf(ga, kb, r, s[ga][kb][r]);
        softmax_step(s[ga], m[ga], lsum[ga], O[ga]);
    }
    const int q = fr >> 2, pp = fr & 3;
#pragma unroll
    for (int t = 0; t < 2; ++t) {
        bf16x8 pf[2];
#pragma unroll
        for (int ga = 0; ga < 2; ++ga) { v4u w; w.x = pg8::cvt_pk_bf16(s[ga][2 * t][0], s[ga][2 * t][1]); w.y = pg8::cvt_pk_bf16(s[ga][2 * t][2], s[ga][2 * t][3]); w.z = pg8::cvt_pk_bf16(s[ga][2 * t + 1][0], s[ga][2 * t + 1][1]); w.w = pg8::cvt_pk_bf16(s[ga][2 * t + 1][2], s[ga][2 * t + 1][3]); pf[ga] = __builtin_bit_cast(bf16x8, w); }
        const LAS unsigned char* base = vt + (32 * t + 4 * g + q) * VP + 8 * pp;
#pragma unroll
        for (int db = 0; db < 8; ++db) { const s16x4 lo = __builtin_amdgcn_ds_read_tr16_b64_v4i16((LAS s16x4*)(base + db * 32)), hi = __builtin_amdgcn_ds_read_tr16_b64_v4i16((LAS s16x4*)(base + 16 * VP + db * 32));
            const bf16x8 vf = __builtin_shufflevector(lo, hi, 0, 1, 2, 3, 4, 5, 6, 7);
            O[0][db] = __builtin_amdgcn_mfma_f32_16x16x32_bf16(vf, pf[0], O[0][db], 0, 0, 0); O[1][db] = __builtin_amdgcn_mfma_f32_16x16x32_bf16(vf, pf[1], O[1][db], 0, 0, 0); }
    }
}

__device__ __forceinline__ void moba_unit(LAS unsigned char* lds, const bf16* z, const float* kmean, bf16* mixed, float* pbuf, float* plse, int bh, int cur, int part, int tid) {
    const int lane = tid & 63, w = __builtin_amdgcn_readfirstlane(tid >> 6), fr = lane & 15, g = lane >> 4;
    const int b = bh >> 2, hh = bh & 3, q0 = 256 * cur;
    const bf16* zb = z + (size_t)b * T * NIN;
    const float slope2 = exp2f(-(float)(2 * hh + 1)) * LOG2E, c1 = 0.08838834764831845f * LOG2E;
    int t[2]; bf16x8 Qf[2][4]; unsigned sel[2];
    const int nown = part == 0 ? 4 : 0, pb_lo = part == 0 ? 0 : 3 * part - 1, pb_hi_ = part == 0 ? 2 : 3 * part + 2, pb_hi = pb_hi_ < cur ? pb_hi_ : cur;
    const int npast = pb_hi > pb_lo ? 4 * (pb_hi - pb_lo) : 0, ntl = nown + npast;
    auto tile_key0 = [&](int i) -> int { return i < nown ? q0 + 64 * i : pb_lo * 256 + 64 * (i - nown); };
    const bf16* kbase = zb + ZKA + hh * 128; const bf16* vbase = zb + ZVA + hh * 128;
    TileRegs R; tile_load(R, kbase, vbase, NIN, tile_key0(0), T, tid);
#pragma unroll
    for (int ga = 0; ga < 2; ++ga) { t[ga] = q0 + 32 * w + 16 * ga + fr; load_q(Qf[ga], zb + (size_t)t[ga] * NIN + ZQA + hh * 128, g); }
    f32x4 kmv = (f32x4){0.f, 0.f, 0.f, 0.f};
    if (tid < 256) kmv = *(const GAS f32x4*)(kmean + (size_t)bh * 1024 + 4 * tid);
    f32x4 O[2][8];
#pragma unroll
    for (int ga = 0; ga < 2; ++ga)
#pragma unroll
        for (int db = 0; db < 8; ++db) O[ga][db] = (f32x4){0.f, 0.f, 0.f, 0.f};
    float m[2] = {NEG, NEG}, lsum[2] = {0.f, 0.f};
    __syncthreads();
    tile_store(lds, 0, R, tid);
    if (tid < 256) *(LAS f32x4*)(lds + OFF_KM + 16 * tid) = kmv;
    __syncthreads();
    if (1 < ntl) tile_load(R, kbase, vbase, NIN, tile_key0(1), T, tid);
    {
        float gt[2][8];
#pragma unroll
        for (int n = 0; n < 8; ++n) { float a0 = 0.f, a1 = 0.f; const LAS unsigned char* km = lds + OFF_KM + (n * 128 + 8 * g) * 4;
#pragma unroll
            for (int ks = 0; ks < 4; ++ks) { const f32x4 k0 = *(const LAS f32x4*)(km + 128 * ks), k1 = *(const LAS f32x4*)(km + 128 * ks + 16);
                const v4u qa = __builtin_bit_cast(v4u, Qf[0][ks]), qb = __builtin_bit_cast(v4u, Qf[1][ks]);
                a0 += (bflo(qa.x) * k0[0] + bfhi(qa.x) * k0[1]) + (bflo(qa.y) * k0[2] + bfhi(qa.y) * k0[3]) + (bflo(qa.z) * k1[0] + bfhi(qa.z) * k1[1]) + (bflo(qa.w) * k1[2] + bfhi(qa.w) * k1[3]);
                a1 += (bflo(qb.x) * k0[0] + bfhi(qb.x) * k0[1]) + (bflo(qb.y) * k0[2] + bfhi(qb.y) * k0[3]) + (bflo(qb.z) * k1[0] + bfhi(qb.z) * k1[1]) + (bflo(qb.w) * k1[2] + bfhi(qb.w) * k1[3]); }
            a0 = quad_sum(a0); a1 = quad_sum(a1); gt[0][n] = n < cur ? a0 : NEG; gt[1][n] = n < cur ? a1 : NEG; }
        const int nsel = cur < 3 ? cur : 3;
#pragma unroll
        for (int ga = 0; ga < 2; ++ga) { unsigned sl = 0u;
            for (int k = 0; k < nsel; ++k) { float best = 0.f; int bi = -1;
#pragma unroll
                for (int n = 0; n < 8; ++n) { const bool ok = n < cur && !((sl >> n) & 1u) && (bi < 0 || gt[ga][n] > best); if (ok) { best = gt[ga][n]; bi = n; } }
                sl |= 1u << bi; }
            sel[ga] = sl; }
    }
    for (int i = 0; i < ntl; ++i) {
        const int key0 = tile_key0(i), nb = key0 >> 8;
        const bool skip = nb == cur && key0 > q0 + 32 * w + 31;
        if (!skip) {
            const LAS unsigned char* kt = lds + ((i & 1) ? OFF_K1 : OFF_K0); const LAS unsigned char* vt = lds + ((i & 1) ? OFF_V1 : OFF_V0);
            float base[2]; int lim[2];
#pragma unroll
            for (int ga = 0; ga < 2; ++ga) { const int cl = t[ga] - key0 - 4 * g; base[ga] = -slope2 * (float)cl; lim[ga] = nb == cur ? cl : (((sel[ga] >> nb) & 1u) ? 9999 : -1); }
            tile_step(kt, vt, Qf, fr, g, m, lsum, O, [&](int ga, int kb, int r, float sv) -> float { const float v = fmaf((float)(16 * kb + r), slope2, fmaf(sv, c1, base[ga])); return (16 * kb + r <= lim[ga]) ? v : MASKED; });
        }
        if (i + 1 < ntl) tile_store(lds, (i + 1) & 1, R, tid);
        __syncthreads();
        if (i + 2 < ntl) tile_load(R, kbase, vbase, NIN, tile_key0(i + 2), T, tid);
    }
    const bool direct = cur <= 2;
#pragma unroll
    for (int ga = 0; ga < 2; ++ga) {
        const float ls = quad_sum(lsum[ga]); const float inv = ls > 0.f ? 1.0f / ls : 0.f; const size_t row = (size_t)b * T + t[ga];
        if (direct) { bf16* orow = mixed + row * D + hh * 128 + 4 * g;
#pragma unroll
            for (int db = 0; db < 8; ++db) { v2u o; o.x = pg8::cvt_pk_bf16(O[ga][db][0] * inv, O[ga][db][1] * inv); o.y = pg8::cvt_pk_bf16(O[ga][db][2] * inv, O[ga][db][3] * inv); *(GAS v2u*)(orow + 16 * db) = o; } }
        else { bf16* orow = (bf16*)pbuf + ((size_t)part * M + row) * 512 + hh * 128 + 4 * g;
#pragma unroll
            for (int db = 0; db < 8; ++db) { v2u o; o.x = pg8::cvt_pk_bf16(O[ga][db][0] * inv, O[ga][db][1] * inv); o.y = pg8::cvt_pk_bf16(O[ga][db][2] * inv, O[ga][db][3] * inv); *(GAS v2u*)(orow + 16 * db) = o; }
            if (g == 0) plse[((size_t)part * M + row) * 4 + hh] = ls > 0.f ? m[ga] + __builtin_amdgcn_logf(ls) : NEG; }
    }
}

__device__ __forceinline__ void dil_unit(LAS unsigned char* lds, const bf16* z, float* obuf, float* lsebuf, int bh, int p, int r, int qt, int tid) {
    const int lane = tid & 63, w = __builtin_amdgcn_readfirstlane(tid >> 6), fr = lane & 15, g = lane >> 4;
    const int b = bh >> 2, hh = bh & 3, dil = p == 0 ? 1 : (p == 1 ? 4 : 16), L = T / dil, u0 = 256 * qt;
    const bf16* zb = z + ((size_t)b * T + r) * NIN; const size_t stride = (size_t)dil * NIN;
    const float slope2 = exp2f(-(float)(2 * hh + 2)) * LOG2E * (float)dil, c1 = 0.08838834764831845f * LOG2E;
    int uq[2]; bf16x8 Qf[2][4];
#pragma unroll
    for (int ga = 0; ga < 2; ++ga) { uq[ga] = u0 + 32 * w + 16 * ga + fr; const int uc = uq[ga] < L ? uq[ga] : L - 1; load_q(Qf[ga], zb + (size_t)uc * stride + ZQC + hh * 128, g); }
    const bf16* kbase = zb + ZKC + hh * 128; const bf16* vbase = zb + ZVC + hh * 128;
    f32x4 O[2][8];
#pragma unroll
    for (int ga = 0; ga < 2; ++ga)
#pragma unroll
        for (int db = 0; db < 8; ++db) O[ga][db] = (f32x4){0.f, 0.f, 0.f, 0.f};
    float m[2] = {NEG, NEG}, lsum[2] = {0.f, 0.f};
    const int j0 = u0 >= 128 ? 0 : 2, qend = u0 + 256 < L ? u0 + 256 : L, j1 = (qend - (u0 - 128) + 63) >> 6;
    TileRegs R; tile_load(R, kbase, vbase, stride, u0 - 128 + 64 * j0, L, tid);
    __syncthreads();
    tile_store(lds, 0, R, tid);
    __syncthreads();
    const int uw = u0 + 32 * w;
    for (int j = j0; j < j1; ++j) {
        const int key0 = u0 - 128 + 64 * j, bi = (j - j0) & 1;
        if (j + 1 < j1) tile_load(R, kbase, vbase, stride, key0 + 64, L, tid);
        const bool skip = (key0 > uw + 31) || (key0 + 63 < uw - 128) || uw >= L;
        if (!skip) {
            int d0[2]; float base[2];
#pragma unroll
            for (int ga = 0; ga < 2; ++ga) { d0[ga] = uq[ga] - key0 - 4 * g; base[ga] = -slope2 * (float)d0[ga]; }
            tile_step(lds + (bi ? OFF_K1 : OFF_K0), lds + (bi ? OFF_V1 : OFF_V0), Qf, fr, g, m, lsum, O,
                      [&](int ga, int kb, int rr, float sv) -> float { const int d = d0[ga] - (16 * kb + rr); const float v = fmaf((float)(16 * kb + rr), slope2, fmaf(sv, c1, base[ga])); return (d >= 0 && d <= 128) ? v : MASKED; });
        }
        if (j + 1 < j1) tile_store(lds, bi ^ 1, R, tid);
        __syncthreads();
    }
#pragma unroll
    for (int ga = 0; ga < 2; ++ga) {
        const float ls = quad_sum(lsum[ga]);
        if (uq[ga] < L) {
            const float inv = 1.0f / ls; const size_t row = (size_t)b * T + (size_t)uq[ga] * dil + r;
            bf16* orow = (bf16*)obuf + ((size_t)p * M + row) * 512 + hh * 128 + 4 * g;
#pragma unroll
            for (int db = 0; db < 8; ++db) { v2u o; o.x = pg8::cvt_pk_bf16(O[ga][db][0] * inv, O[ga][db][1] * inv); o.y = pg8::cvt_pk_bf16(O[ga][db][2] * inv, O[ga][db][3] * inv); *(GAS v2u*)(orow + 16 * db) = o; }
            if (g == 0) lsebuf[((size_t)p * M + row) * 4 + hh] = m[ga] + __builtin_amdgcn_logf(ls);
        }
    }
}
}

__device__ __forceinline__ void dil_combine(Frame& F) {
    OPAQUE_TID(F);
    const float* obuf = (const float*)(F.ws + WS_DOUT); const float* lse = (const float*)(F.ws + WS_DLSE); bf16* mixed = (bf16*)(F.ws + WS_MIXED);
    const float* pbuf = (const float*)(F.ws + WS_MOUT); const float* plse = (const float*)(F.ws + WS_MLSE);
    const size_t gt = (size_t)F.vcu * 512 + F.tid, NT = (size_t)F.G * 512;
    for (size_t i0 = gt; i0 < (size_t)M * 128; i0 += 4 * NT) {
        const bf16* o0_[4]; const bf16* o1_[4]; const bf16* o2_[4]; const float* l0_[4]; const float* l1_[4]; const float* l2_[4]; bool on_[4], three_[4]; size_t dst_[4];
#pragma unroll
        for (int k = 0; k < 4; ++k) {
            const size_t i = i0 + (size_t)k * NT; bool on = i < (size_t)M * 128;
            const bool mo = on && i >= (size_t)M * 64; const size_t ii = on ? (mo ? i - (size_t)M * 64 : i) : 0;
            size_t row = ii >> 6; int c8 = (int)(ii & 63); int np = 3;
            if (mo) { const int cur = (int)((row & (T - 1)) >> 8); if (cur <= 2) on = false; np = cur <= 5 ? 2 : 3; }
            const bool mox = mo && on; if (!on) { row = 0; c8 = 0; np = 3; }
            const int hh = c8 >> 4; const bf16* ob = (const bf16*)(mox ? pbuf : obuf); const float* lb = mox ? plse : lse;
            on_[k] = on; three_[k] = np == 3; dst_[k] = row * D + (mox ? 0 : 1536) + c8 * 8;
            l0_[k] = lb + (0 * (size_t)M + row) * 4 + hh; l1_[k] = lb + (1 * (size_t)M + row) * 4 + hh; l2_[k] = lb + ((np == 3 ? 2 : 1) * (size_t)M + row) * 4 + hh;
            o0_[k] = ob + (0 * (size_t)M + row) * 512 + c8 * 8; o1_[k] = ob + (1 * (size_t)M + row) * 512 + c8 * 8; o2_[k] = ob + ((np == 3 ? 2 : 1) * (size_t)M + row) * 512 + c8 * 8;
        }
        float lv[4][3]; v4u ow[4][3];
#pragma unroll
        for (int k = 0; k < 4; ++k) { lv[k][0] = *(const GAS float*)l0_[k]; lv[k][1] = *(const GAS float*)l1_[k]; lv[k][2] = *(const GAS float*)l2_[k];
            ow[k][0] = *(const GAS v4u*)o0_[k]; ow[k][1] = *(const GAS v4u*)o1_[k]; ow[k][2] = *(const GAS v4u*)o2_[k]; }
#pragma unroll
        for (int k = 0; k < 4; ++k) {
            const float l0 = lv[k][0], l1 = lv[k][1], l2 = three_[k] ? lv[k][2] : att::NEG;
            const float mx = fmaxf(l0, fmaxf(l1, l2)); float w0 = __builtin_amdgcn_exp2f(l0 - mx), w1 = __builtin_amdgcn_exp2f(l1 - mx), w2 = three_[k] ? __builtin_amdgcn_exp2f(l2 - mx) : 0.f;
            const float inv = 1.0f / (w0 + w1 + w2); w0 *= inv; w1 *= inv; w2 *= inv;
            f32x4 av, bv;
            { const v4u x = ow[k][0], y = ow[k][1], z_ = ow[k][2];
              av[0] = bflo(x.x) * w0 + bflo(y.x) * w1 + bflo(z_.x) * w2; av[1] = bfhi(x.x) * w0 + bfhi(y.x) * w1 + bfhi(z_.x) * w2; av[2] = bflo(x.y) * w0 + bflo(y.y) * w1 + bflo(z_.y) * w2; av[3] = bfhi(x.y) * w0 + bfhi(y.y) * w1 + bfhi(z_.y) * w2;
              bv[0] = bflo(x.z) * w0 + bflo(y.z) * w1 + bflo(z_.z) * w2; bv[1] = bfhi(x.z) * w0 + bfhi(y.z) * w1 + bfhi(z_.z) * w2; bv[2] = bflo(x.w) * w0 + bflo(y.w) * w1 + bflo(z_.w) * w2; bv[3] = bfhi(x.w) * w0 + bfhi(y.w) * w1 + bfhi(z_.w) * w2; }
            if (on_[k]) { v4u o; o.x = pg8::cvt_pk_bf16(av[0], av[1]); o.y = pg8::cvt_pk_bf16(av[2], av[3]); o.z = pg8::cvt_pk_bf16(bv[0], bv[1]); o.w = pg8::cvt_pk_bf16(bv[2], bv[3]);
                *(GAS v4u*)(mixed + dst_[k]) = o; }
        }
    }
}
__device__ __forceinline__ void attn_phase(Frame& F, const Args& A, int layer, int nconv) {
    OPAQUE_TID(F);
    const bf16* z = (const bf16*)(F.ws + WS_Z); const float* kmean = (const float*)(F.ws + WS_KMEAN); bf16* mixed = (bf16*)(F.ws + WS_MIXED);
    float* obuf = (float*)(F.ws + WS_DOUT); float* lse = (float*)(F.ws + WS_DLSE); float* pbuf = (float*)(F.ws + WS_MOUT); float* plse = (float*)(F.ws + WS_MLSE);
    unsigned* qctr = (unsigned*)(F.ctl + CW_QUEUE + 64 * layer);
    LAS unsigned* slot = (LAS unsigned*)(F.lds + att::OFF_MISC + 64);
    const int R = 752 + nconv;
    int idx = F.vcu;
    while (idx < 752 + nconv) {
        int u = idx, cu = -1;
        if (nconv > 0) { const int j = idx; const int c0 = (int)(((long)j * nconv) / R), c1 = (int)(((long)(j + 1) * nconv) / R); if (c1 > c0) cu = c0; else u = j - c0; }
        if (cu >= 0) convert_queue_unit(F, A, layer, cu);
        else {
        const int bh = u & 15; int k = u >> 4;
        bool is_moba; int p0, p1, p2 = 0;
        if (k < 9) { is_moba = true; p0 = (int)((0x776655432ull >> (4 * k)) & 15ull); p1 = (0x150 >> k) & 1; }
        else if (k < 20) { is_moba = false; k -= 9; if (k < 7) { p0 = 0; p1 = 0; p2 = k + 1; } else { p0 = 1; p1 = k - 7; p2 = 1; } }
        else if (k < 23) { is_moba = true; k -= 20; p0 = k == 0 ? 1 : (k == 1 ? 4 : 7); p1 = k; }
        else if (k < 26) { is_moba = true; k -= 23; p0 = 3 * k; p1 = k; }
        else if (k < 31) { is_moba = false; k -= 26; if (k == 0) { p0 = 0; p1 = 0; } else { p0 = 1; p1 = k - 1; } }
        else { is_moba = false; p0 = 2; p1 = k - 31; }
        int tid_ = F.tid; asm volatile("" : "+v"(tid_));
        if (is_moba) att::moba_unit(F.lds, z, kmean, mixed, pbuf, plse, bh, p0, p1, tid_);
        else att::dil_unit(F.lds, z, obuf, lse, bh, p0, p1, p2, tid_);
        }
        __syncthreads();
        if (F.tid == 0) *slot = (unsigned)F.G + __hip_atomic_fetch_add(qctr, 1u, __ATOMIC_RELAXED, __HIP_MEMORY_SCOPE_AGENT);
        __syncthreads();
        idx = (int)*slot;
        __syncthreads();
    }
}


namespace ml {
typedef short bf16x8 __attribute__((ext_vector_type(8)));
typedef short s16x4 __attribute__((ext_vector_type(4)));
typedef float f32x2_t __attribute__((ext_vector_type(2)));
constexpr int CH = 128, NCH = T / CH;
constexpr int KP = 288, VP = 544, KRP = 272;
constexpr int OFF_KT = 0, OFF_VT = CH * KP, OFF_SM = OFF_VT + CH * VP;
__device__ __forceinline__ bf16x8 tr_frag(const LAS unsigned char* p, int pitch) {
    const s16x4 lo = __builtin_amdgcn_ds_read_tr16_b64_v4i16((LAS s16x4*)p), hi = __builtin_amdgcn_ds_read_tr16_b64_v4i16((LAS s16x4*)(p + 16 * pitch));
    return __builtin_shufflevector(lo, hi, 0, 1, 2, 3, 4, 5, 6, 7);
}
__device__ __forceinline__ float fexp(float x) { return __builtin_amdgcn_exp2f(x * LOG2E); }
__device__ __forceinline__ float logsig(float x) { return fminf(x, 0.f) - 0.6931471805599453f * __builtin_amdgcn_logf(1.0f + fexp(-fabsf(x))); }

__device__ __forceinline__ void m1_unit(LAS unsigned char* lds, const Args& A, unsigned char* ws, int layer, int unit, int tid) {
    const int lane = tid & 63, w = __builtin_amdgcn_readfirstlane(tid >> 6), fr = lane & 15, g = lane >> 4;
    const int bh = unit / NCH, c = unit - bh * NCH, b = bh >> 2, hh = bh & 3, t0 = c * CH;
    const bf16* z = (const bf16*)(ws + WS_Z); const float* gates = (const float*)(ws + WS_GATES);
    bf16* qc = (bf16*)(ws + WS_QC); bf16* kc = (bf16*)(ws + WS_KC);
    float* bq = (float*)(ws + WS_BQ); float* aq = (float*)(ws + WS_AQ); float* blast = (float*)(ws + WS_BLAST); float* amaxp = (float*)(ws + WS_AMAX);
    float* dCT = (float*)(ws + WS_DCT) + (size_t)unit * 32768; float* dn = (float*)(ws + WS_DN) + (size_t)unit * 128;
    LAS float* wl = (LAS float*)(lds + OFF_SM);
    __syncthreads();
    v4u vr[8];
#pragma unroll
    for (int i = 0; i < 8; ++i) { const int cc = tid + 512 * i, row = cc >> 5, ch = cc & 31; vr[i] = *(const GAS v4u*)(z + (size_t)(b * T + t0 + row) * NIN + ZVM + hh * 256 + ch * 8); }
    const int chunk = tid & 31, isk = chunk >> 4, ch = (chunk & 15) * 8, zc = ZQKM + isk * 512 + hh * 128 + ch, cwc = isk * 512 + hh * 128 + ch, s0 = 8 * (tid >> 5);
    v4u zw[11];
#pragma unroll
    for (int j = 0; j < 11; ++j) { const int tt = t0 + s0 - 3 + j; zw[j] = (v4u){0u, 0u, 0u, 0u}; if (tt >= 0) zw[j] = *(const GAS v4u*)(z + (size_t)(b * T + tt) * NIN + zc); }
    float wt[4][8], bias[8];
    {
        const float* cw = A.in[7] + (size_t)layer * 4096 + cwc; const float* cb = A.in[8] + (size_t)layer * 1024 + cwc;
#pragma unroll
        for (int j = 0; j < 4; ++j) { const f32x4 a0 = *(const GAS f32x4*)(cw + j * 1024), a1 = *(const GAS f32x4*)(cw + j * 1024 + 4);
#pragma unroll
            for (int e = 0; e < 4; ++e) { wt[j][e] = a0[e]; wt[j][4 + e] = a1[e]; } }
        const f32x4 a0 = *(const GAS f32x4*)cb, a1 = *(const GAS f32x4*)(cb + 4);
#pragma unroll
        for (int e = 0; e < 4; ++e) { bias[e] = a0[e]; bias[4 + e] = a1[e]; }
    }
    if (w == 0) {
        const size_t row = (size_t)b * T + t0 + 2 * lane;
        const f32x4 g0a = *(const GAS f32x4*)(gates + row * 8), g0b = *(const GAS f32x4*)(gates + row * 8 + 4), g1a = *(const GAS f32x4*)(gates + row * 8 + 8), g1b = *(const GAS f32x4*)(gates + row * 8 + 12);
        const float f0 = hh == 0 ? g0b[0] : (hh == 1 ? g0b[1] : (hh == 2 ? g0b[2] : g0b[3])), f1 = hh == 0 ? g1b[0] : (hh == 1 ? g1b[1] : (hh == 2 ? g1b[2] : g1b[3]));
        const float li0 = hh == 0 ? g0a[0] : (hh == 1 ? g0a[1] : (hh == 2 ? g0a[2] : g0a[3])), li1 = hh == 0 ? g1a[0] : (hh == 1 ? g1a[1] : (hh == 2 ? g1a[2] : g1a[3]));
        const float lf0 = logsig(f0), lf1 = logsig(f1);
        float v = lf0 + lf1;
#pragma unroll
        for (int o = 1; o < 64; o <<= 1) { const float n = wv::lane_up(v, o, lane); if (lane >= o) v += n; }
        const float b1 = v, b0 = v - lf1, a0 = li0 - b0, a1 = li1 - b1, am = wave_max(fmaxf(a0, a1));
        *(GAS f32x2_t*)(bq + (size_t)bh * T + t0 + 2 * lane) = (f32x2_t){b0, b1}; *(GAS f32x2_t*)(aq + (size_t)bh * T + t0 + 2 * lane) = (f32x2_t){a0, a1};
        wl[2 * lane] = fexp(a0 - am); wl[2 * lane + 1] = fexp(a1 - am);
        if (lane == 63) blast[unit] = b1; if (lane == 0) amaxp[unit] = am;
    }
#pragma unroll
    for (int i = 0; i < 8; ++i) { const int cc = tid + 512 * i, row = cc >> 5, ch2 = cc & 31; *(LAS v4u*)(lds + OFF_VT + row * VP + ch2 * 16) = vr[i]; }
    __syncthreads();
#pragma unroll
    for (int i = 0; i < 8; ++i) {
        const int s = s0 + i, t = t0 + s; float y[8];
#pragma unroll
        for (int e = 0; e < 8; ++e) y[e] = bias[e];
#pragma unroll
        for (int j = 0; j < 4; ++j) { const v4u q4 = zw[i + j];
            y[0] += wt[j][0] * bflo(q4.x); y[1] += wt[j][1] * bfhi(q4.x); y[2] += wt[j][2] * bflo(q4.y); y[3] += wt[j][3] * bfhi(q4.y);
            y[4] += wt[j][4] * bflo(q4.z); y[5] += wt[j][5] * bfhi(q4.z); y[6] += wt[j][6] * bflo(q4.w); y[7] += wt[j][7] * bfhi(q4.w); }
#pragma unroll
        for (int e = 0; e < 8; ++e) y[e] = y[e] * sigmoid_fast(y[e]);
        if (isk) {
#pragma unroll
            for (int e = 0; e < 8; ++e) y[e] *= 0.08838834764831845f;
            v4u o; o.x = pg8::cvt_pk_bf16(y[0], y[1]); o.y = pg8::cvt_pk_bf16(y[2], y[3]); o.z = pg8::cvt_pk_bf16(y[4], y[5]); o.w = pg8::cvt_pk_bf16(y[6], y[7]);
            *(GAS v4u*)(kc + ((size_t)bh * T + t) * 128 + ch) = o;
            const float ws_ = wl[s];
            v4u o2; o2.x = pg8::cvt_pk_bf16(y[0] * ws_, y[1] * ws_); o2.y = pg8::cvt_pk_bf16(y[2] * ws_, y[3] * ws_); o2.z = pg8::cvt_pk_bf16(y[4] * ws_, y[5] * ws_); o2.w = pg8::cvt_pk_bf16(y[6] * ws_, y[7] * ws_);
            *(LAS v4u*)(lds + OFF_KT + s * KP + ch * 2) = o2;
        } else {
            v4u o; o.x = pg8::cvt_pk_bf16(y[0], y[1]); o.y = pg8::cvt_pk_bf16(y[2], y[3]); o.z = pg8::cvt_pk_bf16(y[4], y[5]); o.w = pg8::cvt_pk_bf16(y[6], y[7]);
            *(GAS v4u*)(qc + ((size_t)bh * T + t) * 128 + ch) = o;
        }
    }
    __syncthreads();
    {
        f32x4 acc[2][8], accn = (f32x4){0.f, 0.f, 0.f, 0.f};
#pragma unroll
        for (int e = 0; e < 2; ++e)
#pragma unroll
            for (int db = 0; db < 8; ++db) acc[e][db] = (f32x4){0.f, 0.f, 0.f, 0.f};
        const int q = fr >> 2, pp = fr & 3;
        unsigned one2 = 0x3f803f80u; asm volatile("" : "+v"(one2));
        const bf16x8 ones = __builtin_bit_cast(bf16x8, (v4u){one2, one2, one2, one2});
#pragma unroll
        for (int t = 0; t < CH / 32; ++t) {
            const LAS unsigned char* kb_ = lds + OFF_KT + (32 * t + 4 * g + q) * KP + 8 * pp; const LAS unsigned char* vb_ = lds + OFF_VT + (32 * t + 4 * g + q) * VP + 8 * pp;
            bf16x8 bf[2];
#pragma unroll
            for (int e = 0; e < 2; ++e) bf[e] = tr_frag(vb_ + (2 * w + e) * 32, VP);
#pragma unroll
            for (int db = 0; db < 8; ++db) { const bf16x8 af = tr_frag(kb_ + db * 32, KP);
#pragma unroll
                for (int e = 0; e < 2; ++e) acc[e][db] = __builtin_amdgcn_mfma_f32_16x16x32_bf16(af, bf[e], acc[e][db], 0, 0, 0);
                if (db == w) accn = __builtin_amdgcn_mfma_f32_16x16x32_bf16(af, ones, accn, 0, 0, 0); }
        }
#pragma unroll
        for (int e = 0; e < 2; ++e)
#pragma unroll
            for (int db = 0; db < 8; ++db) *(GAS f32x4*)(dCT + (size_t)(16 * (2 * w + e) + fr) * 128 + 16 * db + 4 * g) = acc[e][db];
        if (fr == 0) *(GAS f32x4*)(dn + 16 * w + 4 * g) = accn;
    }
}

__device__ __forceinline__ void m2_phase(LAS unsigned char* lds, unsigned char* ws, int vcu, int G, int tid) {
    const float* blast = (const float*)(ws + WS_BLAST); const float* amaxp = (const float*)(ws + WS_AMAX); float* mst = (float*)(ws + WS_MST);
    const float* dCT = (const float*)(ws + WS_DCT); bf16* CstT = (bf16*)(ws + WS_CST); const float* dn = (const float*)(ws + WS_DN); float* nst = (float*)(ws + WS_NST);
    LAS float* wo = (LAS float*)lds; LAS float* fk = wo + 32;
    const int lane = tid & 63;
    for (int blk = vcu; blk < NBH * 16; blk += G) {
        const int bh = blk >> 4, sub = blk & 15;
        __syncthreads();
        const size_t e = (size_t)(sub * 512 + tid) * 4;
        f32x4 v[NCH];
#pragma unroll
        for (int i = 0; i < NCH; ++i) v[i] = *(const GAS f32x4*)(dCT + (size_t)(bh * NCH + i) * 32768 + e);
        if (tid < 64) {
            const int cl = lane & (NCH - 1); const float bl = blast[bh * NCH + cl], ml = bl + amaxp[bh * NCH + cl];
            float m = 0.f, mywo = 0.f, myfk = 0.f, mym = 0.f;
#pragma unroll
            for (int c = 0; c < NCH; ++c) { const float blc = wv::lane_get(bl, c), mlc = wv::lane_get(ml, c), mn = fmaxf(blc + m, mlc), w_ = fexp(blc + m - mn), f_ = fexp(mlc - mn);
                if (lane == c) { mywo = w_; myfk = f_; mym = m; } m = mn; }
            if (lane < NCH) { wo[lane] = mywo; fk[lane] = myfk; if (sub == 0) mst[bh * NCH + lane] = mym; }
        }
        __syncthreads();
        {
            float z0 = 0.f; asm volatile("" : "+v"(z0)); f32x4 C = (f32x4){z0, z0, z0, z0};
#pragma unroll
            for (int c = 0; c < NCH; ++c) { v2u o; o.x = pg8::cvt_pk_bf16(C[0], C[1]); o.y = pg8::cvt_pk_bf16(C[2], C[3]);
                *(GAS v2u*)(CstT + (size_t)(bh * NCH + c) * 32768 + e) = o; C = C * wo[c] + v[c] * fk[c]; }
        }
        if (sub == 0 && tid < 32) {
            float z0 = 0.f; asm volatile("" : "+v"(z0)); f32x4 C = (f32x4){z0, z0, z0, z0};
            f32x4 dv[NCH];
#pragma unroll
            for (int c = 0; c < NCH; ++c) dv[c] = *(const GAS f32x4*)(dn + (size_t)(bh * NCH + c) * 128 + tid * 4);
#pragma unroll
            for (int c = 0; c < NCH; ++c) { *(GAS f32x4*)(nst + (size_t)(bh * NCH + c) * 128 + tid * 4) = C; C = C * wo[c] + dv[c] * fk[c]; }
        }
    }
    __syncthreads();
}

__device__ __forceinline__ void m3_unit(LAS unsigned char* lds, const Args& A, unsigned char* ws, int layer, int unit, int tid) {
    const int lane = tid & 63, w = __builtin_amdgcn_readfirstlane(tid >> 6), fr = lane & 15, g = lane >> 4;
    const int bh = unit / NCH, c = unit - bh * NCH, b = bh >> 2, hh = bh & 3, t0 = c * CH, tp = w & 3, half = w >> 2;
    const bf16* z = (const bf16*)(ws + WS_Z); const bf16* qc = (const bf16*)(ws + WS_QC); const bf16* kc = (const bf16*)(ws + WS_KC);
    const float* bq = (const float*)(ws + WS_BQ); const float* aq = (const float*)(ws + WS_AQ); const float* mst = (const float*)(ws + WS_MST);
    const bf16* CstT = (const bf16*)(ws + WS_CST) + (size_t)unit * 32768; const float* nst = (const float*)(ws + WS_NST) + (size_t)unit * 128; bf16* mixed = (bf16*)(ws + WS_MIXED);
    LAS float* U = (LAS float*)(lds + OFF_SM); LAS float* A2 = U + CH; LAS float* WI = U + 2 * CH; LAS float* EM = U + 3 * CH; LAS float* RS = U + 4 * CH;
    __syncthreads();
    v4u kr[4], vr[8];
#pragma unroll
    for (int i = 0; i < 4; ++i) { const int cc = tid + 512 * i, row = cc >> 4, ch = cc & 15; kr[i] = *(const GAS v4u*)(kc + ((size_t)bh * T + t0 + row) * 128 + ch * 8); }
#pragma unroll
    for (int i = 0; i < 8; ++i) { const int cc = tid + 512 * i, row = cc >> 5, ch = cc & 31; vr[i] = *(const GAS v4u*)(z + (size_t)(b * T + t0 + row) * NIN + ZVM + hh * 256 + ch * 8); }
    int tq[2]; bf16x8 Qf[2][4];
#pragma unroll
    for (int ga = 0; ga < 2; ++ga) { tq[ga] = 16 * (2 * tp + ga) + fr;
#pragma unroll
        for (int ks = 0; ks < 4; ++ks) Qf[ga][ks] = __builtin_bit_cast(bf16x8, *(const GAS v4u*)(qc + ((size_t)bh * T + t0 + tq[ga]) * 128 + 32 * ks + 8 * g)); }
    f32x4 nv[4][2];
#pragma unroll
    for (int ks = 0; ks < 4; ++ks) { nv[ks][0] = *(const GAS f32x4*)(nst + 32 * ks + 8 * g); nv[ks][1] = *(const GAS f32x4*)(nst + 32 * ks + 8 * g + 4); }
    if (w == 0) {
        const f32x2_t bt = *(const GAS f32x2_t*)(bq + (size_t)bh * T + t0 + 2 * lane), a = *(const GAS f32x2_t*)(aq + (size_t)bh * T + t0 + 2 * lane); const float ms = mst[unit];
        float pmx = fmaxf(a[0], a[1]);
#pragma unroll
        for (int o = 1; o < 64; o <<= 1) { const float n = wv::lane_up(pmx, o, lane); if (lane >= o) pmx = fmaxf(pmx, n); }
        float ex = wv::lane_up(pmx, 1, lane); if (lane == 0) ex = -3.0e38f;
        const float pm0 = fmaxf(ex, a[0]), pm1 = fmaxf(pm0, a[1]), mt0 = bt[0] + fmaxf(ms, pm0), mt1 = bt[1] + fmaxf(ms, pm1);
        U[2 * lane] = (bt[0] - mt0) * LOG2E; U[2 * lane + 1] = (bt[1] - mt1) * LOG2E; A2[2 * lane] = a[0] * LOG2E; A2[2 * lane + 1] = a[1] * LOG2E;
        WI[2 * lane] = fexp(bt[0] + ms - mt0); WI[2 * lane + 1] = fexp(bt[1] + ms - mt1); EM[2 * lane] = fexp(-mt0); EM[2 * lane + 1] = fexp(-mt1);
    }
#pragma unroll
    for (int i = 0; i < 4; ++i) { const int cc = tid + 512 * i, row = cc >> 4, ch = cc & 15; *(LAS v4u*)(lds + OFF_KT + row * KRP + ch * 16) = kr[i]; }
#pragma unroll
    for (int i = 0; i < 8; ++i) { const int cc = tid + 512 * i, row = cc >> 5, ch = cc & 31; *(LAS v4u*)(lds + OFF_VT + row * VP + ch * 16) = vr[i]; }
    float qn[2] = {0.f, 0.f};
#pragma unroll
    for (int ks = 0; ks < 4; ++ks) { const f32x4 n0 = nv[ks][0], n1 = nv[ks][1];
#pragma unroll
        for (int ga = 0; ga < 2; ++ga) { const v4u qw = __builtin_bit_cast(v4u, Qf[ga][ks]);
            qn[ga] += (bflo(qw.x) * n0[0] + bfhi(qw.x) * n0[1]) + (bflo(qw.y) * n0[2] + bfhi(qw.y) * n0[3]) + (bflo(qw.z) * n1[0] + bfhi(qw.z) * n1[1]) + (bflo(qw.w) * n1[2] + bfhi(qw.w) * n1[3]); } }
    f32x4 acc[2][8];
#pragma unroll
    for (int eh = 0; eh < 2; ++eh) {
        v4u cfw[4][4];
#pragma unroll
        for (int e4 = 0; e4 < 4; ++e4)
#pragma unroll
            for (int ks = 0; ks < 4; ++ks) cfw[e4][ks] = *(const GAS v4u*)(CstT + (size_t)(128 * half + 16 * (4 * eh + e4) + fr) * 128 + 32 * ks + 8 * g);
        asm volatile("" ::: "memory");
#pragma unroll
        for (int e4 = 0; e4 < 4; ++e4) { const int eb = 4 * eh + e4; acc[0][eb] = (f32x4){0.f, 0.f, 0.f, 0.f}; acc[1][eb] = (f32x4){0.f, 0.f, 0.f, 0.f};
#pragma unroll
            for (int ks = 0; ks < 4; ++ks) { const bf16x8 cf = __builtin_bit_cast(bf16x8, cfw[e4][ks]);
                acc[0][eb] = __builtin_amdgcn_mfma_f32_16x16x32_bf16(cf, Qf[0][ks], acc[0][eb], 0, 0, 0); acc[1][eb] = __builtin_amdgcn_mfma_f32_16x16x32_bf16(cf, Qf[1][ks], acc[1][eb], 0, 0, 0); } }
    }
    __syncthreads();
    float wi[2], ut[2], dsum[2] = {0.f, 0.f};
#pragma unroll
    for (int ga = 0; ga < 2; ++ga) { qn[ga] = att::quad_sum(qn[ga]); wi[ga] = WI[tq[ga]]; ut[ga] = U[tq[ga]];
#pragma unroll
        for (int eb = 0; eb < 8; ++eb) acc[ga][eb] = acc[ga][eb] * wi[ga]; }
    const int q = fr >> 2, pp = fr & 3;
#pragma unroll
    for (int kt = 0; kt < CH / 32; ++kt) if (kt <= tp) {
        f32x4 P[2][2];
#pragma unroll
        for (int j = 0; j < 2; ++j) { const int sb = 2 * kt + j;
            P[0][j] = (f32x4){0.f, 0.f, 0.f, 0.f}; P[1][j] = (f32x4){0.f, 0.f, 0.f, 0.f};
            if (sb <= 2 * tp + 1) {
                bf16x8 kf[4];
#pragma unroll
                for (int ks = 0; ks < 4; ++ks) kf[ks] = *(const LAS bf16x8*)(lds + OFF_KT + (16 * sb + fr) * KRP + (4 * ks + g) * 16);
                const f32x4 a2 = *(const LAS f32x4*)(A2 + 16 * sb + 4 * g);
#pragma unroll
                for (int ga = 0; ga < 2; ++ga) if (sb <= 2 * tp + ga) {
                    f32x4 s = (f32x4){0.f, 0.f, 0.f, 0.f};
#pragma unroll
                    for (int ks = 0; ks < 4; ++ks) s = __builtin_amdgcn_mfma_f32_16x16x32_bf16(kf[ks], Qf[ga][ks], s, 0, 0, 0);
#pragma unroll
                    for (int r = 0; r < 4; ++r) { const int sidx = 16 * sb + 4 * g + r; const float pv = sidx <= tq[ga] ? s[r] * __builtin_amdgcn_exp2f(ut[ga] + a2[r]) : 0.f; P[ga][j][r] = pv; dsum[ga] += pv; }
                }
            }
        }
        bf16x8 pf[2];
#pragma unroll
        for (int ga = 0; ga < 2; ++ga) { v4u wv; wv.x = pg8::cvt_pk_bf16(P[ga][0][0], P[ga][0][1]); wv.y = pg8::cvt_pk_bf16(P[ga][0][2], P[ga][0][3]); wv.z = pg8::cvt_pk_bf16(P[ga][1][0], P[ga][1][1]); wv.w = pg8::cvt_pk_bf16(P[ga][1][2], P[ga][1][3]); pf[ga] = __builtin_bit_cast(bf16x8, wv); }
        const LAS unsigned char* vb_ = lds + OFF_VT + (32 * kt + 4 * g + q) * VP + 8 * pp + half * 256;
#pragma unroll
        for (int eb = 0; eb < 8; ++eb) { const bf16x8 vf = tr_frag(vb_ + eb * 32, VP);
            acc[0][eb] = __builtin_amdgcn_mfma_f32_16x16x32_bf16(vf, pf[0], acc[0][eb], 0, 0, 0); acc[1][eb] = __builtin_amdgcn_mfma_f32_16x16x32_bf16(vf, pf[1], acc[1][eb], 0, 0, 0); }
    }
#pragma unroll
    for (int ga = 0; ga < 2; ++ga) {
        const float den = wi[ga] * qn[ga] + att::quad_sum(dsum[ga]), dinv = 1.0f / fmaxf(fabsf(den), EM[tq[ga]]);
        float ss = 0.f;
#pragma unroll
        for (int eb = 0; eb < 8; ++eb) { acc[ga][eb] = acc[ga][eb] * dinv; ss += (acc[ga][eb][0] * acc[ga][eb][0] + acc[ga][eb][1] * acc[ga][eb][1]) + (acc[ga][eb][2] * acc[ga][eb][2] + acc[ga][eb][3] * acc[ga][eb][3]); }
        ss = att::quad_sum(ss);
        if (g == 0) RS[tq[ga] * 2 + half] = ss;
    }
    __syncthreads();
#pragma unroll
    for (int ga = 0; ga < 2; ++ga) {
        const float rn = __builtin_amdgcn_rsqf((RS[tq[ga] * 2] + RS[tq[ga] * 2 + 1]) * (1.0f / 256.0f) + RMS_EPS);
        const size_t row = (size_t)b * T + t0 + tq[ga]; const float* gh = A.in[11] + (size_t)layer * 1024 + hh * 256 + 128 * half + 4 * g;
        const bf16* orow = z + row * NIN + ZOM + hh * 256 + 128 * half + 4 * g; bf16* mrow = mixed + row * D + 512 + hh * 256 + 128 * half + 4 * g;
        f32x4 gvv[8]; v2u oww[8];
#pragma unroll
        for (int eb = 0; eb < 8; ++eb) { gvv[eb] = *(const GAS f32x4*)(gh + 16 * eb); oww[eb] = *(const GAS v2u*)(orow + 16 * eb); }
        asm volatile("" ::: "memory");
#pragma unroll
        for (int eb = 0; eb < 8; ++eb) { const f32x4 gv = gvv[eb]; const v2u ow = oww[eb];
            const float r0 = acc[ga][eb][0] * rn * gv[0] * sigmoid_fast(bflo(ow.x)), r1 = acc[ga][eb][1] * rn * gv[1] * sigmoid_fast(bfhi(ow.x)), r2 = acc[ga][eb][2] * rn * gv[2] * sigmoid_fast(bflo(ow.y)), r3 = acc[ga][eb][3] * rn * gv[3] * sigmoid_fast(bfhi(ow.y));
            v2u o; o.x = pg8::cvt_pk_bf16(r0, r1); o.y = pg8::cvt_pk_bf16(r2, r3); *(GAS v2u*)(mrow + 16 * eb) = o; }
    }
}
}

struct KmeanRegs { v4u kv[8]; };
__device__ __forceinline__ void kmean_load(Frame& F, int it, KmeanRegs& R) {
    const bf16* z = (const bf16*)(F.ws + WS_Z);
    const int bh = it >> 3, blk = it & 7, b = bh >> 2, hh = bh & 3, r = F.lane >> 4, c = F.lane & 15;
    const bf16* base = z + (size_t)(b * T + blk * 256 + 32 * F.wave + r) * NIN + ZKA + hh * 128 + 8 * c;
#pragma unroll
    for (int i = 0; i < 8; ++i) R.kv[i] = *(const GAS v4u*)(base + (size_t)(4 * i) * NIN);
}
__device__ __forceinline__ void kmean_finish(Frame& F, int it, const KmeanRegs& R) {
    float* kmean = (float*)(F.ws + WS_KMEAN); LAS float* part = (LAS float*)F.lds;
    const int r = F.lane >> 4, c = F.lane & 15;
    float a[8];
#pragma unroll
    for (int e = 0; e < 8; ++e) a[e] = 0.f;
#pragma unroll
    for (int i = 0; i < 8; ++i) { a[0] += bflo(R.kv[i].x); a[1] += bfhi(R.kv[i].x); a[2] += bflo(R.kv[i].y); a[3] += bfhi(R.kv[i].y); a[4] += bflo(R.kv[i].z); a[5] += bfhi(R.kv[i].z); a[6] += bflo(R.kv[i].w); a[7] += bfhi(R.kv[i].w); }
#pragma unroll
    for (int e = 0; e < 8; ++e) a[e] = wv::quad_sum(a[e]);
    __syncthreads();
    if (r == 0) {
#pragma unroll
        for (int e = 0; e < 8; ++e) part[F.wave * 128 + 8 * c + e] = a[e]; }
    __syncthreads();
    if (F.tid < 128) { float s_ = 0.f;
#pragma unroll
        for (int w_ = 0; w_ < 8; ++w_) s_ += part[w_ * 128 + F.tid];
        kmean[(size_t)it * 128 + F.tid] = s_ * (1.0f / 256.0f); }
}
__device__ __forceinline__ void m1_phase(Frame& F, const Args& A, int layer) {
    OPAQUE_TID(F);
    for (int it = F.vcu; it < NBH * 8 || it < NBH * ml::NCH; it += F.G) {
        KmeanRegs KR; const bool hk = it < NBH * 8;
        if (hk) kmean_load(F, it, KR);
        if (it < NBH * ml::NCH) ml::m1_unit(F.lds, A, F.ws, layer, it, F.tid);
        if (hk) kmean_finish(F, it, KR);
    }
    __syncthreads();
}
__device__ __forceinline__ void m3_phase(Frame& F, const Args& A, int layer) {
    OPAQUE_TID(F);
    for (int u = F.vcu; u < NBH * ml::NCH; u += F.G) ml::m3_unit(F.lds, A, F.ws, layer, u, F.tid);
    __syncthreads();
}

constexpr int N_PHASES = 2 + 10 * DEPTH;
__global__ void __launch_bounds__(NWAVES * 64, 2) mk_fwd(Args args) {
    extern __shared__ __attribute__((aligned(16))) unsigned char lds[];
    Frame F;
    F.lds = (LAS unsigned char*)lds;
    F.MISC = (volatile LAS unsigned*)(F.lds + MISC_OFF);
    F.tid = threadIdx.x; F.lane = F.tid & 63; F.wave = __builtin_amdgcn_readfirstlane(F.tid >> 6); F.wave0 = F.wave;
    F.G = gridDim.x; { const int bx = blockIdx.x; F.vcu = (F.G % 8 == 0) ? (bx % 8) * (F.G / 8) + bx / 8 : bx; }
    F.ws = args.ws; F.out = args.out; F.ctl = (gu32*)(args.ws + WS_CTL);
    for (int u = F.tid; u < (LDS_BYTES - LDSCTL_OFF) / 4; u += NWAVES * 64) ((LAS unsigned*)(F.lds + LDSCTL_OFF))[u] = 0u;
    __syncthreads();
    XcdBarrier bar = xcd_barrier_post((unsigned*)(F.ctl + CW_BAR), F.MISC + 8);
    const int lo = args.ph_lo, hi = args.ph_hi;
#define IN(k) (lo <= (k) && (k) < hi)
#define SEAM(k) do { if (IN((k) + 1)) xcd_barrier(bar); } while (0)
#define PH_BEGIN int L = layer; asm volatile("" : "+s"(L)); int BX = blockIdx.x; asm volatile("" : "+s"(BX)); int GG = gridDim.x; asm volatile("" : "+s"(GG)); unsigned char* ws = args.ws; asm volatile("" : "+s"(ws)); \
    bf16* hb_cur = (bf16*)(ws + ((L & 1) ? WS_HB1 : WS_HB0)); bf16* hb_nxt = (bf16*)(ws + ((L & 1) ? WS_HB0 : WS_HB1)); \
    float* ssq0 = (float*)(ws + WS_SSQ0); float* ssq1 = (float*)(ws + WS_SSQ1); \
    bf16* act = (bf16*)(ws + WS_ACT); bf16* z = (bf16*)(ws + WS_Z); bf16* mixed = (bf16*)(ws + WS_MIXED); bf16* pp = (bf16*)(ws + WS_PP); \
    (void)hb_cur; (void)hb_nxt; (void)ssq0; (void)ssq1; (void)act; (void)z; (void)mixed; (void)pp;

    if (IN(0)) { p0_prologue(F, args); SEAM(0); }

    for (int layer = 0; layer < DEPTH; ++layer) {
        const int pb = 1 + 10 * layer;
        if (IN(pb + 0)) { PH_BEGIN
            pg8::Gemm g{hb_cur, WPTR(LW_UP1), M, NUP, D}; pg8::StaticOrder S; S.init(M, NUP, GG, BX);
            pg8::EpiSwiGLU E{act, ssq0, DFF};
            pg8::gemm_phase<pg8::EpiSwiGLU, pg8::StaticOrder, true, true>(F.lds + RING_OFF, g, S, E, F.wave0);
            if (GG == 256 && BX >= 128) {
                pg8::Gemm g2{(const bf16*)(ws + WS_PB) + (size_t)L * M * DPLE, WPTR(LW_P), M, D, DPLE}; pg8::StaticOrder S2; S2.init(M, D, 128, BX - 128);
                pg8::EpiScaleBf16 E2{pp, nullptr, D};
                pg8::gemm_phase<pg8::EpiScaleBf16, pg8::StaticOrder, true, true>(F.lds + RING_OFF, g2, S2, E2, F.wave0);
                convert_tail(F, args, L, 1, BX);
            }
            if (!IN(pb + 1)) {}
        }
        if (IN(pb + 1)) { PH_BEGIN
            pg8::Gemm g{act, WPTR(LW_DN1), M, D, DFF}; pg8::StaticOrder S; S.init(M, D, GG, BX);
            pg8::EpiResid<0, 1> E{hb_cur, hb_cur, ssq1, nullptr, nullptr};
            pg8::gemm_phase<pg8::EpiResid<0, 1>, pg8::StaticOrder, true, true, BarHook>(F.lds + RING_OFF, g, S, E, F.wave0, BarHook{bar, IN(pb + 0)});
            SEAM(pb + 1);
        }
        if (IN(pb + 2)) { PH_BEGIN
            pg8::Gemm g{hb_cur, WPTR(LW_IN), M, NIN, D}; pg8::StaticOrder S; S.init(M, NIN, GG, BX);
            pg8::EpiScaleBf16 E{z, ssq1, NIN};
            pg8::gemm_phase<pg8::EpiScaleBf16, pg8::StaticOrder, true, true>(F.lds + RING_OFF, g, S, E, F.wave0);
            gates_phase(F, args, L, ssq1, hb_cur);
            SEAM(pb + 2);
        }
        if (IN(pb + 3)) { PH_BEGIN
            pg8::Gemm g{(const bf16*)(F.ws + WS_PB) + (size_t)L * M * DPLE, WPTR(LW_P), M, D, DPLE}; pg8::StaticOrder S; S.init(M, D, GG, BX);
            pg8::EpiScaleBf16 E{pp, nullptr, D};
            if (GG != 256) pg8::gemm_phase<pg8::EpiScaleBf16, pg8::StaticOrder, true, true>(F.lds + RING_OFF, g, S, E, F.wave0);
            m1_phase(F, args, L);
            SEAM(pb + 3);
        }
        if (IN(pb + 4)) { PH_BEGIN OPAQUE_TID(F); ml::m2_phase(F.lds, ws, F.vcu, GG, F.tid); attn_phase(F, args, L, GG == 256 ? CQ_U1 + (L + 1 < DEPTH ? CQ_U2 : 0) : 0); SEAM(pb + 4); }
        if (IN(pb + 5)) { PH_BEGIN m3_phase(F, args, L); dil_combine(F); }
        if (IN(pb + 6)) { PH_BEGIN
            pg8::Gemm g{mixed, WPTR(LW_OUT), M, D, D}; pg8::StaticOrder S; S.init(M, D, GG, BX);
            pg8::EpiResid<0, 2> E{hb_cur, hb_cur, ssq0, nullptr, nullptr};
            pg8::gemm_phase<pg8::EpiResid<0, 2>, pg8::StaticOrder, true, true, BarHook>(F.lds + RING_OFF, g, S, E, F.wave0, BarHook{bar, IN(pb + 5)});
            SEAM(pb + 6);
        }
        if (IN(pb + 7)) { PH_BEGIN
            pg8::Gemm g{hb_cur, WPTR(LW_UP2), M, NUP, D}; pg8::StaticOrder S; S.init(M, NUP, GG, BX);
            pg8::EpiSwiGLU E{act, ssq0, DFF};
            pg8::gemm_phase<pg8::EpiSwiGLU, pg8::StaticOrder, true, true>(F.lds + RING_OFF, g, S, E, F.wave0);
            if (GG == 256 && BX >= 128) convert_tail(F, args, L + 1, 0, BX);
        }
        if (IN(pb + 8)) { PH_BEGIN
            pg8::Gemm g{act, WPTR(LW_DN2), M, D, DFF}; pg8::StaticOrder S; S.init(M, D, GG, BX);
            pg8::EpiResid<0, 1> E{hb_cur, hb_cur, ssq1, nullptr, nullptr};
            pg8::gemm_phase<pg8::EpiResid<0, 1>, pg8::StaticOrder, true, true, BarHook>(F.lds + RING_OFF, g, S, E, F.wave0, BarHook{bar, IN(pb + 7)});
            SEAM(pb + 8);
        }
        if (IN(pb + 9)) { PH_BEGIN
            pg8::Gemm g{hb_cur, WPTR(LW_G), M, D, D}; pg8::StaticOrder S; S.init(M, D, GG, BX);
            pg8::EpiResid<1, 2> E{hb_cur, hb_nxt, ssq0, ssq1, pp};
            pg8::gemm_phase<pg8::EpiResid<1, 2>, pg8::StaticOrder, true, true>(F.lds + RING_OFF, g, S, E, F.wave0);
            SEAM(pb + 9);
        }
    }
    if (IN(N_PHASES - 1)) final_norm(F, args);
#undef IN
#undef SEAM
#undef PH_BEGIN
}

#ifndef MK_MULTI
#define MK_MULTI 0
#endif
extern "C" void kernel_launch(void* const* d_in, const int* in_sizes, int n_in, void* d_out, int out_size, void* d_ws, size_t ws_size, hipStream_t stream) {
    static int grid = 0;
    if (grid == 0) {
        if (n_in != 20 || in_sizes[0] != M * D || out_size != M * D || ws_size < WS_END) { fprintf(stderr, "kernel_launch: unexpected shapes: n_in %d in0 %d out %d ws %zu (need %zu)\n", n_in, n_in > 0 ? in_sizes[0] : -1, out_size, ws_size, (size_t)WS_END); grid = -1; return; }
        int dev = 0, cus = 0, per_cu = 0;
        if (hipGetDevice(&dev) != hipSuccess || hipDeviceGetAttribute(&cus, hipDeviceAttributeMultiprocessorCount, dev) != hipSuccess) { grid = -1; return; }
        if (hipFuncSetAttribute((const void*)mk_fwd, hipFuncAttributeMaxDynamicSharedMemorySize, LDS_BYTES) != hipSuccess) { fprintf(stderr, "kernel_launch: hipFuncSetAttribute failed\n"); grid = -1; return; }
        if (hipOccupancyMaxActiveBlocksPerMultiprocessor(&per_cu, (const void*)mk_fwd, NWAVES * 64, LDS_BYTES) != hipSuccess || per_cu < 1) { fprintf(stderr, "kernel_launch: occupancy query says %d blocks per CU\n", per_cu); }
        (void)hipGetLastError();
        grid = cus;
    }
    if (grid < 0) return;
    if (hipMemsetAsync((char*)d_ws + WS_CTL, 0, CTL_ZERO_BYTES, stream) != hipSuccess) return;
    Args a{};
    for (int i = 0; i < 20; ++i) a.in[i] = (const float*)d_in[i];
    a.out = (float*)d_out; a.ws = (unsigned char*)d_ws;
#if MK_MULTI
    for (int p = 0; p < N_PHASES; ++p) { a.ph_lo = p; a.ph_hi = p + 1; hipLaunchKernelGGL(mk_fwd, dim3(grid), dim3(NWAVES * 64), LDS_BYTES, stream, a); }
#else
    a.ph_lo = 0; a.ph_hi = N_PHASES;
    hipLaunchKernelGGL(mk_fwd, dim3(grid), dim3(NWAVES * 64), LDS_BYTES, stream, a);
#endif
    const hipError_t le = hipPeekAtLastError();
    if (le != hipSuccess) fprintf(stderr, "kernel_launch: launch failed: %s\n", hipGetErrorName(le));
}
```

```cpp
#include <hip/hip_runtime.h>
#include <cstdio>
#include <cstdint>
namespace wv {
typedef unsigned u32x2_t __attribute__((ext_vector_type(2)));
#define WV_DPP(v, ctrl) __uint_as_float((unsigned)__builtin_amdgcn_update_dpp(0, (int)__float_as_uint(v), (ctrl), 0xf, 0xf, true))
__device__ __forceinline__ float swap16_a(float x, float& other) { const u32x2_t r = __builtin_amdgcn_permlane16_swap(__float_as_uint(x), __float_as_uint(x), false, false); other = __uint_as_float(r[1]); return __uint_as_float(r[0]); }
__device__ __forceinline__ float swap32_a(float x, float& other) { const u32x2_t r = __builtin_amdgcn_permlane32_swap(__float_as_uint(x), __float_as_uint(x), false, false); other = __uint_as_float(r[1]); return __uint_as_float(r[0]); }
__device__ __forceinline__ float quad_sum(float x) { float o; float a = swap16_a(x, o); x = a + o; a = swap32_a(x, o); return a + o; }
__device__ __forceinline__ float quad_max(float x) { float o; float a = swap16_a(x, o); x = fmaxf(a, o); a = swap32_a(x, o); return fmaxf(a, o); }
__device__ __forceinline__ float row_sum(float v) { v += WV_DPP(v, 0xB1); v += WV_DPP(v, 0x4E); v += WV_DPP(v, 0x141); v += WV_DPP(v, 0x140); return v; }
__device__ __forceinline__ float row_max(float v) { v = fmaxf(v, WV_DPP(v, 0xB1)); v = fmaxf(v, WV_DPP(v, 0x4E)); v = fmaxf(v, WV_DPP(v, 0x141)); v = fmaxf(v, WV_DPP(v, 0x140)); return v; }
__device__ __forceinline__ float wave_sum(float v) { return quad_sum(row_sum(v)); }
__device__ __forceinline__ float wave_max(float v) { return quad_max(row_max(v)); }
__device__ __forceinline__ float lane_up(float v, int d, int lane) { return __uint_as_float((unsigned)__builtin_amdgcn_ds_bpermute((lane - d) << 2, (int)__float_as_uint(v))); }
__device__ __forceinline__ float lane_get(float v, int src) { return __uint_as_float((unsigned)__builtin_amdgcn_readlane((int)__float_as_uint(v), src)); }
}
namespace pg8 {
#define PG8_LAS __attribute__((address_space(3)))
typedef unsigned short bf16_t;
typedef short bf16x8 __attribute__((ext_vector_type(8)));
typedef float f32x4 __attribute__((ext_vector_type(4)));
typedef unsigned u32x4 __attribute__((ext_vector_type(4)));
constexpr int BM = 256, BK = 64, HALF = 128, HTB = HALF * BK * 2  , STAGE_BYTES = 8 * HTB, NXCD = 8, WGM = 8;

__host__ __device__ __forceinline__ int lds_byte(int r, int c) { const int st = (r >> 4) * 2 + (c >> 5), rr = r & 15, cc = c & 31, ob = rr * 64 + cc * 2; return st * 1024 + (ob ^ (((ob >> 9) & 1) << 5)); }
__host__ __device__ __forceinline__ void stage_rc(int b, int& R, int& C) { const int st = b / 1024, sb = b % 1024, swz = sb ^ (((sb >> 9) & 1) << 5); R = (st >> 1) * 16 + swz / 64; C = (st & 1) * 32 + (swz % 64) / 2; }
__host__ __device__ __forceinline__ int perm32(int rho) { const int n = rho >> 4, i = rho & 15; return 8 * (i >> 2) + 4 * n + (i & 3); }

struct Unit { int pm, pn; };
struct Gemm { const bf16_t* A; const bf16_t* Bt; int M, N, K; };

struct StaticOrder {
    int nM, nN, nwg, G, c;
    __host__ __device__ void init(int M, int N, int G_, int c_) { nM = M / BM; nN = N / BM; nwg = nM * nN; G = G_; c = c_; }
    __host__ __device__ bool next(int i, Unit& u) const {
        const long L = (long)i * G + c; if (L >= nwg) return false;
        int wgid = (int)L; { const int q = nwg / NXCD, r = nwg % NXCD, xcd = wgid % NXCD, off = wgid / NXCD; wgid = (xcd < r ? xcd * (q + 1) : r * (q + 1) + (xcd - r) * q) + off; }
        const int nig = WGM * nN, gid = wgid / nig, fm = gid * WGM, gsz = (nM - fm) < WGM ? (nM - fm) : WGM;
        u.pm = fm + ((wgid % nig) % gsz); u.pn = (wgid % nig) / gsz; return true;
    }
    __device__ __forceinline__ void a_ready(const Unit&) const {}
    __device__ __forceinline__ void done(const Unit&) const {}
};

__device__ __forceinline__ unsigned cvt_pk_bf16(float lo, float hi) { unsigned r; asm volatile("v_cvt_pk_bf16_f32 %0, %1, %2" : "=v"(r) : "v"(lo), "v"(hi)); return r; }
typedef float f32x2 __attribute__((ext_vector_type(2)));
#define PG8_GAS __attribute__((address_space(1)))
constexpr float RMS_EPS_F = 1e-6f;
__device__ __forceinline__ void load_rstd(const float* ssq, int row0, int fq, float (&rs)[2][4]) {
    f32x4 raw[2][4][2];
#pragma unroll
    for (int ai = 0; ai < 2; ++ai)
#pragma unroll
        for (int m = 0; m < 4; ++m) {
            const PG8_GAS f32x4* p = (const PG8_GAS f32x4*)(ssq + (size_t)(row0 + ai * HALF + m * 16) * 32 + fq * 8);
            raw[ai][m][0] = p[0]; raw[ai][m][1] = p[1];
        }
    asm volatile("" ::: "memory");
#pragma unroll
    for (int ai = 0; ai < 2; ++ai)
#pragma unroll
        for (int m = 0; m < 4; ++m) {
            const f32x4 a = raw[ai][m][0], b = raw[ai][m][1];
            float s = ((a[0] + a[1]) + (a[2] + a[3])) + ((b[0] + b[1]) + (b[2] + b[3]));
            s = wv::quad_sum(s);
            rs[ai][m] = __builtin_amdgcn_rsqf(s * (1.0f / 2048.0f) + RMS_EPS_F);
        }
}
__device__ __forceinline__ float sigmoid_f(float x) { return __builtin_amdgcn_rcpf(1.0f + __builtin_amdgcn_exp2f(-1.4426950408889634f * x)); }

struct EpiSwiGLU {
    static constexpr bool PERM = true, AFTER_DRAIN = false, INIT = false;
    bf16_t* act; const float* ssq; int ldc;
    __device__ __forceinline__ void operator()(const f32x4 (&acc)[2][2][4][2], const Unit& u, int wr, int wc, int fr, int fq) const {
        const int row0 = u.pm * BM + wr * 64 + fr, col0 = u.pn * HALF + wc * 32 + 8 * fq;
        float rs[2][4]; load_rstd(ssq, row0, fq, rs);
#pragma unroll
        for (int ai = 0; ai < 2; ++ai)
#pragma unroll
            for (int m = 0; m < 4; ++m) {
                const float s = rs[ai][m]; float v[8];
#pragma unroll
                for (int n = 0; n < 2; ++n)
#pragma unroll
                    for (int j = 0; j < 4; ++j) { const float g = acc[ai][0][m][n][j] * s, up = acc[ai][1][m][n][j] * s; v[n * 4 + j] = g * sigmoid_f(g) * up; }
                u32x4 w; w.x = cvt_pk_bf16(v[0], v[1]); w.y = cvt_pk_bf16(v[2], v[3]); w.z = cvt_pk_bf16(v[4], v[5]); w.w = cvt_pk_bf16(v[6], v[7]);
                *(PG8_GAS u32x4*)(act + (size_t)(row0 + ai * HALF + m * 16) * ldc + col0) = w;
            }
    }
};
struct EpiScaleBf16 {
    static constexpr bool PERM = true, AFTER_DRAIN = false, INIT = false;
    bf16_t* O; const float* ssq; int ldc;
    __device__ __forceinline__ void operator()(const f32x4 (&acc)[2][2][4][2], const Unit& u, int wr, int wc, int fr, int fq) const {
        const int row0 = u.pm * BM + wr * 64 + fr, col0 = u.pn * BM + wc * 32 + 8 * fq;
        float rs[2][4];
        if (ssq) load_rstd(ssq, row0, fq, rs);
        else {
#pragma unroll
            for (int ai = 0; ai < 2; ++ai)
#pragma unroll
                for (int m = 0; m < 4; ++m) rs[ai][m] = 1.0f; }
#pragma unroll
        for (int ai = 0; ai < 2; ++ai)
#pragma unroll
            for (int m = 0; m < 4; ++m) { const float s = rs[ai][m]; bf16_t* rowp = O + (size_t)(row0 + ai * HALF + m * 16) * ldc + col0;
#pragma unroll
                for (int bj = 0; bj < 2; ++bj) { const f32x4 v0 = acc[ai][bj][m][0] * s, v1 = acc[ai][bj][m][1] * s;
                    u32x4 w; w.x = cvt_pk_bf16(v0[0], v0[1]); w.y = cvt_pk_bf16(v0[2], v0[3]); w.z = cvt_pk_bf16(v1[0], v1[1]); w.w = cvt_pk_bf16(v1[2], v1[3]);
                    *(PG8_GAS u32x4*)(rowp + bj * HALF) = w; } }
    }
};
template <int MODE, int ALPHA_X2> struct EpiResid {
    static constexpr bool PERM = true, AFTER_DRAIN = false, INIT = (MODE == 0);
    static constexpr float alpha = 0.5f * ALPHA_X2;
    const bf16_t* hin; bf16_t* hb; float* ssq_out; const float* ssq_in; const bf16_t* pp;
    static __device__ __forceinline__ float lo16(unsigned w) { return __uint_as_float(w << 16); }
    static __device__ __forceinline__ float hi16(unsigned w) { return __uint_as_float(w & 0xffff0000u); }
    __device__ __forceinline__ void init(f32x4 (&acc)[2][2][4][2], const Unit& u, int wr, int wc, int fr, int fq) const {
        const int row0 = u.pm * BM + wr * 64 + fr, col0 = u.pn * BM + wc * 32 + 8 * fq; constexpr float ia = 1.0f / alpha;
        u32x4 w[2][4][2];
#pragma unroll
        for (int ai = 0; ai < 2; ++ai)
#pragma unroll
            for (int m = 0; m < 4; ++m)
#pragma unroll
                for (int bj = 0; bj < 2; ++bj) w[ai][m][bj] = *(const PG8_GAS u32x4*)(hin + (size_t)(row0 + ai * HALF + m * 16) * 2048 + col0 + bj * HALF);
#pragma unroll
        for (int ai = 0; ai < 2; ++ai)
#pragma unroll
            for (int m = 0; m < 4; ++m)
#pragma unroll
                for (int bj = 0; bj < 2; ++bj) { const u32x4 v = w[ai][m][bj];
                    acc[ai][bj][m][0] = (f32x4){lo16(v.x), hi16(v.x), lo16(v.y), hi16(v.y)} * ia; acc[ai][bj][m][1] = (f32x4){lo16(v.z), hi16(v.z), lo16(v.w), hi16(v.w)} * ia; }
    }
    __device__ __forceinline__ float put(unsigned eoff, const f32x4& a, const f32x4& b) const {
        u32x4 w; w.x = cvt_pk_bf16(a[0], a[1]); w.y = cvt_pk_bf16(a[2], a[3]); w.z = cvt_pk_bf16(b[0], b[1]); w.w = cvt_pk_bf16(b[2], b[3]);
        *(PG8_GAS u32x4*)((PG8_GAS char*)hb + 2u * eoff) = w;
        const float a0 = lo16(w.x), a1 = hi16(w.x), a2 = lo16(w.y), a3 = hi16(w.y), b0 = lo16(w.z), b1 = hi16(w.z), b2 = lo16(w.w), b3 = hi16(w.w);
        return ((a0 * a0 + a1 * a1) + (a2 * a2 + a3 * a3)) + ((b0 * b0 + b1 * b1) + (b2 * b2 + b3 * b3));
    }
    __device__ __forceinline__ void operator()(const f32x4 (&acc)[2][2][4][2], const Unit& u, int wr, int wc, int fr, int fq) const {
        const int row0 = u.pm * BM + wr * 64 + fr, col0 = u.pn * BM + wc * 32 + 8 * fq;
        const unsigned e0 = (unsigned)(row0 * 2048 + col0);
        if constexpr (MODE == 0) {
#pragma unroll
            for (int ai = 0; ai < 2; ++ai)
#pragma unroll
                for (int m = 0; m < 4; ++m) {
                    const int r = row0 + ai * HALF + m * 16; float q = 0.f;
#pragma unroll
                    for (int bj = 0; bj < 2; ++bj) q += put(e0 + (unsigned)((ai * HALF + m * 16) * 2048 + bj * HALF), acc[ai][bj][m][0] * alpha, acc[ai][bj][m][1] * alpha);
                    q = wv::quad_sum(q);
                    if (fq == 0) *(PG8_GAS float*)(ssq_out + (size_t)r * 32 + u.pn * 4 + wc) = q;
                }
        } else {
            float rs[2][4]; load_rstd(ssq_in, row0, fq, rs);
            const PG8_GAS char* hB = (const PG8_GAS char*)hin; const PG8_GAS char* pB = (const PG8_GAS char*)pp;
            u32x4 hv[2][2], pv[2][2];
#define RES_LD(IT, BUF) { _Pragma("unroll") for (int bj = 0; bj < 2; ++bj) { const unsigned bo = 2u * (e0 + (unsigned)(((((IT) >> 2) * HALF + ((IT) & 3) * 16) * 2048 + bj * HALF))); \
                hv[BUF][bj] = *(const PG8_GAS u32x4*)(hB + bo); pv[BUF][bj] = *(const PG8_GAS u32x4*)(pB + bo); } }
            RES_LD(0, 0)
#pragma unroll
            for (int it = 0; it < 8; ++it) {
                const int ai = it >> 2, m = it & 3, cb = it & 1;
                if (it + 1 < 8) RES_LD(it + 1, cb ^ 1)
                asm volatile("" ::: "memory");
                const int r = row0 + ai * HALF + m * 16; float q = 0.f; const float s = rs[ai][m];
#pragma unroll
                for (int bj = 0; bj < 2; ++bj) {
                    const u32x4 hw = hv[cb][bj], pw = pv[cb][bj];
                    f32x4 a = (f32x4){lo16(hw.x), hi16(hw.x), lo16(hw.y), hi16(hw.y)}, b = (f32x4){lo16(hw.z), hi16(hw.z), lo16(hw.w), hi16(hw.w)};
#pragma unroll
                    for (int j = 0; j < 4; ++j) {
                        const unsigned w0 = pw[j >> 1], w1 = pw[2 + (j >> 1)];
                        const float p0 = (j & 1) ? hi16(w0) : lo16(w0), p1 = (j & 1) ? hi16(w1) : lo16(w1);
                        a[j] += sigmoid_f(acc[ai][bj][m][0][j] * s) * p0; b[j] += sigmoid_f(acc[ai][bj][m][1][j] * s) * p1; }
                    q += put(e0 + (unsigned)((ai * HALF + m * 16) * 2048 + bj * HALF), a, b);
                }
                q = wv::quad_sum(q);
                if (fq == 0) *(PG8_GAS float*)(ssq_out + (size_t)r * 32 + u.pn * 4 + wc) = q;
            }
#undef RES_LD
        }
    }
};
struct NoHook { __device__ __forceinline__ void operator()() const {} };
template <class Epi, class Sched, bool ALIGN_EPI = false, bool SP2 = false, class Hook = NoHook>
__device__ __forceinline__ void gemm_phase(PG8_LAS unsigned char* lds, const Gemm g, const Sched& S, const Epi& E, int wave_id, const Hook& hook = Hook()) {
    int wid_ = wave_id; asm volatile("" : "+s"(wid_)); int lane_; asm volatile("v_mbcnt_lo_u32_b32 %0, -1, 0\n\tv_mbcnt_hi_u32_b32 %0, -1, %0" : "=v"(lane_));
    const int wid = wid_, lane = lane_, tid = wid * 64 + lane, wr = wid >> 2, wc = wid & 3, fr = lane & 15, fq = lane >> 4;
    const int K = g.K, nt = K / BK;
    unsigned voffA[2], voffB[2];
#pragma unroll
    for (int i = 0; i < 2; ++i) { int R, C; stage_rc(tid * 16 + i * 8192, R, C); const int Rb = Epi::PERM ? ((R & ~31) + perm32(R & 31)) : R;
        voffA[i] = (unsigned)(R * K + C) * 2u; voffB[i] = (unsigned)(Rb * K + C) * 2u; }
    const size_t kstep = (size_t)(BK * 2);
    const size_t hstep = (size_t)HALF * K * 2;
    const size_t tstep = 2 * hstep;
    const unsigned ldsw = (unsigned)wid * 1024u;
    const int aoff = lds_byte(wr * 64 + fr, fq * 8), boff = lds_byte(wc * 32 + fr, fq * 8);
#define PG8_SA(b, h) (((b) * 2 + (h)) * HTB)
#define PG8_SB(b, h) ((4 + (b) * 2 + (h)) * HTB)
#define PG8_STAGE(bufoff, gbase, voff) do { _Pragma("unroll") for (int _i = 0; _i < 2; ++_i) \
        __builtin_amdgcn_global_load_lds((const unsigned*)((const char*)(gbase) + (voff)[_i]), (PG8_LAS unsigned*)(lds + (bufoff) + ldsw + _i * 8192), 16, 0, 0); } while (0)
#define PG8_LDA(dst, b, h) do { _Pragma("unroll") for (int m = 0; m < 4; ++m) _Pragma("unroll") for (int k = 0; k < 2; ++k) dst[m][k] = *(const PG8_LAS bf16x8*)(lds + PG8_SA(b, h) + aoff + m * 2048 + k * 1024); } while (0)
#define PG8_LDB(dst, b, h) do { _Pragma("unroll") for (int n = 0; n < 2; ++n) _Pragma("unroll") for (int k = 0; k < 2; ++k) dst[n][k] = *(const PG8_LAS bf16x8*)(lds + PG8_SB(b, h) + boff + n * 2048 + k * 1024); } while (0)
#define PG8_MMA(ai, bj, At, Bt) do { __builtin_amdgcn_s_setprio(1); _Pragma("unroll") for (int m = 0; m < 4; ++m) _Pragma("unroll") for (int n = 0; n < 2; ++n) _Pragma("unroll") for (int k = 0; k < 2; ++k) \
        acc[ai][bj][m][n] = __builtin_amdgcn_mfma_f32_16x16x32_bf16(Bt[n][k], At[m][k], acc[ai][bj][m][n], 0, 0, 0); __builtin_amdgcn_s_setprio(0); } while (0)
#define PG8_WAIT_V(n) asm volatile("s_waitcnt vmcnt(" #n ")" ::: "memory")
#define PG8_WAIT_L(n) asm volatile("s_waitcnt lgkmcnt(" #n ")" ::: "memory")
#define PG8_BAR __builtin_amdgcn_s_barrier()
#define PG8_SCHED __builtin_amdgcn_sched_barrier(0)
    Unit cur, nxt; int ui = 0;
    const bool has_unit = S.next(0, cur);
    f32x4 acc[2][2][4][2];
    if constexpr (Epi::INIT) { if (has_unit) E.init(acc, cur, wr, wc, fr, fq); }
    else {
#pragma unroll
    for (int a = 0; a < 2; ++a)
#pragma unroll
        for (int b = 0; b < 2; ++b)
#pragma unroll
            for (int m = 0; m < 4; ++m)
#pragma unroll
                for (int n = 0; n < 2; ++n) acc[a][b][m][n] = (f32x4){0.f, 0.f, 0.f, 0.f};
    }
    hook();
    if (!has_unit) return;
    bf16x8 At[4][2], B0[2][2], B1[2][2];
    const char* cA = (const char*)g.A + (size_t)cur.pm * tstep; const char* cB = (const char*)g.Bt + (size_t)cur.pn * tstep;
    S.a_ready(cur);
    if constexpr (SP2) {
        PG8_STAGE(PG8_SB(0, 0), cB, voffB); PG8_STAGE(PG8_SB(0, 1), cB + hstep, voffB); PG8_STAGE(PG8_SA(0, 0), cA, voffA); PG8_STAGE(PG8_SA(0, 1), cA + hstep, voffA);
        if (wr == 1) PG8_BAR;
        PG8_WAIT_V(2); PG8_BAR;
        PG8_STAGE(PG8_SB(1, 0), cB + kstep, voffB); PG8_STAGE(PG8_SA(1, 0), cA + kstep, voffA); PG8_STAGE(PG8_SB(1, 1), cB + hstep + kstep, voffB);
        PG8_WAIT_V(6); PG8_BAR;
    } else {
        PG8_STAGE(PG8_SB(0, 0), cB, voffB); PG8_STAGE(PG8_SA(0, 0), cA, voffA); PG8_STAGE(PG8_SB(0, 1), cB + hstep, voffB); PG8_STAGE(PG8_SA(0, 1), cA + hstep, voffA);
        if (wr == 1) PG8_BAR;
        PG8_WAIT_V(4); PG8_BAR;
        PG8_STAGE(PG8_SB(1, 0), cB + kstep, voffB); PG8_STAGE(PG8_SA(1, 0), cA + kstep, voffA); PG8_STAGE(PG8_SB(1, 1), cB + hstep + kstep, voffB);
        PG8_WAIT_V(6); PG8_BAR;
    }
    for (;;) {
        const bool has_next = S.next(ui + 1, nxt);
        const char* nA = has_next ? (const char*)g.A + (size_t)nxt.pm * tstep : cA; const char* nB = has_next ? (const char*)g.Bt + (size_t)nxt.pn * tstep : cB;
        for (int t = 0; t < nt; t += 2) {
            const bool last = (t == nt - 2);
            const char* a1 = cA + (size_t)(t + 1) * kstep;
            const char* a2 = last ? nA : cA + (size_t)(t + 2) * kstep; const char* b2 = last ? nB : cB + (size_t)(t + 2) * kstep;
            const char* a3 = a2 + kstep; const char* b3 = b2 + kstep;
            if (last && has_next) S.a_ready(nxt);
            if constexpr (SP2) {
            PG8_LDB(B0, 0, 0); PG8_LDB(B1, 0, 1); PG8_SCHED; PG8_LDA(At, 0, 0); PG8_STAGE(PG8_SA(1, 1), a1 + hstep, voffA);
            PG8_WAIT_V(8); PG8_WAIT_L(0); PG8_BAR; PG8_MMA(0, 0, At, B0); PG8_MMA(0, 1, At, B1); PG8_BAR; PG8_SCHED;
            PG8_LDA(At, 0, 1); PG8_STAGE(PG8_SB(0, 0), b2, voffB); PG8_STAGE(PG8_SB(0, 1), b2 + hstep, voffB); PG8_STAGE(PG8_SA(0, 0), a2, voffA);
            PG8_WAIT_V(8); PG8_WAIT_L(0); PG8_BAR; PG8_MMA(1, 0, At, B0); PG8_MMA(1, 1, At, B1); PG8_BAR; PG8_SCHED;
            PG8_LDB(B0, 1, 0); PG8_LDB(B1, 1, 1); PG8_SCHED; PG8_LDA(At, 1, 0); PG8_STAGE(PG8_SA(0, 1), a2 + hstep, voffA);
            PG8_WAIT_V(8); PG8_WAIT_L(0); PG8_BAR; PG8_MMA(0, 0, At, B0); PG8_MMA(0, 1, At, B1); PG8_BAR; PG8_SCHED;
            PG8_LDA(At, 1, 1); PG8_STAGE(PG8_SB(1, 0), b3, voffB); PG8_STAGE(PG8_SB(1, 1), b3 + hstep, voffB); PG8_STAGE(PG8_SA(1, 0), a3, voffA);
            PG8_WAIT_V(8); PG8_WAIT_L(0); PG8_BAR; PG8_MMA(1, 0, At, B0); PG8_MMA(1, 1, At, B1); PG8_BAR; PG8_SCHED;
            } else {
            PG8_LDB(B0, 0, 0); PG8_SCHED; PG8_LDA(At, 0, 0); PG8_STAGE(PG8_SA(1, 1), a1 + hstep, voffA);
            PG8_WAIT_L(8); PG8_BAR; PG8_WAIT_L(0); PG8_MMA(0, 0, At, B0); PG8_BAR; PG8_SCHED;
            PG8_LDB(B1, 0, 1); PG8_STAGE(PG8_SB(0, 0), b2, voffB);
            PG8_BAR; PG8_WAIT_L(0); PG8_MMA(0, 1, At, B1); PG8_BAR;
            PG8_LDA(At, 0, 1); PG8_STAGE(PG8_SA(0, 0), a2, voffA);
            PG8_BAR; PG8_WAIT_L(0); PG8_MMA(1, 0, At, B0); PG8_BAR; PG8_SCHED;
            PG8_STAGE(PG8_SB(0, 1), b2 + hstep, voffB);
            PG8_WAIT_V(6); PG8_BAR; PG8_MMA(1, 1, At, B1); PG8_BAR;
            PG8_LDB(B0, 1, 0); PG8_SCHED; PG8_LDA(At, 1, 0); PG8_STAGE(PG8_SA(0, 1), a2 + hstep, voffA);
            PG8_WAIT_L(8); PG8_BAR; PG8_WAIT_L(0); PG8_MMA(0, 0, At, B0); PG8_BAR; PG8_SCHED;
            PG8_LDB(B1, 1, 1); PG8_STAGE(PG8_SB(1, 0), b3, voffB);
            PG8_BAR; PG8_WAIT_L(0); PG8_MMA(0, 1, At, B1); PG8_BAR;
            PG8_LDA(At, 1, 1); PG8_STAGE(PG8_SA(1, 0), a3, voffA);
            PG8_BAR; PG8_WAIT_L(0); PG8_MMA(1, 0, At, B0); PG8_BAR; PG8_SCHED;
            PG8_STAGE(PG8_SB(1, 1), b3 + hstep, voffB);
            PG8_WAIT_V(6); PG8_BAR; PG8_MMA(1, 1, At, B1); PG8_BAR;
            }
        }
        if constexpr (ALIGN_EPI) { if (wr == 0) PG8_BAR; }
        if constexpr (!Epi::AFTER_DRAIN) { E(acc, cur, wr, wc, fr, fq); S.done(cur); }
        if (!has_next) break;
        if constexpr (Epi::INIT) E.init(acc, nxt, wr, wc, fr, fq);
        else {
#pragma unroll
        for (int a = 0; a < 2; ++a)
#pragma unroll
            for (int b = 0; b < 2; ++b)
#pragma unroll
                for (int m = 0; m < 4; ++m)
#pragma unroll
                    for (int n = 0; n < 2; ++n) acc[a][b][m][n] = (f32x4){0.f, 0.f, 0.f, 0.f};
        }
        cur = nxt; cA = nA; cB = nB; ++ui;
        if constexpr (ALIGN_EPI) { if (wr == 1) PG8_BAR; }
    }
    PG8_WAIT_V(0);
    if constexpr (!ALIGN_EPI) { if (wr == 0) PG8_BAR; }
    PG8_BAR;
    if constexpr (Epi::AFTER_DRAIN) { E.fused(acc, cur, wr, wc, fr, fq, lds, wid, lane); S.done(cur); }
#undef PG8_SA
#undef PG8_SB
#undef PG8_STAGE
#undef PG8_LDA
#undef PG8_LDB
#undef PG8_MMA
#undef PG8_WAIT_V
#undef PG8_WAIT_L
#undef PG8_BAR
#undef PG8_SCHED
}
}

constexpr int NBATCH = 4, T = 2048, D = 2048, M = NBATCH * T, DEPTH = 4, DFF = 5632, NUP = 2 * DFF, NIN = 6144, DIN = 6152, DPLE = 256;
constexpr int NH = 4, HD = 128, DKM = 128, DVM = 256, NBH = NBATCH * NH;
constexpr int ZQA = 0, ZKA = 512, ZVA = 1024, ZQC = 1536, ZKC = 2048, ZVC = 2560, ZQKM = 3072, ZVM = 4096, ZOM = 5120;
constexpr float RMS_EPS = 1e-6f, LOG2E = 1.4426950408889634f;
constexpr int NWAVES = 8;

constexpr size_t MiB = 1u << 20;
constexpr size_t WS_CTL = 0, CTL_ZERO_BYTES = 1 * MiB;
constexpr size_t WS_W = 2 * MiB, LW_UP1 = 0, LW_DN1 = 44 * MiB, LW_IN = 66 * MiB, LW_OUT = 90 * MiB, LW_UP2 = 98 * MiB, LW_DN2 = 142 * MiB, LW_G = 164 * MiB, LW_P = 172 * MiB, LW_STRIDE = 174 * MiB;
constexpr size_t WS_HB0 = 700 * MiB, WS_HB1 = 732 * MiB, WS_SSQ0 = 764 * MiB, WS_SSQ1 = 765 * MiB, WS_GATES = 766 * MiB, WS_BCUM = 767 * MiB;
constexpr size_t WS_ACT = 768 * MiB, WS_Z = 856 * MiB, WS_MIXED = 952 * MiB, WS_PP = 984 * MiB, WS_PB = 1016 * MiB;
constexpr size_t WS_QC = 1032 * MiB, WS_KC = 1040 * MiB, WS_KMEAN = 1048 * MiB, WS_DLSE = 1049 * MiB, WS_DOUT = 1056 * MiB;
constexpr size_t WS_BQ = 1050 * MiB, WS_AQ = WS_BQ + 131072, WS_BLAST = WS_AQ + 131072, WS_AMAX = WS_BLAST + 4096, WS_MST = WS_AMAX + 4096, WS_DN = 1051 * MiB, WS_NST = WS_DN + 262144;
constexpr size_t WS_DCT = 1104 * MiB, WS_CST = 1168 * MiB, WS_MOUT = 1200 * MiB, WS_MLSE = 1248 * MiB, WS_END = 1250 * MiB;
static_assert(WS_W + 4 * LW_STRIDE <= WS_HB0 && WS_ACT + (size_t)M * DFF * 2 <= WS_Z && WS_Z + (size_t)M * NIN * 2 <= WS_MIXED, "d_ws map");
constexpr int CW_BAR = 4096, CW_QUEUE = 8192;

constexpr int RING_OFF = 0, RING_BYTES = 131072;
constexpr int SCR_BYTES = 8 * 16640;
constexpr int LDSCTL_OFF = SCR_BYTES, MISC_OFF = LDSCTL_OFF + 320;
constexpr int LDS_BYTES = 147456;
static_assert(MISC_OFF + 128 <= LDS_BYTES && SCR_BYTES >= RING_BYTES, "LDS map");

#define GAS __attribute__((address_space(1)))
#define LAS __attribute__((address_space(3)))
typedef unsigned short bf16;
typedef unsigned v4u __attribute__((ext_vector_type(4)));
typedef unsigned v2u __attribute__((ext_vector_type(2)));
typedef float f32x4 __attribute__((ext_vector_type(4)));
typedef GAS unsigned gu32;
#define RLX_AGENT __ATOMIC_RELAXED, __HIP_MEMORY_SCOPE_AGENT
#define LDS_WAIT() asm volatile("s_waitcnt lgkmcnt(0)" ::: "memory")
#define VM_WAIT() asm volatile("s_waitcnt vmcnt(0)" ::: "memory")
__device__ __forceinline__ unsigned f2bf(float f) { unsigned u = __builtin_bit_cast(unsigned, f); return (u + 0x7fffu + ((u >> 16) & 1u)) >> 16; }
__device__ __forceinline__ unsigned pk2(float lo, float hi) { return f2bf(lo) | (f2bf(hi) << 16); }
__device__ __forceinline__ float bflo(unsigned w) { return __uint_as_float(w << 16); }
__device__ __forceinline__ float bfhi(unsigned w) { return __uint_as_float(w & 0xffff0000u); }
__device__ __forceinline__ float sigmoid_fast(float x) { return __builtin_amdgcn_rcpf(1.0f + __builtin_amdgcn_exp2f(-1.4426950408889634f * x)); }
__device__ __forceinline__ float bf2f(bf16 b) { return __uint_as_float(((unsigned)b) << 16); }

#define XB_TMO      128
#define XB_XCNT(j)  (256  + 64 * (j))
#define XB_XSUB(j)  (1280 + 64 * (j))
#define XB_XGEN(j)  (2304 + 64 * (j))
#define XB_TOP      3328
#define XB_TOPGEN   3392
#define XCD_BAR_WORDS 3456
#define XB_SPIN_CAP (1u << 18)

__device__ __forceinline__ unsigned xb_ld(unsigned* p)              { return __hip_atomic_load(p, __ATOMIC_RELAXED, __HIP_MEMORY_SCOPE_AGENT); }
__device__ __forceinline__ unsigned xb_add(unsigned* p, unsigned v) { return __hip_atomic_fetch_add(p, v, __ATOMIC_RELAXED, __HIP_MEMORY_SCOPE_AGENT); }
__device__ __forceinline__ unsigned xb_xcc_id() { return (unsigned)__builtin_amdgcn_s_getreg((3 << 11) | 20) & 0xFu; }
#define XB_SPIN(cond, bar) do { unsigned _sp = 0; while (cond) { __builtin_amdgcn_s_sleep(1); \
    if ((++_sp & 255u) == 0u) { if (xb_ld(&(bar)[XB_TMO])) break; if (_sp > XB_SPIN_CAP) { atomicAdd(&(bar)[XB_TMO], 1u); break; } } } } while (0)

struct XcdBarrier {
    unsigned* bar; unsigned x;
    volatile LAS unsigned* st;
};

__device__ __forceinline__ XcdBarrier xcd_barrier_post(unsigned* bar, volatile LAS unsigned* st) {
    XcdBarrier b; b.bar = bar; b.x = xb_xcc_id(); b.st = st;
    if (threadIdx.x == 0) (void)xb_add(&bar[XB_XCNT(b.x)], 1u);
    return b;
}
__device__ __forceinline__ void xcd_barrier_complete(unsigned* bar, unsigned x, unsigned& nloc, unsigned& nx) {
    const unsigned G = gridDim.x * gridDim.y * gridDim.z;
    unsigned sum, cnt, mine, sp = 0u;
    for (;;) {
        sum = 0u; cnt = 0u; mine = 0u;
#pragma unroll
        for (unsigned j = 0; j < 16; ++j) { const unsigned c = xb_ld(&bar[XB_XCNT(j)]); sum += c; cnt += (c > 0u) ? 1u : 0u; mine = (j == x) ? c : mine; }
        if (sum == G) break;
        __builtin_amdgcn_s_sleep(1);
        if ((++sp & 255u) == 0u) { if (xb_ld(&bar[XB_TMO])) break; if (sp > XB_SPIN_CAP) { atomicAdd(&bar[XB_TMO], 1u); break; } }
    }
    nloc = mine > 0u ? mine : 1u; nx = cnt > 0u ? cnt : 1u;
}

__device__ __forceinline__ void xcd_barrier(const XcdBarrier& b) {
    asm volatile("s_waitcnt vmcnt(0)" ::: "memory");
    __syncthreads();
    if (threadIdx.x == 0) {
        unsigned* bar = b.bar;
        __builtin_amdgcn_s_waitcnt(0);
        unsigned nloc = b.st[0], nx = b.st[1];
        if (nloc == 0u) { xcd_barrier_complete(bar, b.x, nloc, nx); b.st[0] = nloc; b.st[1] = nx; }
        const unsigned old = xb_add(&bar[XB_XSUB(b.x)], 1u);
        const unsigned gen = old / nloc;
        if (old + 1u == (gen + 1u) * nloc) {
            __builtin_amdgcn_fence(__ATOMIC_RELEASE, "agent");
            asm volatile("s_waitcnt vmcnt(0)" ::: "memory");
            const unsigned og = xb_add(&bar[XB_TOP], 1u);
            const unsigned tg = og / nx;
            if (og + 1u == (tg + 1u) * nx) xb_add(&bar[XB_TOPGEN], 1u);
            else XB_SPIN(xb_ld(&bar[XB_TOPGEN]) == tg, bar);
            __builtin_amdgcn_fence(__ATOMIC_ACQUIRE, "agent");
            xb_add(&bar[XB_XGEN(b.x)], 1u);
            asm volatile("s_waitcnt vmcnt(0)" ::: "memory");
        } else {
            XB_SPIN(xb_ld(&bar[XB_XGEN(b.x)]) == gen, bar);
            __builtin_amdgcn_fence(__ATOMIC_ACQUIRE, "agent");
            asm volatile("s_waitcnt vmcnt(0)" ::: "memory");
        }
    }
    __syncthreads();
}


struct BarHook { const XcdBarrier& b; bool on; __device__ __forceinline__ void operator()() const { if (on) xcd_barrier(b); } };
struct Args { const float* in[20]; float* out; unsigned char* ws; int ph_lo, ph_hi; };
struct Frame {
    LAS unsigned char* lds;
    volatile LAS unsigned* MISC;
    gu32* ctl;
    int tid, lane, wave, wave0;
    int vcu, G;
    float* out; unsigned char* ws;
};
__device__ __forceinline__ float wave_sum(float v) { return wv::wave_sum(v); }
__device__ __forceinline__ float wave_max(float v) { return wv::wave_max(v); }
__device__ __forceinline__ bf16* wptr(Frame& F, int layer, size_t off) { return (bf16*)(F.ws + WS_W + (size_t)layer * LW_STRIDE + off); }
#define WPTR(off) ((bf16*)(ws + WS_W + (size_t)L * LW_STRIDE + (off)))

#define OPAQUE_TID(F) do { int w_ = (F).wave0; asm volatile("" : "+s"(w_)); int l_; asm volatile("v_mbcnt_lo_u32_b32 %0, -1, 0\n\tv_mbcnt_hi_u32_b32 %0, -1, %0" : "=v"(l_)); (F).lane = l_; (F).wave = w_; (F).tid = w_ * 64 + l_; } while (0)
struct ItemDesc { const float* W; const float* g; bf16* WT; int K, ldn, upmap, k0, n0; };
struct ItemRegs { f32x4 v[16], g0, g1; };
__device__ __forceinline__ void item_load(const ItemDesc& d, int lane, ItemRegs& R) {
    const int kq = lane >> 4, nc = (lane & 15) * 4, c = lane & 7;
    const float* src = d.W + (size_t)(d.k0 + kq) * d.ldn + d.n0 + nc;
    const float* gp = d.g ? d.g + d.k0 + 8 * c : src;
    R.g0 = *(const GAS f32x4*)gp; R.g1 = *(const GAS f32x4*)(gp + 4);
#pragma unroll
    for (int i = 0; i < 16; ++i) R.v[i] = __builtin_nontemporal_load((const GAS f32x4*)(src + (size_t)(4 * i) * d.ldn));
}
__device__ __forceinline__ void item_finish(const ItemDesc& d, LAS float* scr, int lane, const ItemRegs& R) {
    const int kq = lane >> 4, nc = (lane & 15) * 4;
#pragma unroll
    for (int i = 0; i < 16; ++i) { LAS float* p = scr + (4 * i + kq) * 65 + nc; p[0] = R.v[i][0]; p[1] = R.v[i][1]; p[2] = R.v[i][2]; p[3] = R.v[i][3]; }
    int drow0 = d.n0;
    if (d.upmap) { const int bj = d.n0 / DFF, j = d.n0 - bj * DFF; drow0 = 256 * (j >> 7) + 128 * bj + (j & 127); }
    const int c = lane & 7;
    const f32x4 one4 = (f32x4){1.f, 1.f, 1.f, 1.f}; const f32x4 g0 = d.g ? R.g0 : one4, g1 = d.g ? R.g1 : one4;
    LDS_WAIT(); asm volatile("" ::: "memory");
#pragma unroll
    for (int j = 0; j < 8; ++j) { const int n = (lane >> 3) + 8 * j; const LAS float* s_ = scr + (8 * c) * 65 + n;
        v4u o; o.x = pk2(s_[0 * 65] * g0[0], s_[1 * 65] * g0[1]); o.y = pk2(s_[2 * 65] * g0[2], s_[3 * 65] * g0[3]); o.z = pk2(s_[4 * 65] * g1[0], s_[5 * 65] * g1[1]); o.w = pk2(s_[6 * 65] * g1[2], s_[7 * 65] * g1[3]);
        *(GAS v4u*)(d.WT + (size_t)(drow0 + n) * d.K + d.k0 + 8 * c) = o; }
    LDS_WAIT(); asm volatile("" ::: "memory");
}
constexpr int I_UP = (D / 64) * (NUP / 64), I_DN = (DFF / 64) * (D / 64), I_IN = (D / 64) * (NIN / 64), I_SQ = (D / 64) * (D / 64), I_P = (DPLE / 64) * (D / 64);
constexpr int I_LAYER = 2 * I_UP + 2 * I_DN + I_IN + 2 * I_SQ + I_P, I_SPLIT = 12544;
__device__ __forceinline__ ItemDesc decode_item(Frame& F, const Args& A, int l, int it) {
    ItemDesc d; int r = it, nblk;
    if (r < I_UP) { d.W = A.in[3] + (size_t)l * D * NUP; d.K = D; d.ldn = NUP; d.g = A.in[2] + l * D; d.WT = wptr(F, l, LW_UP1); d.upmap = 1; nblk = NUP / 64; }
    else if ((r -= I_UP) < I_DN) { d.W = A.in[4] + (size_t)l * DFF * D; d.K = DFF; d.ldn = D; d.g = nullptr; d.WT = wptr(F, l, LW_DN1); d.upmap = 0; nblk = D / 64; }
    else if ((r -= I_DN) < I_IN) { d.W = A.in[6] + (size_t)l * D * DIN; d.K = D; d.ldn = DIN; d.g = A.in[5] + l * D; d.WT = wptr(F, l, LW_IN); d.upmap = 0; nblk = NIN / 64; }
    else if ((r -= I_IN) < I_SQ) { d.W = A.in[12] + (size_t)l * D * D; d.K = D; d.ldn = D; d.g = nullptr; d.WT = wptr(F, l, LW_OUT); d.upmap = 0; nblk = D / 64; }
    else if ((r -= I_SQ) < I_UP) { d.W = A.in[14] + (size_t)l * D * NUP; d.K = D; d.ldn = NUP; d.g = A.in[13] + l * D; d.WT = wptr(F, l, LW_UP2); d.upmap = 1; nblk = NUP / 64; }
    else if ((r -= I_UP) < I_DN) { d.W = A.in[15] + (size_t)l * DFF * D; d.K = DFF; d.ldn = D; d.g = nullptr; d.WT = wptr(F, l, LW_DN2); d.upmap = 0; nblk = D / 64; }
    else if ((r -= I_DN) < I_SQ) { d.W = A.in[17] + (size_t)l * D * D; d.K = D; d.ldn = D; d.g = A.in[16] + l * D; d.WT = wptr(F, l, LW_G); d.upmap = 0; nblk = D / 64; }
    else { r -= I_SQ; d.W = A.in[18] + (size_t)l * DPLE * D; d.K = DPLE; d.ldn = D; d.g = nullptr; d.WT = wptr(F, l, LW_P); d.upmap = 0; nblk = D / 64; }
    const int kb = r / nblk; d.k0 = 64 * kb; d.n0 = 64 * (r - kb * nblk);
    return d;
}
__device__ __forceinline__ void convert_items_lw(Frame& F, const Args& A, int l, int it_lo, int it_hi, int wv, int nwv, int wave_, int lane_) {
    LAS float* scr = (LAS float*)(F.lds + wave_ * 16640);
    int it = it_lo + wv;
    if (it >= it_hi) return;
    ItemRegs R0, R1;
    ItemDesc d0 = decode_item(F, A, l, it), d1 = d0;
    item_load(d0, lane_, R0);
    for (;;) {
        const int n1 = it + nwv;
        if (n1 < it_hi) { d1 = decode_item(F, A, l, n1); item_load(d1, lane_, R1); }
        item_finish(d0, scr, lane_, R0);
        if (n1 >= it_hi) break;
        const int n2 = n1 + nwv;
        if (n2 < it_hi) { d0 = decode_item(F, A, l, n2); item_load(d0, lane_, R0); }
        item_finish(d1, scr, lane_, R1);
        if (n2 >= it_hi) break;
        it = n2;
    }
}
__device__ __forceinline__ void convert_items(Frame& F, const Args& A, int l, int it_lo, int it_hi, int wv, int nwv) { convert_items_lw(F, A, l, it_lo, it_hi, wv, nwv, F.wave, F.lane); }
__device__ __forceinline__ void convert_part(Frame& F, const Args& A, int l, int part, int wv, int nwv) {
    if (part) convert_items(F, A, l, I_SPLIT, I_LAYER - I_P, wv, nwv);
    else { convert_items(F, A, l, 0, I_SPLIT, wv, nwv); convert_items(F, A, l, I_LAYER - I_P, I_LAYER, wv, nwv); }
}
#ifndef CONV_NA
#define CONV_NA 3584
#define CONV_ND0 6400
#endif
constexpr int CONV_CH = 32;
constexpr int CQ_N1 = (I_LAYER - I_P - I_SPLIT) - CONV_NA, CQ_U1 = (CQ_N1 + CONV_CH - 1) / CONV_CH, CQ_U2 = (CONV_ND0 + CONV_CH - 1) / CONV_CH;
__device__ __forceinline__ void convert_tail(Frame& F, const Args& A, int l, int part, int bx) {
    OPAQUE_TID(F);
    if (l >= DEPTH) return;
    const int wv = (bx - 128) * NWAVES + F.wave, nwv = 128 * NWAVES;
    if (part) convert_items(F, A, l, I_SPLIT, I_SPLIT + CONV_NA, wv, nwv);
    else { convert_items(F, A, l, CONV_ND0, I_SPLIT, wv, nwv); convert_items(F, A, l, I_LAYER - I_P, I_LAYER, wv, nwv); }
    __syncthreads();
}
__device__ __forceinline__ void convert_queue_unit(Frame& F, const Args& A, int layer, int cu) {
    int l, lo, hi;
    if (cu < CQ_U1) { l = layer; lo = I_SPLIT + CONV_NA + cu * CONV_CH; hi = lo + CONV_CH < I_LAYER - I_P ? lo + CONV_CH : I_LAYER - I_P; }
    else { l = layer + 1; lo = (cu - CQ_U1) * CONV_CH; hi = lo + CONV_CH < CONV_ND0 ? lo + CONV_CH : CONV_ND0; }
    int w_ = F.wave0; asm volatile("" : "+s"(w_)); int l_; asm volatile("v_mbcnt_lo_u32_b32 %0, -1, 0\n\tv_mbcnt_hi_u32_b32 %0, -1, %0" : "=v"(l_));
    convert_items_lw(F, A, l, lo, hi, w_, NWAVES, w_, l_);
}
__device__ __forceinline__ void p0_prologue(Frame& F, const Args& A) {
    OPAQUE_TID(F);
    const int gw = F.vcu * NWAVES + F.wave, NGW = F.G * NWAVES;
    if (F.G == 256) convert_part(F, A, 0, 0, gw, NGW);
    else for (int l = 0; l < DEPTH; ++l) convert_items(F, A, l, 0, I_LAYER, gw, NGW);
    bf16* hb = (bf16*)(F.ws + WS_HB0); float* ssq = (float*)(F.ws + WS_SSQ0);
    for (int m0 = gw; m0 < M; m0 += 4 * NGW) {
        f32x4 xv[4][8];
#pragma unroll
        for (int r = 0; r < 4; ++r) { const int m = m0 + r * NGW < M ? m0 + r * NGW : m0; const GAS f32x4* xr = (const GAS f32x4*)(A.in[0] + (size_t)m * D) + F.lane;
#pragma unroll
            for (int j = 0; j < 8; ++j) xv[r][j] = xr[64 * j]; }
        asm volatile("" ::: "memory");
#pragma unroll
        for (int r = 0; r < 4; ++r) { const int m = m0 + r * NGW; if (m >= M) break;
            GAS v2u* br = (GAS v2u*)(hb + (size_t)m * D) + F.lane; float s = 0.f;
#pragma unroll
            for (int j = 0; j < 8; ++j) { const f32x4 v = xv[r][j]; v2u o; o.x = pk2(v[0], v[1]); o.y = pk2(v[2], v[3]); br[64 * j] = o;
                const float r0 = bflo(o.x), r1 = bfhi(o.x), r2 = bflo(o.y), r3 = bfhi(o.y); s += (r0 * r0 + r1 * r1) + (r2 * r2 + r3 * r3); }
            s = wave_sum(s);
            if (F.lane < 32) ssq[(size_t)m * 32 + F.lane] = F.lane == 0 ? s : 0.f; }
    }
    { const size_t n8 = (size_t)DEPTH * M * DPLE / 8, st = (size_t)NGW * 64; const float* p = A.in[1]; bf16* pb = (bf16*)(F.ws + WS_PB);
      for (size_t i0 = (size_t)gw * 64 + F.lane; i0 < n8; i0 += 8 * st) {
          f32x4 a[8], b[8];
#pragma unroll
          for (int u = 0; u < 8; ++u) { const size_t i = i0 + u * st < n8 ? i0 + u * st : i0; a[u] = *(const GAS f32x4*)(p + i * 8); b[u] = *(const GAS f32x4*)(p + i * 8 + 4); }
          asm volatile("" ::: "memory");
#pragma unroll
          for (int u = 0; u < 8; ++u) { const size_t i = i0 + u * st; if (i >= n8) break;
              v4u o; o.x = pk2(a[u][0], a[u][1]); o.y = pk2(a[u][2], a[u][3]); o.z = pk2(b[u][0], b[u][1]); o.w = pk2(b[u][2], b[u][3]); *(GAS v4u*)(pb + i * 8) = o; } } }
}

__device__ __forceinline__ void gates_phase(Frame& F, const Args& A, int layer, const float* ssq, const bf16* hbs) {
    OPAQUE_TID(F);
    const float* w = A.in[6] + (size_t)layer * D * DIN + NIN; const float* g = A.in[5] + layer * D; float* gates = (float*)(F.ws + WS_GATES);
    LAS float* Wt = (LAS float*)F.lds;
    __syncthreads();
    { float gk[4]; f32x4 w0[4], w1[4];
#pragma unroll
      for (int i = 0; i < 4; ++i) { const int k = F.tid + 512 * i; gk[i] = g[k]; w0[i] = *(const GAS f32x4*)(w + (size_t)k * DIN); w1[i] = *(const GAS f32x4*)(w + (size_t)k * DIN + 4); }
      asm volatile("" ::: "memory");
#pragma unroll
      for (int i = 0; i < 4; ++i) { const int k = F.tid + 512 * i;
#pragma unroll
        for (int j = 0; j < 4; ++j) { Wt[j * 2048 + k] = w0[i][j] * gk[i]; Wt[(4 + j) * 2048 + k] = w1[i][j] * gk[i]; } } }
    __syncthreads();
    for (int rg = F.vcu; rg < M / 32; rg += F.G) {
        const int row0 = rg * 32 + F.wave * 4;
        float sqv[4];
#pragma unroll
        for (int r = 0; r < 4; ++r) sqv[r] = F.lane < 32 ? ssq[(size_t)(row0 + r) * 32 + F.lane] : 0.f;
        float acc[4][8];
#pragma unroll
        for (int r = 0; r < 4; ++r)
#pragma unroll
            for (int j = 0; j < 8; ++j) acc[r][j] = 0.f;
        v2u hw[8][4];
#pragma unroll
        for (int i = 0; i < 8; ++i)
#pragma unroll
            for (int r = 0; r < 4; ++r) hw[i][r] = *(const GAS v2u*)(hbs + (size_t)(row0 + r) * D + 4 * F.lane + 256 * i);
        asm volatile("" ::: "memory");
#pragma unroll
        for (int i = 0; i < 8; ++i) {
            f32x4 hv[4];
#pragma unroll
            for (int r = 0; r < 4; ++r) hv[r] = (f32x4){bflo(hw[i][r].x), bfhi(hw[i][r].x), bflo(hw[i][r].y), bfhi(hw[i][r].y)};
#pragma unroll
            for (int j = 0; j < 8; ++j) { const f32x4 wv_ = *(const LAS f32x4*)(Wt + j * 2048 + 4 * F.lane + 256 * i);
#pragma unroll
                for (int r = 0; r < 4; ++r) acc[r][j] += (hv[r][0] * wv_[0] + hv[r][1] * wv_[1]) + (hv[r][2] * wv_[2] + hv[r][3] * wv_[3]); }
        }
        float val = 0.f;
#pragma unroll
        for (int r = 0; r < 4; ++r) {
            const float sq = wave_sum(sqv[r]);
            const float rstd = __builtin_amdgcn_rsqf(sq * (1.0f / D) + RMS_EPS);
#pragma unroll
            for (int j = 0; j < 8; ++j) { const float t_ = wave_sum(acc[r][j]) * rstd; if (F.lane == r * 8 + j) val = t_; }
        }
        if (F.lane < 32) { const int j = F.lane & 7; const float bias = j < 4 ? A.in[9][layer * 4 + j] : A.in[10][layer * 4 + j - 4]; gates[(size_t)row0 * 8 + F.lane] = val + bias; }
    }
    __syncthreads();
}
__device__ __forceinline__ void final_norm(Frame& F, const Args& A) {
    OPAQUE_TID(F);
    const int gw = F.vcu * NWAVES + F.wave, NGW = F.G * NWAVES; const float* g = A.in[19];
    const bf16* hfin = (const bf16*)(F.ws + ((DEPTH & 1) ? WS_HB1 : WS_HB0));
    f32x4 gv[8];
#pragma unroll
    for (int j = 0; j < 8; ++j) gv[j] = *((const GAS f32x4*)g + F.lane + 64 * j);
    for (int m0 = gw; m0 < M; m0 += 4 * NGW) {
        v2u hw[4][8];
#pragma unroll
        for (int r = 0; r < 4; ++r) { const int m = m0 + r * NGW < M ? m0 + r * NGW : m0; const GAS v2u* br = (const GAS v2u*)(hfin + (size_t)m * D) + F.lane;
#pragma unroll
            for (int j = 0; j < 8; ++j) hw[r][j] = br[64 * j]; }
        asm volatile("" ::: "memory");
#pragma unroll
        for (int r = 0; r < 4; ++r) { const int m = m0 + r * NGW; if (m >= M) break;
            GAS f32x4* hr = (GAS f32x4*)(F.out + (size_t)m * D) + F.lane; f32x4 v[8]; float s = 0.f;
#pragma unroll
            for (int j = 0; j < 8; ++j) { v[j] = (f32x4){bflo(hw[r][j].x), bfhi(hw[r][j].x), bflo(hw[r][j].y), bfhi(hw[r][j].y)}; s += (v[j][0] * v[j][0] + v[j][1] * v[j][1]) + (v[j][2] * v[j][2] + v[j][3] * v[j][3]); }
            const float rstd = 1.0f / sqrtf(wave_sum(s) * (1.0f / D) + RMS_EPS);
#pragma unroll
            for (int j = 0; j < 8; ++j) hr[64 * j] = v[j] * rstd * gv[j]; }
    }
}


namespace att {
typedef short bf16x8 __attribute__((ext_vector_type(8)));
typedef short s16x4 __attribute__((ext_vector_type(4)));
constexpr int KP = 272, VP = 288, OFF_K0 = 0, OFF_K1 = 64 * KP, OFF_V0 = 128 * KP, OFF_V1 = 128 * KP + 64 * VP, OFF_MISC = 128 * KP + 128 * VP, OFF_KM = 73728;
constexpr float NEG = -1.0e30f, MASKED = -2.0e30f;
struct TileRegs { v4u k[2], v[2]; };
__device__ __forceinline__ void tile_load(TileRegs& R, const bf16* kbase, const bf16* vbase, size_t stride, int key0, int nkeys, int tid) {
#pragma unroll
    for (int i = 0; i < 2; ++i) { const int c = tid + 512 * i, row = c >> 4, ch = c & 15; int key = key0 + row; key = key < 0 ? 0 : (key >= nkeys ? nkeys - 1 : key);
        R.k[i] = *(const GAS v4u*)(kbase + (size_t)key * stride + ch * 8); R.v[i] = *(const GAS v4u*)(vbase + (size_t)key * stride + ch * 8); }
}
__device__ __forceinline__ void tile_store(LAS unsigned char* lds, int buf, const TileRegs& R, int tid) {
#pragma unroll
    for (int i = 0; i < 2; ++i) { const int c = tid + 512 * i, row = c >> 4, ch = c & 15;
        *(LAS v4u*)(lds + (buf ? OFF_K1 : OFF_K0) + row * KP + ch * 16) = R.k[i]; *(LAS v4u*)(lds + (buf ? OFF_V1 : OFF_V0) + row * VP + ch * 16) = R.v[i]; }
}
__device__ __forceinline__ float quad_max(float x) { return wv::quad_max(x); }
__device__ __forceinline__ float quad_sum(float x) { return wv::quad_sum(x); }
__device__ __forceinline__ void qk_tile(const LAS unsigned char* kt, const bf16x8 (&Qf)[4], int fr, int g, f32x4 (&s)[4]) {
    bf16x8 kf[4][4];
#pragma unroll
    for (int kb = 0; kb < 4; ++kb)
#pragma unroll
        for (int ks = 0; ks < 4; ++ks) kf[kb][ks] = *(const LAS bf16x8*)(kt + (16 * kb + fr) * KP + (4 * ks + g) * 16);
#pragma unroll
    for (int kb = 0; kb < 4; ++kb) s[kb] = (f32x4){0.f, 0.f, 0.f, 0.f};
#pragma unroll
    for (int ks = 0; ks < 4; ++ks)
#pragma unroll
        for (int kb = 0; kb < 4; ++kb) s[kb] = __builtin_amdgcn_mfma_f32_16x16x32_bf16(kf[kb][ks], Qf[ks], s[kb], 0, 0, 0);
}
__device__ __forceinline__ void pv_tile(const LAS unsigned char* vt, const f32x4 (&p)[4], int fr, int g, f32x4 (&O)[8]) {
    const int q = fr >> 2, pp = fr & 3;
#pragma unroll
    for (int t = 0; t < 2; ++t) {
        bf16x8 pf; { v4u w; w.x = pg8::cvt_pk_bf16(p[2 * t][0], p[2 * t][1]); w.y = pg8::cvt_pk_bf16(p[2 * t][2], p[2 * t][3]); w.z = pg8::cvt_pk_bf16(p[2 * t + 1][0], p[2 * t + 1][1]); w.w = pg8::cvt_pk_bf16(p[2 * t + 1][2], p[2 * t + 1][3]); pf = __builtin_bit_cast(bf16x8, w); }
        const LAS unsigned char* base = vt + (32 * t + 4 * g + q) * VP + 8 * pp;
        s16x4 lo[8], hi[8];
#pragma unroll
        for (int db = 0; db < 8; ++db) { lo[db] = __builtin_amdgcn_ds_read_tr16_b64_v4i16((LAS s16x4*)(base + db * 32)); hi[db] = __builtin_amdgcn_ds_read_tr16_b64_v4i16((LAS s16x4*)(base + 16 * VP + db * 32)); }
#pragma unroll
        for (int db = 0; db < 8; ++db) { const bf16x8 vf = __builtin_shufflevector(lo[db], hi[db], 0, 1, 2, 3, 4, 5, 6, 7); O[db] = __builtin_amdgcn_mfma_f32_16x16x32_bf16(vf, pf, O[db], 0, 0, 0); }
    }
}
__device__ __forceinline__ void softmax_step(f32x4 (&sc)[4], float& m, float& lsum, f32x4 (&O)[8]) {
    float tm = fmaxf(fmaxf(sc[0][0], sc[0][1]), fmaxf(sc[0][2], sc[0][3]));
#pragma unroll
    for (int kb = 1; kb < 4; ++kb) tm = fmaxf(tm, fmaxf(fmaxf(sc[kb][0], sc[kb][1]), fmaxf(sc[kb][2], sc[kb][3])));
    tm = quad_max(tm);
    const float mn = fmaxf(m, tm), alpha = __builtin_amdgcn_exp2f(m - mn); float ps = 0.f;
#pragma unroll
    for (int kb = 0; kb < 4; ++kb)
#pragma unroll
        for (int r = 0; r < 4; ++r) { const float pv = __builtin_amdgcn_exp2f(sc[kb][r] - mn); sc[kb][r] = pv; ps += pv; }
    lsum = lsum * alpha + ps; m = mn;
#pragma unroll
    for (int db = 0; db < 8; ++db) O[db] = O[db] * alpha;
}
__device__ __forceinline__ void load_q(bf16x8 (&Qf)[4], const bf16* qrow, int g) {
#pragma unroll
    for (int ks = 0; ks < 4; ++ks) Qf[ks] = __builtin_bit_cast(bf16x8, *(const GAS v4u*)(qrow + 32 * ks + 8 * g));
}


template <class MaskF>
__device__ __forceinline__ void tile_step(const LAS unsigned char* kt, const LAS unsigned char* vt, const bf16x8 (&Qf)[2][4], int fr, int g, float (&m)[2], float (&lsum)[2], f32x4 (&O)[2][8], const MaskF& maskf) {
    f32x4 s[2][4];
    {
#pragma unroll
        for (int ga = 0; ga < 2; ++ga)
#pragma unroll
            for (int kb = 0; kb < 4; ++kb) s[ga][kb] = (f32x4){0.f, 0.f, 0.f, 0.f};
#pragma unroll
        for (int ks = 0; ks < 4; ++ks) {
            bf16x8 kf[4];
#pragma unroll
            for (int kb = 0; kb < 4; ++kb) kf[kb] = *(const LAS bf16x8*)(kt + (16 * kb + fr) * KP + (4 * ks + g) * 16);
#pragma unroll
            for (int kb = 0; kb < 4; ++kb) { s[0][kb] = __builtin_amdgcn_mfma_f32_16x16x32_bf16(kf[kb], Qf[0][ks], s[0][kb], 0, 0, 0); s[1][kb] = __builtin_amdgcn_mfma_f32_16x16x32_bf16(kf[kb], Qf[1][ks], s[1][kb], 0, 0, 0); }
        }
    }
#pragma unroll
    for (int ga = 0; ga < 2; ++ga) {
#pragma unroll
        for (int kb = 0; kb < 4; ++kb)
#pragma unroll
            for (int r = 0; r < 4; ++r) s[ga][kb][r] = maskf(ga, kb, r, s[ga][kb][r]);
        softmax_step(s[ga], m[ga], lsum[ga], O[ga]);
    }
    const int q = fr >> 2, pp = fr & 3;
#pragma unroll
    for (int t = 0; t < 2; ++t) {
        bf16x8 pf[2];
#pragma unroll
        for (int ga = 0; ga < 2; ++ga) { v4u w; w.x = pg8::cvt_pk_bf16(s[ga][2 * t][0], s[ga][2 * t][1]); w.y = pg8::cvt_pk_bf16(s[ga][2 * t][2], s[ga][2 * t][3]); w.z = pg8::cvt_pk_bf16(s[ga][2 * t + 1][0], s[ga][2 * t + 1][1]); w.w = pg8::cvt_pk_bf16(s[ga][2 * t + 1][2], s[ga][2 * t + 1][3]); pf[ga] = __builtin_bit_cast(bf16x8, w); }
        const LAS unsigned char* base = vt + (32 * t + 4 * g + q) * VP + 8 * pp;
#pragma unroll
        for (int db = 0; db < 8; ++db) { const s16x4 lo = __builtin_amdgcn_ds_read_tr16_b64_v4i16((LAS s16x4*)(base + db * 32)), hi = __builtin_amdgcn_ds_read_tr16_b64_v4i16((LAS s16x4*)(base + 16 * VP + db * 32));
            const bf16x8 vf = __builtin_shufflevector(lo, hi, 0, 1, 2, 3, 4, 5, 6, 7);
            O[0][db] = __builtin_amdgcn_mfma_f32_16x16x32_bf16(vf, pf[0], O[0][db], 0, 0, 0); O[1][db] = __builtin_amdgcn_mfma_f32_16x16x32_bf16(vf, pf[1], O[1][db], 0, 0, 0); }
    }
}

__device__ __forceinline__ void moba_unit(LAS unsigned char* lds, const bf16* z, const float* kmean, bf16* mixed, float* pbuf, float* plse, int bh, int cur, int part, int tid) {
    const int lane = tid & 63, w = __builtin_amdgcn_readfirstlane(tid >> 6), fr = lane & 15, g = lane >> 4;
    const int b = bh >> 2, hh = bh & 3, q0 = 256 * cur;
    const bf16* zb = z + (size_t)b * T * NIN;
    const float slope2 = exp2f(-(float)(2 * hh + 1)) * LOG2E, c1 = 0.08838834764831845f * LOG2E;
    int t[2]; bf16x8 Qf[2][4]; unsigned sel[2];
    const int nown = part == 0 ? 4 : 0, pb_lo = part == 0 ? 0 : 3 * part - 1, pb_hi_ = part == 0 ? 2 : 3 * part + 2, pb_hi = pb_hi_ < cur ? pb_hi_ : cur;
    const int npast = pb_hi > pb_lo ? 4 * (pb_hi - pb_lo) : 0, ntl = nown + npast;
    auto tile_key0 = [&](int i) -> int { return i < nown ? q0 + 64 * i : pb_lo * 256 + 64 * (i - nown); };
    const bf16* kbase = zb + ZKA + hh * 128; const bf16* vbase = zb + ZVA + hh * 128;
    TileRegs R; tile_load(R, kbase, vbase, NIN, tile_key0(0), T, tid);
#pragma unroll
    for (int ga = 0; ga < 2; ++ga) { t[ga] = q0 + 32 * w + 16 * ga + fr; load_q(Qf[ga], zb + (size_t)t[ga] * NIN + ZQA + hh * 128, g); }
    f32x4 kmv = (f32x4){0.f, 0.f, 0.f, 0.f};
    if (tid < 256) kmv = *(const GAS f32x4*)(kmean + (size_t)bh * 1024 + 4 * tid);
    f32x4 O[2][8];
#pragma unroll
    for (int ga = 0; ga < 2; ++ga)
#pragma unroll
        for (int db = 0; db < 8; ++db) O[ga][db] = (f32x4){0.f, 0.f, 0.f, 0.f};
    float m[2] = {NEG, NEG}, lsum[2] = {0.f, 0.f};
    __syncthreads();
    tile_store(lds, 0, R, tid);
    if (tid < 256) *(LAS f32x4*)(lds + OFF_KM + 16 * tid) = kmv;
    __syncthreads();
    if (1 < ntl) tile_load(R, kbase, vbase, NIN, tile_key0(1), T, tid);
    {
        float gt[2][8];
#pragma unroll
        for (int n = 0; n < 8; ++n) { float a0 = 0.f, a1 = 0.f; const LAS unsigned char* km = lds + OFF_KM + (n * 128 + 8 * g) * 4;
#pragma unroll
            for (int ks = 0; ks < 4; ++ks) { const f32x4 k0 = *(const LAS f32x4*)(km + 128 * ks), k1 = *(const LAS f32x4*)(km + 128 * ks + 16);
                const v4u qa = __builtin_bit_cast(v4u, Qf[0][ks]), qb = __builtin_bit_cast(v4u, Qf[1][ks]);
                a0 += (bflo(qa.x) * k0[0] + bfhi(qa.x) * k0[1]) + (bflo(qa.y) * k0[2] + bfhi(qa.y) * k0[3]) + (bflo(qa.z) * k1[0] + bfhi(qa.z) * k1[1]) + (bflo(qa.w) * k1[2] + bfhi(qa.w) * k1[3]);
                a1 += (bflo(qb.x) * k0[0] + bfhi(qb.x) * k0[1]) + (bflo(qb.y) * k0[2] + bfhi(qb.y) * k0[3]) + (bflo(qb.z) * k1[0] + bfhi(qb.z) * k1[1]) + (bflo(qb.w) * k1[2] + bfhi(qb.w) * k1[3]); }
            a0 = quad_sum(a0); a1 = quad_sum(a1); gt[0][n] = n < cur ? a0 : NEG; gt[1][n] = n < cur ? a1 : NEG; }
        const int nsel = cur < 3 ? cur : 3;
#pragma unroll
        for (int ga = 0; ga < 2; ++ga) { unsigned sl = 0u;
            for (int k = 0; k < nsel; ++k) { float best = 0.f; int bi = -1;
#pragma unroll
                for (int n = 0; n < 8; ++n) { const bool ok = n < cur && !((sl >> n) & 1u) && (bi < 0 || gt[ga][n] > best); if (ok) { best = gt[ga][n]; bi = n; } }
                sl |= 1u << bi; }
            sel[ga] = sl; }
    }
    for (int i = 0; i < ntl; ++i) {
        const int key0 = tile_key0(i), nb = key0 >> 8;
        const bool skip = nb == cur && key0 > q0 + 32 * w + 31;
        if (!skip) {
            const LAS unsigned char* kt = lds + ((i & 1) ? OFF_K1 : OFF_K0); const LAS unsigned char* vt = lds + ((i & 1) ? OFF_V1 : OFF_V0);
            float base[2]; int lim[2];
#pragma unroll
            for (int ga = 0; ga < 2; ++ga) { const int cl = t[ga] - key0 - 4 * g; base[ga] = -slope2 * (float)cl; lim[ga] = nb == cur ? cl : (((sel[ga] >> nb) & 1u) ? 9999 : -1); }
            tile_step(kt, vt, Qf, fr, g, m, lsum, O, [&](int ga, int kb, int r, float sv) -> float { const float v = fmaf((float)(16 * kb + r), slope2, fmaf(sv, c1, base[ga])); return (16 * kb + r <= lim[ga]) ? v : MASKED; });
        }
        if (i + 1 < ntl) tile_store(lds, (i + 1) & 1, R, tid);
        __syncthreads();
        if (i + 2 < ntl) tile_load(R, kbase, vbase, NIN, tile_key0(i + 2), T, tid);
    }
    const bool direct = cur <= 2;
#pragma unroll
    for (int ga = 0; ga < 2; ++ga) {
        const float ls = quad_sum(lsum[ga]); const float inv = ls > 0.f ? 1.0f / ls : 0.f; const size_t row = (size_t)b * T + t[ga];
        if (direct) { bf16* orow = mixed + row * D + hh * 128 + 4 * g;
#pragma unroll
            for (int db = 0; db < 8; ++db) { v2u o; o.x = pg8::cvt_pk_bf16(O[ga][db][0] * inv, O[ga][db][1] * inv); o.y = pg8::cvt_pk_bf16(O[ga][db][2] * inv, O[ga][db][3] * inv); *(GAS v2u*)(orow + 16 * db) = o; } }
        else { bf16* orow = (bf16*)pbuf + ((size_t)part * M + row) * 512 + hh * 128 + 4 * g;
#pragma unroll
            for (int db = 0; db < 8; ++db) { v2u o; o.x = pg8::cvt_pk_bf16(O[ga][db][0] * inv, O[ga][db][1] * inv); o.y = pg8::cvt_pk_bf16(O[ga][db][2] * inv, O[ga][db][3] * inv); *(GAS v2u*)(orow + 16 * db) = o; }
            if (g == 0) plse[((size_t)part * M + row) * 4 + hh] = ls > 0.f ? m[ga] + __builtin_amdgcn_logf(ls) : NEG; }
    }
}

__device__ __forceinline__ void dil_unit(LAS unsigned char* lds, const bf16* z, float* obuf, float* lsebuf, int bh, int p, int r, int qt, int tid) {
    const int lane = tid & 63, w = __builtin_amdgcn_readfirstlane(tid >> 6), fr = lane & 15, g = lane >> 4;
    const int b = bh >> 2, hh = bh & 3, dil = p == 0 ? 1 : (p == 1 ? 4 : 16), L = T / dil, u0 = 256 * qt;
    const bf16* zb = z + ((size_t)b * T + r) * NIN; const size_t stride = (size_t)dil * NIN;
    const float slope2 = exp2f(-(float)(2 * hh + 2)) * LOG2E * (float)dil, c1 = 0.08838834764831845f * LOG2E;
    int uq[2]; bf16x8 Qf[2][4];
#pragma unroll
    for (int ga = 0; ga < 2; ++ga) { uq[ga] = u0 + 32 * w + 16 * ga + fr; const int uc = uq[ga] < L ? uq[ga] : L - 1; load_q(Qf[ga], zb + (size_t)uc * stride + ZQC + hh * 128, g); }
    const bf16* kbase = zb + ZKC + hh * 128; const bf16* vbase = zb + ZVC + hh * 128;
    f32x4 O[2][8];
#pragma unroll
    for (int ga = 0; ga < 2; ++ga)
#pragma unroll
        for (int db = 0; db < 8; ++db) O[ga][db] = (f32x4){0.f, 0.f, 0.f, 0.f};
    float m[2] = {NEG, NEG}, lsum[2] = {0.f, 0.f};
    const int j0 = u0 >= 128 ? 0 : 2, qend = u0 + 256 < L ? u0 + 256 : L, j1 = (qend - (u0 - 128) + 63) >> 6;
    TileRegs R; tile_load(R, kbase, vbase, stride, u0 - 128 + 64 * j0, L, tid);
    __syncthreads();
    tile_store(lds, 0, R, tid);
    __syncthreads();
    const int uw = u0 + 32 * w;
    for (int j = j0; j < j1; ++j) {
        const int key0 = u0 - 128 + 64 * j, bi = (j - j0) & 1;
        if (j + 1 < j1) tile_load(R, kbase, vbase, stride, key0 + 64, L, tid);
        const bool skip = (key0 > uw + 31) || (key0 + 63 < uw - 128) || uw >= L;
        if (!skip) {
            int d0[2]; float base[2];
#pragma unroll
            for (int ga = 0; ga < 2; ++ga) { d0[ga] = uq[ga] - key0 - 4 * g; base[ga] = -slope2 * (float)d0[ga]; }
            tile_step(lds + (bi ? OFF_K1 : OFF_K0), lds + (bi ? OFF_V1 : OFF_V0), Qf, fr, g, m, lsum, O,
                      [&](int ga, int kb, int rr, float sv) -> float { const int d = d0[ga] - (16 * kb + rr); const float v = fmaf((float)(16 * kb + rr), slope2, fmaf(sv, c1, base[ga])); return (d >= 0 && d <= 128) ? v : MASKED; });
        }
        if (j + 1 < j1) tile_store(lds, bi ^ 1, R, tid);
        __syncthreads();
    }
#pragma unroll
    for (int ga = 0; ga < 2; ++ga) {
        const float ls = quad_sum(lsum[ga]);
        if (uq[ga] < L) {
            const float inv = 1.0f / ls; const size_t row = (size_t)b * T + (size_t)uq[ga] * dil + r;
            bf16* orow = (bf16*)obuf + ((size_t)p * M + row) * 512 + hh * 128 + 4 * g;
#pragma unroll
            for (int db = 0; db < 8; ++db) { v2u o; o.x = pg8::cvt_pk_bf16(O[ga][db][0] * inv, O[ga][db][1] * inv); o.y = pg8::cvt_pk_bf16(O[ga][db][2] * inv, O[ga][db][3] * inv); *(GAS v2u*)(orow + 16 * db) = o; }
            if (g == 0) lsebuf[((size_t)p * M + row) * 4 + hh] = m[ga] + __builtin_amdgcn_logf(ls);
        }
    }
}
}

__device__ __forceinline__ void dil_combine(Frame& F) {
    OPAQUE_TID(F);
    const float* obuf = (const float*)(F.ws + WS_DOUT); const float* lse = (const float*)(F.ws + WS_DLSE); bf16* mixed = (bf16*)(F.ws + WS_MIXED);
    const float* pbuf = (const float*)(F.ws + WS_MOUT); const float* plse = (const float*)(F.ws + WS_MLSE);
    const size_t gt = (size_t)F.vcu * 512 + F.tid, NT = (size_t)F.G * 512;
    for (size_t i0 = gt; i0 < (size_t)M * 128; i0 += 4 * NT) {
        const bf16* o0_[4]; const bf16* o1_[4]; const bf16* o2_[4]; const float* l0_[4]; const float* l1_[4]; const float* l2_[4]; bool on_[4], three_[4]; size_t dst_[4];
#pragma unroll
        for (int k = 0; k < 4; ++k) {
            const size_t i = i0 + (size_t)k * NT; bool on = i < (size_t)M * 128;
            const bool mo = on && i >= (size_t)M * 64; const size_t ii = on ? (mo ? i - (size_t)M * 64 : i) : 0;
            size_t row = ii >> 6; int c8 = (int)(ii & 63); int np = 3;
            if (mo) { const int cur = (int)((row & (T - 1)) >> 8); if (cur <= 2) on = false; np = cur <= 5 ? 2 : 3; }
            const bool mox = mo && on; if (!on) { row = 0; c8 = 0; np = 3; }
            const int hh = c8 >> 4; const bf16* ob = (const bf16*)(mox ? pbuf : obuf); const float* lb = mox ? plse : lse;
            on_[k] = on; three_[k] = np == 3; dst_[k] = row * D + (mox ? 0 : 1536) + c8 * 8;
            l0_[k] = lb + (0 * (size_t)M + row) * 4 + hh; l1_[k] = lb + (1 * (size_t)M + row) * 4 + hh; l2_[k] = lb + ((np == 3 ? 2 : 1) * (size_t)M + row) * 4 + hh;
            o0_[k] = ob + (0 * (size_t)M + row) * 512 + c8 * 8; o1_[k] = ob + (1 * (size_t)M + row) * 512 + c8 * 8; o2_[k] = ob + ((np == 3 ? 2 : 1) * (size_t)M + row) * 512 + c8 * 8;
        }
        float lv[4][3]; v4u ow[4][3];
#pragma unroll
        for (int k = 0; k < 4; ++k) { lv[k][0] = *(const GAS float*)l0_[k]; lv[k][1] = *(const GAS float*)l1_[k]; lv[k][2] = *(const GAS float*)l2_[k];
            ow[k][0] = *(const GAS v4u*)o0_[k]; ow[k][1] = *(const GAS v4u*)o1_[k]; ow[k][2] = *(const GAS v4u*)o2_[k]; }
#pragma unroll
        for (int k = 0; k < 4; ++k) {
            const float l0 = lv[k][0], l1 = lv[k][1], l2 = three_[k] ? lv[k][2] : att::NEG;
            const float mx = fmaxf(l0, fmaxf(l1, l2)); float w0 = __builtin_amdgcn_exp2f(l0 - mx), w1 = __builtin_amdgcn_exp2f(l1 - mx), w2 = three_[k] ? __builtin_amdgcn_exp2f(l2 - mx) : 0.f;
            const float inv = 1.0f / (w0 + w1 + w2); w0 *= inv; w1 *= inv; w2 *= inv;
            f32x4 av, bv;
            { const v4u x = ow[k][0], y = ow[k][1], z_ = ow[k][2];
              av[0] = bflo(x.x) * w0 + bflo(y.x) * w1 + bflo(z_.x) * w2; av[1] = bfhi(x.x) * w0 + bfhi(y.x) * w1 + bfhi(z_.x) * w2; av[2] = bflo(x.y) * w0 + bflo(y.y) * w1 + bflo(z_.y) * w2; av[3] = bfhi(x.y) * w0 + bfhi(y.y) * w1 + bfhi(z_.y) * w2;
              bv[0] = bflo(x.z) * w0 + bflo(y.z) * w1 + bflo(z_.z) * w2; bv[1] = bfhi(x.z) * w0 + bfhi(y.z) * w1 + bfhi(z_.z) * w2; bv[2] = bflo(x.w) * w0 + bflo(y.w) * w1 + bflo(z_.w) * w2; bv[3] = bfhi(x.w) * w0 + bfhi(y.w) * w1 + bfhi(z_.w) * w2; }
            if (on_[k]) { v4u o; o.x = pg8::cvt_pk_bf16(av[0], av[1]); o.y = pg8::cvt_pk_bf16(av[2], av[3]); o.z = pg8::cvt_pk_bf16(bv[0], bv[1]); o.w = pg8::cvt_pk_bf16(bv[2], bv[3]);
                *(GAS v4u*)(mixed + dst_[k]) = o; }
        }
    }
}
constexpr int NM2 = 256;
namespace ml { __device__ __forceinline__ void m2_phase(LAS unsigned char* lds, unsigned char* ws, int vcu, int G, int tid); }
__device__ __forceinline__ void attn_phase(Frame& F, const Args& A, int layer, int nconv) {
    OPAQUE_TID(F);
    const bf16* z = (const bf16*)(F.ws + WS_Z); const float* kmean = (const float*)(F.ws + WS_KMEAN); bf16* mixed = (bf16*)(F.ws + WS_MIXED);
    float* obuf = (float*)(F.ws + WS_DOUT); float* lse = (float*)(F.ws + WS_DLSE); float* pbuf = (float*)(F.ws + WS_MOUT); float* plse = (float*)(F.ws + WS_MLSE);
    unsigned* qctr = (unsigned*)(F.ctl + CW_QUEUE + 64 * layer);
    LAS unsigned* slot = (LAS unsigned*)(F.lds + att::OFF_MISC + 64);
    const int R = 752 - 256 + nconv;
    int idx = F.vcu;
    while (idx < 752 + nconv + NM2) {
        if (idx >= 752 + nconv) { int tid2 = F.tid; asm volatile("" : "+v"(tid2)); ml::m2_phase(F.lds, F.ws, idx - (752 + nconv), 1 << 20, tid2); } else {
        int u = idx, cu = -1;
        if (idx >= 256 && nconv > 0) { const int j = idx - 256; const int c0 = (int)(((long)j * nconv) / R), c1 = (int)(((long)(j + 1) * nconv) / R); if (c1 > c0) cu = c0; else u = 256 + j - c0; }
        if (cu >= 0) convert_queue_unit(F, A, layer, cu);
        else {
        const int bh = u & 15; int k = u >> 4;
        bool is_moba; int p0, p1, p2 = 0;
        if (k < 9) { is_moba = true; p0 = (int)((0x776655432ull >> (4 * k)) & 15ull); p1 = (0x150 >> k) & 1; }
        else if (k < 20) { is_moba = false; k -= 9; if (k < 7) { p0 = 0; p1 = 0; p2 = k + 1; } else { p0 = 1; p1 = k - 7; p2 = 1; } }
        else if (k < 23) { is_moba = true; k -= 20; p0 = k == 0 ? 1 : (k == 1 ? 4 : 7); p1 = k; }
        else if (k < 26) { is_moba = true; k -= 23; p0 = 3 * k; p1 = k; }
        else if (k < 31) { is_moba = false; k -= 26; if (k == 0) { p0 = 0; p1 = 0; } else { p0 = 1; p1 = k - 1; } }
        else { is_moba = false; p0 = 2; p1 = k - 31; }
        int tid_ = F.tid; asm volatile("" : "+v"(tid_));
        if (is_moba) att::moba_unit(F.lds, z, kmean, mixed, pbuf, plse, bh, p0, p1, tid_);
        else att::dil_unit(F.lds, z, obuf, lse, bh, p0, p1, p2, tid_);
        }
        }
        __syncthreads();
        if (F.tid == 0) *slot = (unsigned)F.G + __hip_atomic_fetch_add(qctr, 1u, __ATOMIC_RELAXED, __HIP_MEMORY_SCOPE_AGENT);
        __syncthreads();
        idx = (int)*slot;
        __syncthreads();
    }
}


namespace ml {
typedef short bf16x8 __attribute__((ext_vector_type(8)));
typedef short s16x4 __attribute__((ext_vector_type(4)));
typedef float f32x2_t __attribute__((ext_vector_type(2)));
constexpr int CH = 128, NCH = T / CH;
constexpr int KP = 288, VP = 544, KRP = 272;
constexpr int OFF_KT = 0, OFF_VT = CH * KP, OFF_SM = OFF_VT + CH * VP;
__device__ __forceinline__ bf16x8 tr_frag(const LAS unsigned char* p, int pitch) {
    const s16x4 lo = __builtin_amdgcn_ds_read_tr16_b64_v4i16((LAS s16x4*)p), hi = __builtin_amdgcn_ds_read_tr16_b64_v4i16((LAS s16x4*)(p + 16 * pitch));
    return __builtin_shufflevector(lo, hi, 0, 1, 2, 3, 4, 5, 6, 7);
}
__device__ __forceinline__ float fexp(float x) { return __builtin_amdgcn_exp2f(x * LOG2E); }
__device__ __forceinline__ float logsig(float x) { return fminf(x, 0.f) - 0.6931471805599453f * __builtin_amdgcn_logf(1.0f + fexp(-fabsf(x))); }

__device__ __forceinline__ void m1_unit(LAS unsigned char* lds, const Args& A, unsigned char* ws, int layer, int unit, int tid) {
    const int lane = tid & 63, w = __builtin_amdgcn_readfirstlane(tid >> 6), fr = lane & 15, g = lane >> 4;
    const int bh = unit / NCH, c = unit - bh * NCH, b = bh >> 2, hh = bh & 3, t0 = c * CH;
    const bf16* z = (const bf16*)(ws + WS_Z); const float* gates = (const float*)(ws + WS_GATES);
    bf16* qc = (bf16*)(ws + WS_QC); bf16* kc = (bf16*)(ws + WS_KC);
    float* bq = (float*)(ws + WS_BQ); float* aq = (float*)(ws + WS_AQ); float* blast = (float*)(ws + WS_BLAST); float* amaxp = (float*)(ws + WS_AMAX);
    float* dCT = (float*)(ws + WS_DCT) + (size_t)unit * 32768; float* dn = (float*)(ws + WS_DN) + (size_t)unit * 128;
    LAS float* wl = (LAS float*)(lds + OFF_SM);
    __syncthreads();
    v4u vr[8];
#pragma unroll
    for (int i = 0; i < 8; ++i) { const int cc = tid + 512 * i, row = cc >> 5, ch = cc & 31; vr[i] = *(const GAS v4u*)(z + (size_t)(b * T + t0 + row) * NIN + ZVM + hh * 256 + ch * 8); }
    const int chunk = tid & 31, isk = chunk >> 4, ch = (chunk & 15) * 8, zc = ZQKM + isk * 512 + hh * 128 + ch, cwc = isk * 512 + hh * 128 + ch, s0 = 8 * (tid >> 5);
    v4u zw[11];
#pragma unroll
    for (int j = 0; j < 11; ++j) { const int tt = t0 + s0 - 3 + j; zw[j] = (v4u){0u, 0u, 0u, 0u}; if (tt >= 0) zw[j] = *(const GAS v4u*)(z + (size_t)(b * T + tt) * NIN + zc); }
    float wt[4][8], bias[8];
    {
        const float* cw = A.in[7] + (size_t)layer * 4096 + cwc; const float* cb = A.in[8] + (size_t)layer * 1024 + cwc;
#pragma unroll
        for (int j = 0; j < 4; ++j) { const f32x4 a0 = *(const GAS f32x4*)(cw + j * 1024), a1 = *(const GAS f32x4*)(cw + j * 1024 + 4);
#pragma unroll
            for (int e = 0; e < 4; ++e) { wt[j][e] = a0[e]; wt[j][4 + e] = a1[e]; } }
        const f32x4 a0 = *(const GAS f32x4*)cb, a1 = *(const GAS f32x4*)(cb + 4);
#pragma unroll
        for (int e = 0; e < 4; ++e) { bias[e] = a0[e]; bias[4 + e] = a1[e]; }
    }
    if (w == 0) {
        const size_t row = (size_t)b * T + t0 + 2 * lane;
        const f32x4 g0a = *(const GAS f32x4*)(gates + row * 8), g0b = *(const GAS f32x4*)(gates + row * 8 + 4), g1a = *(const GAS f32x4*)(gates + row * 8 + 8), g1b = *(const GAS f32x4*)(gates + row * 8 + 12);
        const float f0 = hh == 0 ? g0b[0] : (hh == 1 ? g0b[1] : (hh == 2 ? g0b[2] : g0b[3])), f1 = hh == 0 ? g1b[0] : (hh == 1 ? g1b[1] : (hh == 2 ? g1b[2] : g1b[3]));
        const float li0 = hh == 0 ? g0a[0] : (hh == 1 ? g0a[1] : (hh == 2 ? g0a[2] : g0a[3])), li1 = hh == 0 ? g1a[0] : (hh == 1 ? g1a[1] : (hh == 2 ? g1a[2] : g1a[3]));
        const float lf0 = logsig(f0), lf1 = logsig(f1);
        float v = lf0 + lf1;
#pragma unroll
        for (int o = 1; o < 64; o <<= 1) { const float n = wv::lane_up(v, o, lane); if (lane >= o) v += n; }
        const float b1 = v, b0 = v - lf1, a0 = li0 - b0, a1 = li1 - b1, am = wave_max(fmaxf(a0, a1));
        *(GAS f32x2_t*)(bq + (size_t)bh * T + t0 + 2 * lane) = (f32x2_t){b0, b1}; *(GAS f32x2_t*)(aq + (size_t)bh * T + t0 + 2 * lane) = (f32x2_t){a0, a1};
        wl[2 * lane] = fexp(a0 - am); wl[2 * lane + 1] = fexp(a1 - am);
        if (lane == 63) blast[unit] = b1; if (lane == 0) amaxp[unit] = am;
    }
#pragma unroll
    for (int i = 0; i < 8; ++i) { const int cc = tid + 512 * i, row = cc >> 5, ch2 = cc & 31; *(LAS v4u*)(lds + OFF_VT + row * VP + ch2 * 16) = vr[i]; }
    __syncthreads();
#pragma unroll
    for (int i = 0; i < 8; ++i) {
        const int s = s0 + i, t = t0 + s; float y[8];
#pragma unroll
        for (int e = 0; e < 8; ++e) y[e] = bias[e];
#pragma unroll
        for (int j = 0; j < 4; ++j) { const v4u q4 = zw[i + j];
            y[0] += wt[j][0] * bflo(q4.x); y[1] += wt[j][1] * bfhi(q4.x); y[2] += wt[j][2] * bflo(q4.y); y[3] += wt[j][3] * bfhi(q4.y);
            y[4] += wt[j][4] * bflo(q4.z); y[5] += wt[j][5] * bfhi(q4.z); y[6] += wt[j][6] * bflo(q4.w); y[7] += wt[j][7] * bfhi(q4.w); }
#pragma unroll
        for (int e = 0; e < 8; ++e) y[e] = y[e] * sigmoid_fast(y[e]);
        if (isk) {
#pragma unroll
            for (int e = 0; e < 8; ++e) y[e] *= 0.08838834764831845f;
            v4u o; o.x = pg8::cvt_pk_bf16(y[0], y[1]); o.y = pg8::cvt_pk_bf16(y[2], y[3]); o.z = pg8::cvt_pk_bf16(y[4], y[5]); o.w = pg8::cvt_pk_bf16(y[6], y[7]);
            *(GAS v4u*)(kc + ((size_t)bh * T + t) * 128 + ch) = o;
            const float ws_ = wl[s];
            v4u o2; o2.x = pg8::cvt_pk_bf16(y[0] * ws_, y[1] * ws_); o2.y = pg8::cvt_pk_bf16(y[2] * ws_, y[3] * ws_); o2.z = pg8::cvt_pk_bf16(y[4] * ws_, y[5] * ws_); o2.w = pg8::cvt_pk_bf16(y[6] * ws_, y[7] * ws_);
            *(LAS v4u*)(lds + OFF_KT + s * KP + ch * 2) = o2;
        } else {
            v4u o; o.x = pg8::cvt_pk_bf16(y[0], y[1]); o.y = pg8::cvt_pk_bf16(y[2], y[3]); o.z = pg8::cvt_pk_bf16(y[4], y[5]); o.w = pg8::cvt_pk_bf16(y[6], y[7]);
            *(GAS v4u*)(qc + ((size_t)bh * T + t) * 128 + ch) = o;
        }
    }
    __syncthreads();
    {
        f32x4 acc[2][8], accn = (f32x4){0.f, 0.f, 0.f, 0.f};
#pragma unroll
        for (int e = 0; e < 2; ++e)
#pragma unroll
            for (int db = 0; db < 8; ++db) acc[e][db] = (f32x4){0.f, 0.f, 0.f, 0.f};
        const int q = fr >> 2, pp = fr & 3;
        unsigned one2 = 0x3f803f80u; asm volatile("" : "+v"(one2));
        const bf16x8 ones = __builtin_bit_cast(bf16x8, (v4u){one2, one2, one2, one2});
#pragma unroll
        for (int t = 0; t < CH / 32; ++t) {
            const LAS unsigned char* kb_ = lds + OFF_KT + (32 * t + 4 * g + q) * KP + 8 * pp; const LAS unsigned char* vb_ = lds + OFF_VT + (32 * t + 4 * g + q) * VP + 8 * pp;
            bf16x8 bf[2];
#pragma unroll
            for (int e = 0; e < 2; ++e) bf[e] = tr_frag(vb_ + (2 * w + e) * 32, VP);
#pragma unroll
            for (int db = 0; db < 8; ++db) { const bf16x8 af = tr_frag(kb_ + db * 32, KP);
#pragma unroll
                for (int e = 0; e < 2; ++e) acc[e][db] = __builtin_amdgcn_mfma_f32_16x16x32_bf16(af, bf[e], acc[e][db], 0, 0, 0);
                if (db == w) accn = __builtin_amdgcn_mfma_f32_16x16x32_bf16(af, ones, accn, 0, 0, 0); }
        }
#pragma unroll
        for (int e = 0; e < 2; ++e)
#pragma unroll
            for (int db = 0; db < 8; ++db) *(GAS f32x4*)(dCT + (size_t)(16 * (2 * w + e) + fr) * 128 + 16 * db + 4 * g) = acc[e][db];
        if (fr == 0) *(GAS f32x4*)(dn + 16 * w + 4 * g) = accn;
    }
}

__device__ __forceinline__ void m2_phase(LAS unsigned char* lds, unsigned char* ws, int vcu, int G, int tid) {
    const float* blast = (const float*)(ws + WS_BLAST); const float* amaxp = (const float*)(ws + WS_AMAX); float* mst = (float*)(ws + WS_MST);
    const float* dCT = (const float*)(ws + WS_DCT); bf16* CstT = (bf16*)(ws + WS_CST); const float* dn = (const float*)(ws + WS_DN); float* nst = (float*)(ws + WS_NST);
    LAS float* wo = (LAS float*)lds; LAS float* fk = wo + 32;
    const int lane = tid & 63;
    for (int blk = vcu; blk < NBH * 16; blk += G) {
        const int bh = blk >> 4, sub = blk & 15;
        __syncthreads();
        const size_t e = (size_t)(sub * 512 + tid) * 4;
        f32x4 v[NCH];
#pragma unroll
        for (int i = 0; i < NCH; ++i) v[i] = *(const GAS f32x4*)(dCT + (size_t)(bh * NCH + i) * 32768 + e);
        if (tid < 64) {
            const int cl = lane & (NCH - 1); const float bl = blast[bh * NCH + cl], ml = bl + amaxp[bh * NCH + cl];
            float m = 0.f, mywo = 0.f, myfk = 0.f, mym = 0.f;
#pragma unroll
            for (int c = 0; c < NCH; ++c) { const float blc = wv::lane_get(bl, c), mlc = wv::lane_get(ml, c), mn = fmaxf(blc + m, mlc), w_ = fexp(blc + m - mn), f_ = fexp(mlc - mn);
                if (lane == c) { mywo = w_; myfk = f_; mym = m; } m = mn; }
            if (lane < NCH) { wo[lane] = mywo; fk[lane] = myfk; if (sub == 0) mst[bh * NCH + lane] = mym; }
        }
        __syncthreads();
        {
            float z0 = 0.f; asm volatile("" : "+v"(z0)); f32x4 C = (f32x4){z0, z0, z0, z0};
#pragma unroll
            for (int c = 0; c < NCH; ++c) { v2u o; o.x = pg8::cvt_pk_bf16(C[0], C[1]); o.y = pg8::cvt_pk_bf16(C[2], C[3]);
                *(GAS v2u*)(CstT + (size_t)(bh * NCH + c) * 32768 + e) = o; C = C * wo[c] + v[c] * fk[c]; }
        }
        if (sub == 0 && tid < 32) {
            float z0 = 0.f; asm volatile("" : "+v"(z0)); f32x4 C = (f32x4){z0, z0, z0, z0};
            f32x4 dv[NCH];
#pragma unroll
            for (int c = 0; c < NCH; ++c) dv[c] = *(const GAS f32x4*)(dn + (size_t)(bh * NCH + c) * 128 + tid * 4);
#pragma unroll
            for (int c = 0; c < NCH; ++c) { *(GAS f32x4*)(nst + (size_t)(bh * NCH + c) * 128 + tid * 4) = C; C = C * wo[c] + dv[c] * fk[c]; }
        }
    }
    __syncthreads();
}

__device__ __forceinline__ void m3_unit(LAS unsigned char* lds, const Args& A, unsigned char* ws, int layer, int unit, int tid) {
    const int lane = tid & 63, w = __builtin_amdgcn_readfirstlane(tid >> 6), fr = lane & 15, g = lane >> 4;
    const int bh = unit / NCH, c = unit - bh * NCH, b = bh >> 2, hh = bh & 3, t0 = c * CH, tp = w & 3, half = w >> 2;
    const bf16* z = (const bf16*)(ws + WS_Z); const bf16* qc = (const bf16*)(ws + WS_QC); const bf16* kc = (const bf16*)(ws + WS_KC);
    const float* bq = (const float*)(ws + WS_BQ); const float* aq = (const float*)(ws + WS_AQ); const float* mst = (const float*)(ws + WS_MST);
    const bf16* CstT = (const bf16*)(ws + WS_CST) + (size_t)unit * 32768; const float* nst = (const float*)(ws + WS_NST) + (size_t)unit * 128; bf16* mixed = (bf16*)(ws + WS_MIXED);
    LAS float* U = (LAS float*)(lds + OFF_SM); LAS float* A2 = U + CH; LAS float* WI = U + 2 * CH; LAS float* EM = U + 3 * CH; LAS float* RS = U + 4 * CH;
    __syncthreads();
    v4u kr[4], vr[8];
#pragma unroll
    for (int i = 0; i < 4; ++i) { const int cc = tid + 512 * i, row = cc >> 4, ch = cc & 15; kr[i] = *(const GAS v4u*)(kc + ((size_t)bh * T + t0 + row) * 128 + ch * 8); }
#pragma unroll
    for (int i = 0; i < 8; ++i) { const int cc = tid + 512 * i, row = cc >> 5, ch = cc & 31; vr[i] = *(const GAS v4u*)(z + (size_t)(b * T + t0 + row) * NIN + ZVM + hh * 256 + ch * 8); }
    int tq[2]; bf16x8 Qf[2][4];
#pragma unroll
    for (int ga = 0; ga < 2; ++ga) { tq[ga] = 16 * (2 * tp + ga) + fr;
#pragma unroll
        for (int ks = 0; ks < 4; ++ks) Qf[ga][ks] = __builtin_bit_cast(bf16x8, *(const GAS v4u*)(qc + ((size_t)bh * T + t0 + tq[ga]) * 128 + 32 * ks + 8 * g)); }
    f32x4 nv[4][2];
#pragma unroll
    for (int ks = 0; ks < 4; ++ks) { nv[ks][0] = *(const GAS f32x4*)(nst + 32 * ks + 8 * g); nv[ks][1] = *(const GAS f32x4*)(nst + 32 * ks + 8 * g + 4); }
    if (w == 0) {
        const f32x2_t bt = *(const GAS f32x2_t*)(bq + (size_t)bh * T + t0 + 2 * lane), a = *(const GAS f32x2_t*)(aq + (size_t)bh * T + t0 + 2 * lane); const float ms = mst[unit];
        float pmx = fmaxf(a[0], a[1]);
#pragma unroll
        for (int o = 1; o < 64; o <<= 1) { const float n = wv::lane_up(pmx, o, lane); if (lane >= o) pmx = fmaxf(pmx, n); }
        float ex = wv::lane_up(pmx, 1, lane); if (lane == 0) ex = -3.0e38f;
        const float pm0 = fmaxf(ex, a[0]), pm1 = fmaxf(pm0, a[1]), mt0 = bt[0] + fmaxf(ms, pm0), mt1 = bt[1] + fmaxf(ms, pm1);
        U[2 * lane] = (bt[0] - mt0) * LOG2E; U[2 * lane + 1] = (bt[1] - mt1) * LOG2E; A2[2 * lane] = a[0] * LOG2E; A2[2 * lane + 1] = a[1] * LOG2E;
        WI[2 * lane] = fexp(bt[0] + ms - mt0); WI[2 * lane + 1] = fexp(bt[1] + ms - mt1); EM[2 * lane] = fexp(-mt0); EM[2 * lane + 1] = fexp(-mt1);
    }
#pragma unroll
    for (int i = 0; i < 4; ++i) { const int cc = tid + 512 * i, row = cc >> 4, ch = cc & 15; *(LAS v4u*)(lds + OFF_KT + row * KRP + ch * 16) = kr[i]; }
#pragma unroll
    for (int i = 0; i < 8; ++i) { const int cc = tid + 512 * i, row = cc >> 5, ch = cc & 31; *(LAS v4u*)(lds + OFF_VT + row * VP + ch * 16) = vr[i]; }
    float qn[2] = {0.f, 0.f};
#pragma unroll
    for (int ks = 0; ks < 4; ++ks) { const f32x4 n0 = nv[ks][0], n1 = nv[ks][1];
#pragma unroll
        for (int ga = 0; ga < 2; ++ga) { const v4u qw = __builtin_bit_cast(v4u, Qf[ga][ks]);
            qn[ga] += (bflo(qw.x) * n0[0] + bfhi(qw.x) * n0[1]) + (bflo(qw.y) * n0[2] + bfhi(qw.y) * n0[3]) + (bflo(qw.z) * n1[0] + bfhi(qw.z) * n1[1]) + (bflo(qw.w) * n1[2] + bfhi(qw.w) * n1[3]); } }
    f32x4 acc[2][8];
#pragma unroll
    for (int eh = 0; eh < 2; ++eh) {
        v4u cfw[4][4];
#pragma unroll
        for (int e4 = 0; e4 < 4; ++e4)
#pragma unroll
            for (int ks = 0; ks < 4; ++ks) cfw[e4][ks] = *(const GAS v4u*)(CstT + (size_t)(128 * half + 16 * (4 * eh + e4) + fr) * 128 + 32 * ks + 8 * g);
        asm volatile("" ::: "memory");
#pragma unroll
        for (int e4 = 0; e4 < 4; ++e4) { const int eb = 4 * eh + e4; acc[0][eb] = (f32x4){0.f, 0.f, 0.f, 0.f}; acc[1][eb] = (f32x4){0.f, 0.f, 0.f, 0.f};
#pragma unroll
            for (int ks = 0; ks < 4; ++ks) { const bf16x8 cf = __builtin_bit_cast(bf16x8, cfw[e4][ks]);
                acc[0][eb] = __builtin_amdgcn_mfma_f32_16x16x32_bf16(cf, Qf[0][ks], acc[0][eb], 0, 0, 0); acc[1][eb] = __builtin_amdgcn_mfma_f32_16x16x32_bf16(cf, Qf[1][ks], acc[1][eb], 0, 0, 0); } }
    }
    __syncthreads();
    float wi[2], ut[2], dsum[2] = {0.f, 0.f};
#pragma unroll
    for (int ga = 0; ga < 2; ++ga) { qn[ga] = att::quad_sum(qn[ga]); wi[ga] = WI[tq[ga]]; ut[ga] = U[tq[ga]];
#pragma unroll
        for (int eb = 0; eb < 8; ++eb) acc[ga][eb] = acc[ga][eb] * wi[ga]; }
    const int q = fr >> 2, pp = fr & 3;
#pragma unroll
    for (int kt = 0; kt < CH / 32; ++kt) if (kt <= tp) {
        f32x4 P[2][2];
#pragma unroll
        for (int j = 0; j < 2; ++j) { const int sb = 2 * kt + j;
            P[0][j] = (f32x4){0.f, 0.f, 0.f, 0.f}; P[1][j] = (f32x4){0.f, 0.f, 0.f, 0.f};
            if (sb <= 2 * tp + 1) {
                bf16x8 kf[4];
#pragma unroll
                for (int ks = 0; ks < 4; ++ks) kf[ks] = *(const LAS bf16x8*)(lds + OFF_KT + (16 * sb + fr) * KRP + (4 * ks + g) * 16);
                const f32x4 a2 = *(const LAS f32x4*)(A2 + 16 * sb + 4 * g);
#pragma unroll
                for (int ga = 0; ga < 2; ++ga) if (sb <= 2 * tp + ga) {
                    f32x4 s = (f32x4){0.f, 0.f, 0.f, 0.f};
#pragma unroll
                    for (int ks = 0; ks < 4; ++ks) s = __builtin_amdgcn_mfma_f32_16x16x32_bf16(kf[ks], Qf[ga][ks], s, 0, 0, 0);
#pragma unroll
                    for (int r = 0; r < 4; ++r) { const int sidx = 16 * sb + 4 * g + r; const float pv = sidx <= tq[ga] ? s[r] * __builtin_amdgcn_exp2f(ut[ga] + a2[r]) : 0.f; P[ga][j][r] = pv; dsum[ga] += pv; }
                }
            }
        }
        bf16x8 pf[2];
#pragma unroll
        for (int ga = 0; ga < 2; ++ga) { v4u wv; wv.x = pg8::cvt_pk_bf16(P[ga][0][0], P[ga][0][1]); wv.y = pg8::cvt_pk_bf16(P[ga][0][2], P[ga][0][3]); wv.z = pg8::cvt_pk_bf16(P[ga][1][0], P[ga][1][1]); wv.w = pg8::cvt_pk_bf16(P[ga][1][2], P[ga][1][3]); pf[ga] = __builtin_bit_cast(bf16x8, wv); }
        const LAS unsigned char* vb_ = lds + OFF_VT + (32 * kt + 4 * g + q) * VP + 8 * pp + half * 256;
#pragma unroll
        for (int eb = 0; eb < 8; ++eb) { const bf16x8 vf = tr_frag(vb_ + eb * 32, VP);
            acc[0][eb] = __builtin_amdgcn_mfma_f32_16x16x32_bf16(vf, pf[0], acc[0][eb], 0, 0, 0); acc[1][eb] = __builtin_amdgcn_mfma_f32_16x16x32_bf16(vf, pf[1], acc[1][eb], 0, 0, 0); }
    }
#pragma unroll
    for (int ga = 0; ga < 2; ++ga) {
        const float den = wi[ga] * qn[ga] + att::quad_sum(dsum[ga]), dinv = 1.0f / fmaxf(fabsf(den), EM[tq[ga]]);
        float ss = 0.f;
#pragma unroll
        for (int eb = 0; eb < 8; ++eb) { acc[ga][eb] = acc[ga][eb] * dinv; ss += (acc[ga][eb][0] * acc[ga][eb][0] + acc[ga][eb][1] * acc[ga][eb][1]) + (acc[ga][eb][2] * acc[ga][eb][2] + acc[ga][eb][3] * acc[ga][eb][3]); }
        ss = att::quad_sum(ss);
        if (g == 0) RS[tq[ga] * 2 + half] = ss;
    }
    __syncthreads();
#pragma unroll
    for (int ga = 0; ga < 2; ++ga) {
        const float rn = __builtin_amdgcn_rsqf((RS[tq[ga] * 2] + RS[tq[ga] * 2 + 1]) * (1.0f / 256.0f) + RMS_EPS);
        const size_t row = (size_t)b * T + t0 + tq[ga]; const float* gh = A.in[11] + (size_t)layer * 1024 + hh * 256 + 128 * half + 4 * g;
        const bf16* orow = z + row * NIN + ZOM + hh * 256 + 128 * half + 4 * g; bf16* mrow = mixed + row * D + 512 + hh * 256 + 128 * half + 4 * g;
        f32x4 gvv[8]; v2u oww[8];
#pragma unroll
        for (int eb = 0; eb < 8; ++eb) { gvv[eb] = *(const GAS f32x4*)(gh + 16 * eb); oww[eb] = *(const GAS v2u*)(orow + 16 * eb); }
        asm volatile("" ::: "memory");
#pragma unroll
        for (int eb = 0; eb < 8; ++eb) { const f32x4 gv = gvv[eb]; const v2u ow = oww[eb];
            const float r0 = acc[ga][eb][0] * rn * gv[0] * sigmoid_fast(bflo(ow.x)), r1 = acc[ga][eb][1] * rn * gv[1] * sigmoid_fast(bfhi(ow.x)), r2 = acc[ga][eb][2] * rn * gv[2] * sigmoid_fast(bflo(ow.y)), r3 = acc[ga][eb][3] * rn * gv[3] * sigmoid_fast(bfhi(ow.y));
            v2u o; o.x = pg8::cvt_pk_bf16(r0, r1); o.y = pg8::cvt_pk_bf16(r2, r3); *(GAS v2u*)(mrow + 16 * eb) = o; }
    }
}
}

struct KmeanRegs { v4u kv[8]; };
__device__ __forceinline__ void kmean_load(Frame& F, int it, KmeanRegs& R) {
    const bf16* z = (const bf16*)(F.ws + WS_Z);
    const int bh = it >> 3, blk = it & 7, b = bh >> 2, hh = bh & 3, r = F.lane >> 4, c = F.lane & 15;
    const bf16* base = z + (size_t)(b * T + blk * 256 + 32 * F.wave + r) * NIN + ZKA + hh * 128 + 8 * c;
#pragma unroll
    for (int i = 0; i < 8; ++i) R.kv[i] = *(const GAS v4u*)(base + (size_t)(4 * i) * NIN);
}
__device__ __forceinline__ void kmean_finish(Frame& F, int it, const KmeanRegs& R) {
    float* kmean = (float*)(F.ws + WS_KMEAN); LAS float* part = (LAS float*)F.lds;
    const int r = F.lane >> 4, c = F.lane & 15;
    float a[8];
#pragma unroll
    for (int e = 0; e < 8; ++e) a[e] = 0.f;
#pragma unroll
    for (int i = 0; i < 8; ++i) { a[0] += bflo(R.kv[i].x); a[1] += bfhi(R.kv[i].x); a[2] += bflo(R.kv[i].y); a[3] += bfhi(R.kv[i].y); a[4] += bflo(R.kv[i].z); a[5] += bfhi(R.kv[i].z); a[6] += bflo(R.kv[i].w); a[7] += bfhi(R.kv[i].w); }
#pragma unroll
    for (int e = 0; e < 8; ++e) a[e] = wv::quad_sum(a[e]);
    __syncthreads();
    if (r == 0) {
#pragma unroll
        for (int e = 0; e < 8; ++e) part[F.wave * 128 + 8 * c + e] = a[e]; }
    __syncthreads();
    if (F.tid < 128) { float s_ = 0.f;
#pragma unroll
        for (int w_ = 0; w_ < 8; ++w_) s_ += part[w_ * 128 + F.tid];
        kmean[(size_t)it * 128 + F.tid] = s_ * (1.0f / 256.0f); }
}
__device__ __forceinline__ void m1_phase(Frame& F, const Args& A, int layer) {
    OPAQUE_TID(F);
    for (int it = F.vcu; it < NBH * 8 || it < NBH * ml::NCH; it += F.G) {
        KmeanRegs KR; const bool hk = it < NBH * 8;
        if (hk) kmean_load(F, it, KR);
        if (it < NBH * ml::NCH) ml::m1_unit(F.lds, A, F.ws, layer, it, F.tid);
        if (hk) kmean_finish(F, it, KR);
    }
    __syncthreads();
}
__device__ __forceinline__ void m3_phase(Frame& F, const Args& A, int layer) {
    OPAQUE_TID(F);
    for (int u = F.vcu; u < NBH * ml::NCH; u += F.G) ml::m3_unit(F.lds, A, F.ws, layer, u, F.tid);
    __syncthreads();
}

constexpr int N_PHASES = 2 + 10 * DEPTH;
__global__ void __launch_bounds__(NWAVES * 64, 2) mk_fwd(Args args) {
    extern __shared__ __attribute__((aligned(16))) unsigned char lds[];
    Frame F;
    F.lds = (LAS unsigned char*)lds;
    F.MISC = (volatile LAS unsigned*)(F.lds + MISC_OFF);
    F.tid = threadIdx.x; F.lane = F.tid & 63; F.wave = __builtin_amdgcn_readfirstlane(F.tid >> 6); F.wave0 = F.wave;
    F.G = gridDim.x; { const int bx = blockIdx.x; F.vcu = (F.G % 8 == 0) ? (bx % 8) * (F.G / 8) + bx / 8 : bx; }
    F.ws = args.ws; F.out = args.out; F.ctl = (gu32*)(args.ws + WS_CTL);
    for (int u = F.tid; u < (LDS_BYTES - LDSCTL_OFF) / 4; u += NWAVES * 64) ((LAS unsigned*)(F.lds + LDSCTL_OFF))[u] = 0u;
    __syncthreads();
    XcdBarrier bar = xcd_barrier_post((unsigned*)(F.ctl + CW_BAR), F.MISC + 8);
    const int lo = args.ph_lo, hi = args.ph_hi;
#define IN(k) (lo <= (k) && (k) < hi)
#define SEAM(k) do { if (IN((k) + 1)) xcd_barrier(bar); } while (0)
#define PH_BEGIN int L = layer; asm volatile("" : "+s"(L)); int BX = blockIdx.x; asm volatile("" : "+s"(BX)); int GG = gridDim.x; asm volatile("" : "+s"(GG)); unsigned char* ws = args.ws; asm volatile("" : "+s"(ws)); \
    bf16* hb_cur = (bf16*)(ws + ((L & 1) ? WS_HB1 : WS_HB0)); bf16* hb_nxt = (bf16*)(ws + ((L & 1) ? WS_HB0 : WS_HB1)); \
    float* ssq0 = (float*)(ws + WS_SSQ0); float* ssq1 = (float*)(ws + WS_SSQ1); \
    bf16* act = (bf16*)(ws + WS_ACT); bf16* z = (bf16*)(ws + WS_Z); bf16* mixed = (bf16*)(ws + WS_MIXED); bf16* pp = (bf16*)(ws + WS_PP); \
    (void)hb_cur; (void)hb_nxt; (void)ssq0; (void)ssq1; (void)act; (void)z; (void)mixed; (void)pp;

    if (IN(0)) { p0_prologue(F, args); SEAM(0); }

    for (int layer = 0; layer < DEPTH; ++layer) {
        const int pb = 1 + 10 * layer;
        if (IN(pb + 0)) { PH_BEGIN
            pg8::Gemm g{hb_cur, WPTR(LW_UP1), M, NUP, D}; pg8::StaticOrder S; S.init(M, NUP, GG, BX);
            pg8::EpiSwiGLU E{act, ssq0, DFF};
            pg8::gemm_phase<pg8::EpiSwiGLU, pg8::StaticOrder, true, true>(F.lds + RING_OFF, g, S, E, F.wave0);
            if (GG == 256 && BX >= 128) {
                pg8::Gemm g2{(const bf16*)(ws + WS_PB) + (size_t)L * M * DPLE, WPTR(LW_P), M, D, DPLE}; pg8::StaticOrder S2; S2.init(M, D, 128, BX - 128);
                pg8::EpiScaleBf16 E2{pp, nullptr, D};
                pg8::gemm_phase<pg8::EpiScaleBf16, pg8::StaticOrder, true, true>(F.lds + RING_OFF, g2, S2, E2, F.wave0);
                convert_tail(F, args, L, 1, BX);
            }
            if (!IN(pb + 1)) {}
        }
        if (IN(pb + 1)) { PH_BEGIN
            pg8::Gemm g{act, WPTR(LW_DN1), M, D, DFF}; pg8::StaticOrder S; S.init(M, D, GG, BX);
            pg8::EpiResid<0, 1> E{hb_cur, hb_cur, ssq1, nullptr, nullptr};
            pg8::gemm_phase<pg8::EpiResid<0, 1>, pg8::StaticOrder, true, true, BarHook>(F.lds + RING_OFF, g, S, E, F.wave0, BarHook{bar, IN(pb + 0)});
            SEAM(pb + 1);
        }
        if (IN(pb + 2)) { PH_BEGIN
            pg8::Gemm g{hb_cur, WPTR(LW_IN), M, NIN, D}; pg8::StaticOrder S; S.init(M, NIN, GG, BX);
            pg8::EpiScaleBf16 E{z, ssq1, NIN};
            pg8::gemm_phase<pg8::EpiScaleBf16, pg8::StaticOrder, true, true>(F.lds + RING_OFF, g, S, E, F.wave0);
            gates_phase(F, args, L, ssq1, hb_cur);
            SEAM(pb + 2);
        }
        if (IN(pb + 3)) { PH_BEGIN
            pg8::Gemm g{(const bf16*)(F.ws + WS_PB) + (size_t)L * M * DPLE, WPTR(LW_P), M, D, DPLE}; pg8::StaticOrder S; S.init(M, D, GG, BX);
            pg8::EpiScaleBf16 E{pp, nullptr, D};
            if (GG != 256) pg8::gemm_phase<pg8::EpiScaleBf16, pg8::StaticOrder, true, true>(F.lds + RING_OFF, g, S, E, F.wave0);
            m1_phase(F, args, L);
            SEAM(pb + 3);
        }
        if (IN(pb + 4)) { PH_BEGIN OPAQUE_TID(F); attn_phase(F, args, L, GG == 256 ? CQ_U1 + (L + 1 < DEPTH ? CQ_U2 : 0) : 0); SEAM(pb + 4); }
        if (IN(pb + 5)) { PH_BEGIN m3_phase(F, args, L); dil_combine(F); }
        if (IN(pb + 6)) { PH_BEGIN
            pg8::Gemm g{mixed, WPTR(LW_OUT), M, D, D}; pg8::StaticOrder S; S.init(M, D, GG, BX);
            pg8::EpiResid<0, 2> E{hb_cur, hb_cur, ssq0, nullptr, nullptr};
            pg8::gemm_phase<pg8::EpiResid<0, 2>, pg8::StaticOrder, true, true, BarHook>(F.lds + RING_OFF, g, S, E, F.wave0, BarHook{bar, IN(pb + 5)});
            SEAM(pb + 6);
        }
        if (IN(pb + 7)) { PH_BEGIN
            pg8::Gemm g{hb_cur, WPTR(LW_UP2), M, NUP, D}; pg8::StaticOrder S; S.init(M, NUP, GG, BX);
            pg8::EpiSwiGLU E{act, ssq0, DFF};
            pg8::gemm_phase<pg8::EpiSwiGLU, pg8::StaticOrder, true, true>(F.lds + RING_OFF, g, S, E, F.wave0);
            if (GG == 256 && BX >= 128) convert_tail(F, args, L + 1, 0, BX);
        }
        if (IN(pb + 8)) { PH_BEGIN
            pg8::Gemm g{act, WPTR(LW_DN2), M, D, DFF}; pg8::StaticOrder S; S.init(M, D, GG, BX);
            pg8::EpiResid<0, 1> E{hb_cur, hb_cur, ssq1, nullptr, nullptr};
            pg8::gemm_phase<pg8::EpiResid<0, 1>, pg8::StaticOrder, true, true, BarHook>(F.lds + RING_OFF, g, S, E, F.wave0, BarHook{bar, IN(pb + 7)});
            SEAM(pb + 8);
        }
        if (IN(pb + 9)) { PH_BEGIN
            pg8::Gemm g{hb_cur, WPTR(LW_G), M, D, D}; pg8::StaticOrder S; S.init(M, D, GG, BX);
            pg8::EpiResid<1, 2> E{hb_cur, hb_nxt, ssq0, ssq1, pp};
            pg8::gemm_phase<pg8::EpiResid<1, 2>, pg8::StaticOrder, true, true>(F.lds + RING_OFF, g, S, E, F.wave0);
            SEAM(pb + 9);
        }
    }
    if (IN(N_PHASES - 1)) final_norm(F, args);
#undef IN
#undef SEAM
#undef PH_BEGIN
}

#ifndef MK_MULTI
#define MK_MULTI 0
#endif
extern "C" void kernel_launch(void* const* d_in, const int* in_sizes, int n_in, void* d_out, int out_size, void* d_ws, size_t ws_size, hipStream_t stream) {
    static int grid = 0;
    if (grid == 0) {
        if (n_in != 20 || in_sizes[0] != M * D || out_size != M * D || ws_size < WS_END) { fprintf(stderr, "kernel_launch: unexpected shapes: n_in %d in0 %d out %d ws %zu (need %zu)\n", n_in, n_in > 0 ? in_sizes[0] : -1, out_size, ws_size, (size_t)WS_END); grid = -1; return; }
        int dev = 0, cus = 0, per_cu = 0;
        if (hipGetDevice(&dev) != hipSuccess || hipDeviceGetAttribute(&cus, hipDeviceAttributeMultiprocessorCount, dev) != hipSuccess) { grid = -1; return; }
        if (hipFuncSetAttribute((const void*)mk_fwd, hipFuncAttributeMaxDynamicSharedMemorySize, LDS_BYTES) != hipSuccess) { fprintf(stderr, "kernel_launch: hipFuncSetAttribute failed\n"); grid = -1; return; }
        if (hipOccupancyMaxActiveBlocksPerMultiprocessor(&per_cu, (const void*)mk_fwd, NWAVES * 64, LDS_BYTES) != hipSuccess || per_cu < 1) { fprintf(stderr, "kernel_launch: occupancy query says %d blocks per CU\n", per_cu); }
        (void)hipGetLastError();
        grid = cus;
    }
    if (grid < 0) return;
    if (hipMemsetAsync((char*)d_ws + WS_CTL, 0, CTL_ZERO_BYTES, stream) != hipSuccess) return;
    Args a{};
    for (int i = 0; i < 20; ++i) a.in[i] = (const float*)d_in[i];
    a.out = (float*)d_out; a.ws = (unsigned char*)d_ws;
#if MK_MULTI
    for (int p = 0; p < N_PHASES; ++p) { a.ph_lo = p; a.ph_hi = p + 1; hipLaunchKernelGGL(mk_fwd, dim3(grid), dim3(NWAVES * 64), LDS_BYTES, stream, a); }
#else
    a.ph_lo = 0; a.ph_hi = N_PHASES;
    hipLaunchKernelGGL(mk_fwd, dim3(grid), dim3(NWAVES * 64), LDS_BYTES, stream, a);
#endif
    const hipError_t le = hipPeekAtLastError();
    if (le != hipSuccess) fprintf(stderr, "kernel_launch: launch failed: %s\n", hipGetErrorName(le));
}
```
